# Optimizing an MI355X kernel written in HIP

```python
import math
import jax
import jax.numpy as jnp
from jax import lax
import numpy as np

D_MODEL = 2048
BATCH = 16
SEQ = 2048
DEPTH = 4

CTX_LEN = 256
GRID_W = 64
N_MIXERS = 3
RMS_EPS = 1e-6
N_MOD = 6

ATT_HEADS = 32
ATT_KV_HEADS = 4
ATT_GQA = ATT_HEADS // ATT_KV_HEADS
ATT_HEAD_DIM = 64
ATT_WINDOW = 128
ATT_BLOCK = 128
ATT_Q_DIM = ATT_HEADS * ATT_HEAD_DIM
ATT_KV_DIM = ATT_KV_HEADS * ATT_HEAD_DIM
ATT_IN = 2 * ATT_KV_DIM + ATT_Q_DIM
ROPE_THETA = 10000.0
ROPE_PAIRS = ATT_HEAD_DIM // 4
NEG_INF = -1e30

SSD_D_INNER = 2 * D_MODEL
SSD_HEAD_DIM = 64
SSD_HEADS = SSD_D_INNER // SSD_HEAD_DIM
SSD_GROUPS = 8
SSD_STATE = 128
SSD_GN = SSD_GROUPS * SSD_STATE
SSD_CONV_W = 3
SSD_CHUNK = 64
SSD_CONV_DIM = SSD_D_INNER + 2 * SSD_GN
SSD_IN = SSD_CONV_DIM + 2 * SSD_HEADS + SSD_D_INNER

HG_EXPAND = 128
HG_HEADS = D_MODEL // HG_EXPAND
HG_KEY = HG_HEADS * HG_EXPAND
HG_HEAD_V = D_MODEL // HG_HEADS
HG_VAL = HG_HEADS * HG_HEAD_V
HG_CHUNK = 64
HG_IN = 2 * HG_KEY + HG_VAL + HG_KEY + HG_VAL

FFN_DIM = -(-8 * D_MODEL // (3 * 256)) * 256

kernel_name = 'hybrid_interleaved_dit_trunk'


def _rms(t):
    t32 = t.astype(jnp.float32)
    return (t32 * lax.rsqrt(jnp.mean(t32 * t32, axis=-1, keepdims=True) + RMS_EPS)).astype(t.dtype)


def rms_norm(t, g):
    return _rms(t) * g


def modulate(t, g, shift, scale):
    return rms_norm(t, g) * (1.0 + scale) + shift


def _flip(t):
    return jnp.flip(t, axis=1)


def swiglu(t, w_in, w_out):
    gu = t @ w_in
    return (jax.nn.silu(gu[..., :FFN_DIM]) * gu[..., FFN_DIM:]) @ w_out


def axial_rope_tables(n_tokens):
    rows = n_tokens // GRID_W
    row = jnp.broadcast_to(jnp.arange(rows)[:, None], (rows, GRID_W)).reshape(-1).astype(jnp.float32)
    col = jnp.broadcast_to(jnp.arange(GRID_W)[None, :], (rows, GRID_W)).reshape(-1).astype(jnp.float32)
    inv_freq = ROPE_THETA ** (-jnp.arange(ROPE_PAIRS, dtype=jnp.float32) / ROPE_PAIRS)
    ang = jnp.stack([row[:, None] * inv_freq, col[:, None] * inv_freq], axis=1)
    return jnp.cos(ang), jnp.sin(ang)


def apply_axial_rope(t, cos, sin):
    shp = t.shape
    tt = t.reshape(shp[:-1] + (2, 2, ROPE_PAIRS))
    bshape = (shp[1],) + (1,) * (len(shp) - 3) + (2, ROPE_PAIRS)
    cs = cos.reshape(bshape).astype(t.dtype)
    sn = sin.reshape(bshape).astype(t.dtype)
    t1, t2 = tt[..., 0, :], tt[..., 1, :]
    return jnp.stack([t1 * cs - t2 * sn, t2 * cs + t1 * sn], axis=-2).reshape(shp)


def sink_softmax(scores, sink):
    sink_col = jnp.broadcast_to(sink[:, :, None, None], scores.shape[:-1] + (1,))
    return jax.nn.softmax(jnp.concatenate([sink_col, scores], axis=-1), axis=-1)[..., 1:]


def key_band(t, nb):
    b = t.shape[0]
    tb = t.reshape((b, nb, ATT_BLOCK) + t.shape[2:])
    tp = jnp.pad(tb, ((0, 0), (1, 1), (0, 0), (0, 0), (0, 0)))
    return jnp.concatenate([tp[:, :-2], tp[:, 1:-1], tp[:, 2:]], axis=2)


def banded_window_attention(q, k, v, k_c, v_c, sink):
    b, s = q.shape[:2]
    nb = s // ATT_BLOCK
    scale = ATT_HEAD_DIM ** -0.5
    qb = q.reshape(b, nb, ATT_BLOCK, ATT_KV_HEADS, ATT_GQA, ATT_HEAD_DIM)
    kb, vb = key_band(k, nb), key_band(v, nb)
    s_loc = jnp.einsum('bnqkgd,bnjkd->bnkgqj', qb, kb).astype(jnp.float32) * scale
    s_ctx = jnp.einsum('bnqkgd,bmkd->bnkgqm', qb, k_c).astype(jnp.float32) * scale
    r = jnp.arange(ATT_BLOCK)
    cidx = jnp.arange(3 * ATT_BLOCK)
    blk = jnp.arange(nb)
    in_window = jnp.abs(r[:, None] + ATT_BLOCK - cidx[None, :]) <= ATT_WINDOW
    kpos = (blk[:, None] - 1) * ATT_BLOCK + cidx[None, :]
    valid = in_window[None] & ((kpos >= 0) & (kpos < s))[:, None, :]
    s_loc = jnp.where(valid[None, :, None, None], s_loc, NEG_INF)
    p = sink_softmax(jnp.concatenate([s_loc, s_ctx], axis=-1), sink).astype(v.dtype)
    n_loc = 3 * ATT_BLOCK
    o = (jnp.einsum('bnkgqj,bnjkd->bnqkgd', p[..., :n_loc], vb)
         + jnp.einsum('bnkgqm,bmkd->bnqkgd', p[..., n_loc:], v_c))
    return o.reshape(b, s, ATT_Q_DIM)


def context_attention(q_c, k_c, v_c, sink):
    b, l = q_c.shape[:2]
    scores = jnp.einsum('blkgd,bmkd->bkglm', q_c, k_c).astype(jnp.float32) * (ATT_HEAD_DIM ** -0.5)
    p = sink_softmax(scores, sink).astype(v_c.dtype)
    return jnp.einsum('bkglm,bmkd->blkgd', p, v_c).reshape(b, l, ATT_Q_DIM)


def attention_mixer(u, u_c, w_in, w_out, sink, rope_cos, rope_sin, need_ctx):
    b, s, _ = u.shape
    lc = u_c.shape[1]
    kvh, dh = ATT_KV_HEADS, ATT_HEAD_DIM
    proj = u @ w_in
    k = apply_axial_rope(proj[..., :ATT_KV_DIM].reshape(b, s, kvh, dh), rope_cos, rope_sin)
    v = proj[..., ATT_KV_DIM:2 * ATT_KV_DIM].reshape(b, s, kvh, dh)
    q = apply_axial_rope(proj[..., 2 * ATT_KV_DIM:].reshape(b, s, kvh, ATT_GQA, dh), rope_cos, rope_sin)
    proj_c = u_c @ (w_in if need_ctx else w_in[:, :2 * ATT_KV_DIM])
    k_c = proj_c[..., :ATT_KV_DIM].reshape(b, lc, kvh, dh)
    v_c = proj_c[..., ATT_KV_DIM:2 * ATT_KV_DIM].reshape(b, lc, kvh, dh)
    sink = sink.astype(jnp.float32).reshape(kvh, ATT_GQA)
    y = banded_window_attention(q, k, v, k_c, v_c, sink) @ w_out
    if not need_ctx:
        return y, None
    q_c = proj_c[..., 2 * ATT_KV_DIM:].reshape(b, lc, kvh, ATT_GQA, dh)
    return y, context_attention(q_c, k_c, v_c, sink) @ w_out


def centred_depthwise_conv(t, w, bias):
    pad = SSD_CONV_W // 2
    l = t.shape[1]
    tp = jnp.pad(t, ((0, 0), (pad, pad), (0, 0)))
    out = bias + tp[:, 0:l] * w[0]
    for tap in range(1, SSD_CONV_W):
        out = out + tp[:, tap:tap + l] * w[tap]
    return out


def ssd_chunk_scan(x, dt, a, bm, cm, s0, want_y):
    b, l, nh, p = x.shape
    g, n = bm.shape[-2:]
    e = nh // g
    nc = l // SSD_CHUNK
    q = SSD_CHUNK
    acum = jnp.cumsum((dt * a).reshape(b, nc, q, g, e), axis=2).transpose(0, 1, 3, 4, 2)
    xdt = (x * dt[..., None]).reshape(b, nc, q, g, e, p)
    bc = bm.reshape(b, nc, q, g, n)
    cc = cm.reshape(b, nc, q, g, n)
    decay_end = jnp.exp(acum[..., -1:] - acum)
    states = jnp.einsum('bcqgn,bcgeq,bcqgep->bcgepn', bc, decay_end, xdt)
    chunk_decay = jnp.exp(acum[..., -1])

    def step(s, inp):
        st, dec = inp
        return dec[..., None, None] * s + st, s

    s_fin, s_start = lax.scan(step, s0, (jnp.moveaxis(states, 1, 0), jnp.moveaxis(chunk_decay, 1, 0)))
    if not want_y:
        return None, s_fin
    tril = jnp.tril(jnp.ones((q, q), dtype=bool))
    seg = jnp.where(tril, acum[..., :, None] - acum[..., None, :], -jnp.inf)
    cb = jnp.einsum('bcign,bcjgn->bcgij', cc, bc)
    y_diag = jnp.einsum('bcgij,bcgeij,bcjgep->bcigep', cb, jnp.exp(seg), xdt)
    y_off = jnp.einsum('bcign,cbgepn,bcgei->bcigep', cc, s_start, jnp.exp(acum))
    return (y_diag + y_off).reshape(b, l, nh, p).astype(x.dtype), s_fin


def gated_group_rms_norm(y, z, w):
    b, l = y.shape[:2]
    t = y.reshape(b, l, SSD_D_INNER) * jax.nn.silu(z)
    t = _rms(t.reshape(b, l, SSD_GROUPS, SSD_D_INNER // SSD_GROUPS)).reshape(b, l, SSD_D_INNER)
    return t * w


def ssd_mixer(u, u_c, w_in, conv_w, conv_b, dt_bias, a_log, d_skip, norm_w, w_out, need_ctx):
    b = u.shape[0]
    n_state = SSD_CONV_DIM + 2 * SSD_HEADS
    a = -jnp.exp(a_log.astype(jnp.float32))

    def split_inputs(t, w):
        bt, lt, _ = t.shape
        proj = t @ w
        xbc = jax.nn.silu(centred_depthwise_conv(proj[..., :SSD_CONV_DIM], conv_w, conv_b))
        xs = xbc[..., :SSD_D_INNER].reshape(bt, lt, SSD_HEADS, SSD_HEAD_DIM)
        bm = xbc[..., SSD_D_INNER:SSD_D_INNER + SSD_GN].reshape(bt, lt, SSD_GROUPS, SSD_STATE)
        cm = xbc[..., SSD_D_INNER + SSD_GN:].reshape(bt, lt, SSD_GROUPS, SSD_STATE)
        dt = jax.nn.softplus(proj[..., SSD_CONV_DIM:n_state].astype(jnp.float32).reshape(bt, lt, 2, SSD_HEADS)
                             + dt_bias.astype(jnp.float32))
        return proj[..., n_state:], xs, bm, cm, dt

    def bidir(xs, bm, cm, dt, s_f, s_b, want_y):
        y_f, fin_f = ssd_chunk_scan(xs, dt[:, :, 0], a[0], bm, cm, s_f, want_y)
        y_b, fin_b = ssd_chunk_scan(_flip(xs), _flip(dt[:, :, 1]), a[1], _flip(bm), _flip(cm), s_b, want_y)
        y = (y_f + _flip(y_b) + xs * d_skip[:, None]) if want_y else None
        return y, fin_f, fin_b

    zero = jnp.zeros((b, SSD_GROUPS, SSD_HEADS // SSD_GROUPS, SSD_HEAD_DIM, SSD_STATE), jnp.float32)
    z_c, x_c, b_c, c_c, dt_c = split_inputs(u_c, w_in if need_ctx else w_in[:, :n_state])
    y_c, s_f, s_b = bidir(x_c, b_c, c_c, dt_c, zero, zero, need_ctx)
    z, xs, bm, cm, dt = split_inputs(u, w_in)
    y, _, _ = bidir(xs, bm, cm, dt, s_f, s_b, True)
    y = gated_group_rms_norm(y, z, norm_w) @ w_out
    if not need_ctx:
        return y, None
    return y, gated_group_rms_norm(y_c, z_c, norm_w) @ w_out


def hgrn2_lower_bounds(lb_raw):
    p = jax.nn.softmax(lb_raw.astype(jnp.float32), axis=1)
    return jnp.cumsum(p, axis=1) - p[:, :1]


def hgrn2_chunk_scan(k, v, log_g, s0, q=None):
    b, l, nh, dk = k.shape
    nc = l // HG_CHUNK

    def chunks(t):
        return t.reshape(b, nc, HG_CHUNK, nh, t.shape[-1]).transpose(1, 0, 3, 2, 4)

    tril = jnp.tril(jnp.ones((HG_CHUNK, HG_CHUNK), dtype=bool))

    def step(state, inp):
        kc, vc, gc = inp[0], inp[1], inp[2]
        gcum = jnp.cumsum(gc, axis=2)
        g_last = gcum[:, :, -1:]
        new_state = (jnp.exp(g_last[:, :, 0])[..., None] * state
                     + jnp.einsum('bhsd,bhsv->bhdv', kc * jnp.exp(g_last - gcum), vc))
        if q is None:
            return new_state, None
        qc = inp[3]
        rel = jnp.where(tril[:, :, None], gcum[:, :, :, None] - gcum[:, :, None], -jnp.inf)
        scores = jnp.einsum('bhtd,bhsd,bhtsd->bhts', qc, kc, jnp.exp(rel))
        o = (jnp.einsum('bhts,bhsv->bhtv', scores, vc)
             + jnp.einsum('bhtd,bhdv->bhtv', qc * jnp.exp(gcum), state))
        return new_state, o

    xs = (chunks(k), chunks(v), chunks(log_g)) + (() if q is None else (chunks(q),))
    s_fin, o = lax.scan(step, s0, xs)
    if q is None:
        return None, s_fin
    return o.transpose(1, 0, 3, 2, 4).reshape(b, l, nh, v.shape[-1]), s_fin


def hgrn2_mixer(u, u_c, w_in, lb, norm_w, w_out, need_ctx):
    b = u.shape[0]
    n_state = 2 * HG_KEY + HG_VAL

    def split_inputs(t, w):
        bt, lt, _ = t.shape
        proj = t @ w
        f = proj[..., :2 * HG_KEY].astype(jnp.float32).reshape(bt, lt, 2, HG_KEY)
        g = lb + (1.0 - lb) * jax.nn.sigmoid(f)
        log_g = jnp.log(g).reshape(bt, lt, 2, HG_HEADS, HG_EXPAND)
        k = (1.0 - g).astype(t.dtype).reshape(bt, lt, 2, HG_HEADS, HG_EXPAND)
        v = proj[..., 2 * HG_KEY:n_state].reshape(bt, lt, HG_HEADS, HG_HEAD_V)
        return proj[..., n_state:], k, log_g, v

    def query(rest):
        bt, lt = rest.shape[:2]
        return jax.nn.silu(rest[..., :HG_KEY]).reshape(bt, lt, HG_HEADS, HG_EXPAND)

    def bidir(q, k, log_g, v, s_f, s_b):
        o_f, fin_f = hgrn2_chunk_scan(k[:, :, 0], v, log_g[:, :, 0], s_f, q)
        o_b, fin_b = hgrn2_chunk_scan(_flip(k[:, :, 1]), _flip(v), _flip(log_g[:, :, 1]), s_b,
                                      None if q is None else _flip(q))
        o = None if q is None else o_f + _flip(o_b)
        return o, fin_f, fin_b

    def readout(o, rest):
        bt, lt = o.shape[:2]
        o = (_rms(o.astype(u.dtype)) * norm_w.reshape(HG_HEADS, HG_HEAD_V)).reshape(bt, lt, HG_VAL)
        return (o * jax.nn.silu(rest[..., HG_KEY:])) @ w_out

    zero = jnp.zeros((b, HG_HEADS, HG_EXPAND, HG_HEAD_V), jnp.float32)
    rest_c, k_c, lg_c, v_c = split_inputs(u_c, w_in if need_ctx else w_in[:, :n_state])
    o_c, s_f, s_b = bidir(query(rest_c) if need_ctx else None, k_c, lg_c, v_c, zero, zero)
    rest, k, lg, v = split_inputs(u, w_in)
    o, _, _ = bidir(query(rest), k, lg, v, s_f, s_b)
    y = readout(o, rest)
    if not need_ctx:
        return y, None
    return y, readout(o_c, rest_c)


def setup_inputs(seed: int = 0) -> dict:
    key = jax.random.key(seed)
    ks = iter(jax.random.split(key, 32))

    def nrm(shape, scale):
        return jax.random.normal(next(ks), shape, jnp.float32) * scale

    n_a, n_b, n_c = [len(range(m, DEPTH, N_MIXERS)) for m in range(N_MIXERS)]
    d = D_MODEL
    x = nrm((BATCH, SEQ, d), 1.0)
    c = nrm((BATCH, d), 1.0)
    ctx = nrm((BATCH, CTX_LEN, d), 1.0)
    c_ctx = nrm((d,), 1.0)
    ada_w = nrm((DEPTH, d, N_MOD * d), 0.5 * d ** -0.5)
    ada_b = nrm((DEPTH, N_MOD * d), 0.02)
    norm_g = 1.0 + nrm((DEPTH, 4, d), 0.02)
    ffn_w_in = nrm((DEPTH, d, 2 * FFN_DIM), d ** -0.5)
    ffn_w_out = nrm((DEPTH, FFN_DIM, d), FFN_DIM ** -0.5)
    attn_w_in = nrm((n_a, d, ATT_IN), d ** -0.5)
    attn_w_out = nrm((n_a, ATT_Q_DIM, d), ATT_Q_DIM ** -0.5)
    attn_sink = nrm((n_a, ATT_HEADS), 0.5)
    ssd_w_in = nrm((n_b, d, SSD_IN), d ** -0.5)
    ssd_conv_w = nrm((n_b, SSD_CONV_W, SSD_CONV_DIM), SSD_CONV_W ** -0.5)
    ssd_conv_b = nrm((n_b, SSD_CONV_DIM), 0.02)
    dt0 = jnp.exp(jax.random.uniform(next(ks), (n_b, 2, SSD_HEADS), jnp.float32,
                                     minval=math.log(1e-3), maxval=math.log(1e-1)))
    ssd_dt_bias = dt0 + jnp.log(-jnp.expm1(-dt0))
    ssd_a_log = jnp.log(jax.random.uniform(next(ks), (n_b, 2, SSD_HEADS), jnp.float32, minval=1.0, maxval=16.0))
    ssd_d = 1.0 + nrm((n_b, SSD_HEADS), 0.1)
    ssd_norm_w = 1.0 + nrm((n_b, SSD_D_INNER), 0.02)
    ssd_w_out = nrm((n_b, SSD_D_INNER, d), SSD_D_INNER ** -0.5)
    hgrn_w_in = nrm((n_c, d, HG_IN), d ** -0.5)
    hgrn_lb = nrm((2, DEPTH, HG_KEY), 0.1)
    hgrn_norm_w = 1.0 + nrm((n_c, HG_VAL), 0.02)
    hgrn_w_out = nrm((n_c, HG_VAL, d), HG_VAL ** -0.5)
    return {'x': x, 'c': c, 'ctx': ctx, 'c_ctx': c_ctx,
            'ada_w': ada_w, 'ada_b': ada_b, 'norm_g': norm_g,
            'ffn_w_in': ffn_w_in, 'ffn_w_out': ffn_w_out,
            'attn_w_in': attn_w_in, 'attn_w_out': attn_w_out, 'attn_sink': attn_sink,
            'ssd_w_in': ssd_w_in, 'ssd_conv_w': ssd_conv_w, 'ssd_conv_b': ssd_conv_b,
            'ssd_dt_bias': ssd_dt_bias, 'ssd_a_log': ssd_a_log, 'ssd_d': ssd_d,
            'ssd_norm_w': ssd_norm_w, 'ssd_w_out': ssd_w_out,
            'hgrn_w_in': hgrn_w_in, 'hgrn_lb': hgrn_lb, 'hgrn_norm_w': hgrn_norm_w, 'hgrn_w_out': hgrn_w_out}


def reference(x, c, ctx, c_ctx, ada_w, ada_b, norm_g, ffn_w_in, ffn_w_out,
              attn_w_in, attn_w_out, attn_sink,
              ssd_w_in, ssd_conv_w, ssd_conv_b, ssd_dt_bias, ssd_a_log, ssd_d, ssd_norm_w, ssd_w_out,
              hgrn_w_in, hgrn_lb, hgrn_norm_w, hgrn_w_out):
    b = x.shape[0]
    rope_cos, rope_sin = axial_rope_tables(x.shape[1])
    lower_bounds = hgrn2_lower_bounds(hgrn_lb)
    silu_c = jax.nn.silu(c)
    silu_cc = jax.nn.silu(c_ctx)
    h = ctx
    for i in range(DEPTH):
        kind, j = i % N_MIXERS, i // N_MIXERS
        need_ctx = i < DEPTH - 1
        mod = (silu_c @ ada_w[i] + ada_b[i]).reshape(b, N_MOD, 1, D_MODEL)
        mod_c = (silu_cc @ ada_w[i] + ada_b[i]).reshape(N_MOD, D_MODEL)
        u = modulate(x, norm_g[i, 0], mod[:, 0], mod[:, 1])
        u_c = modulate(h, norm_g[i, 0], mod_c[0], mod_c[1])
        if kind == 0:
            y, y_c = attention_mixer(u, u_c, attn_w_in[j], attn_w_out[j], attn_sink[j],
                                     rope_cos, rope_sin, need_ctx)
        elif kind == 1:
            y, y_c = ssd_mixer(u, u_c, ssd_w_in[j], ssd_conv_w[j], ssd_conv_b[j], ssd_dt_bias[j],
                               ssd_a_log[j], ssd_d[j], ssd_norm_w[j], ssd_w_out[j], need_ctx)
        else:
            y, y_c = hgrn2_mixer(u, u_c, hgrn_w_in[j], lower_bounds[:, i], hgrn_norm_w[j],
                                 hgrn_w_out[j], need_ctx)
        x = x + mod[:, 2] * rms_norm(y, norm_g[i, 1])
        f = swiglu(modulate(x, norm_g[i, 2], mod[:, 3], mod[:, 4]), ffn_w_in[i], ffn_w_out[i])
        x = x + mod[:, 5] * rms_norm(f, norm_g[i, 3])
        if need_ctx:
            h = h + mod_c[2] * rms_norm(y_c, norm_g[i, 1])
            f_c = swiglu(modulate(h, norm_g[i, 2], mod_c[3], mod_c[4]), ffn_w_in[i], ffn_w_out[i])
            h = h + mod_c[5] * rms_norm(f_c, norm_g[i, 3])
    return x
```

```cpp
#include <hip/hip_runtime.h>
#include <cstdio>
#include <cstdint>
#include <cmath>
#define MK_ONE_LAUNCH 0
namespace pg8 {
#define PG8_LAS __attribute__((address_space(3)))
typedef unsigned short bf16_t;
typedef short bf16x8 __attribute__((ext_vector_type(8)));
typedef float f32x4 __attribute__((ext_vector_type(4)));
typedef unsigned u32x4 __attribute__((ext_vector_type(4)));
constexpr int BM = 256, BK = 64, HALF = 128, HTB = HALF * BK * 2  , STAGE_BYTES = 8 * HTB, NXCD = 8, WGM = 8;

__host__ __device__ __forceinline__ int lds_byte(int r, int c) { const int st = (r >> 4) * 2 + (c >> 5), rr = r & 15, cc = c & 31, ob = rr * 64 + cc * 2; return st * 1024 + (ob ^ (((ob >> 9) & 1) << 5)); }
__host__ __device__ __forceinline__ void stage_rc(int b, int& R, int& C) { const int st = b / 1024, sb = b % 1024, swz = sb ^ (((sb >> 9) & 1) << 5); R = (st >> 1) * 16 + swz / 64; C = (st & 1) * 32 + (swz % 64) / 2; }
__host__ __device__ __forceinline__ int perm32(int rho) { const int n = rho >> 4, i = rho & 15; return 8 * (i >> 2) + 4 * n + (i & 3); }

struct Unit { int pm, pn; };
struct Gemm { const bf16_t* A; const bf16_t* Bt; int M, N, K; };

struct StaticOrder {
    int nM, nN, nwg, G, c;
    __host__ __device__ void init(int M, int N, int G_, int c_) { nM = M / BM; nN = N / BM; nwg = nM * nN; G = G_; c = c_; }
    __host__ __device__ bool next(int i, Unit& u) const {
        const long L = (long)i * G + c; if (L >= nwg) return false;
        int wgid = (int)L; { const int q = nwg / NXCD, r = nwg % NXCD, xcd = wgid % NXCD, off = wgid / NXCD; wgid = (xcd < r ? xcd * (q + 1) : r * (q + 1) + (xcd - r) * q) + off; }
        const int nig = WGM * nN, gid = wgid / nig, fm = gid * WGM, gsz = (nM - fm) < WGM ? (nM - fm) : WGM;
        u.pm = fm + ((wgid % nig) % gsz); u.pn = (wgid % nig) / gsz; return true;
    }
    __device__ __forceinline__ void a_ready(const Unit&) const {}
    __device__ __forceinline__ void done(const Unit&) const {}
};

__device__ __forceinline__ unsigned cvt_pk_bf16(float lo, float hi) { unsigned r; asm volatile("v_cvt_pk_bf16_f32 %0, %1, %2" : "=v"(r) : "v"(lo), "v"(hi)); return r; }
typedef float f32x2 __attribute__((ext_vector_type(2)));
template <class Epi, class Sched, bool ALIGN_EPI = false, bool SP2 = false>
__device__ __forceinline__ void gemm_phase(PG8_LAS unsigned char* lds, const Gemm g, const Sched& S, const Epi& E, const int wave_id) {
    int lane_; asm volatile("v_mbcnt_lo_u32_b32 %0, -1, 0\n\tv_mbcnt_hi_u32_b32 %0, -1, %0" : "=v"(lane_));
    const int tid_ = wave_id * 64 + lane_;
    const int tid = tid_, wid = __builtin_amdgcn_readfirstlane(tid >> 6), lane = tid & 63, wr = wid >> 2, wc = wid & 3, fr = lane & 15, fq = lane >> 4;
    const int K = g.K, nt = K / BK;
    unsigned voffA[2], voffB[2];
#pragma unroll
    for (int i = 0; i < 2; ++i) { int R, C; stage_rc(tid * 16 + i * 8192, R, C); const int Rb = Epi::PERM ? ((R & ~31) + perm32(R & 31)) : R;
        voffA[i] = (unsigned)(R * K + C) * 2u; voffB[i] = (unsigned)(Rb * K + C) * 2u; }
    const size_t kstep = (size_t)(BK * 2);
    const size_t hstep = (size_t)HALF * K * 2;
    const size_t tstep = 2 * hstep;
    const unsigned ldsw = (unsigned)wid * 1024u;
    const int aoff = lds_byte(wr * 64 + fr, fq * 8), boff = lds_byte(wc * 32 + fr, fq * 8);
#define PG8_SA(b, h) (((b) * 2 + (h)) * HTB)
#define PG8_SB(b, h) ((4 + (b) * 2 + (h)) * HTB)
#define PG8_STAGE(bufoff, gbase, voff) do { _Pragma("unroll") for (int _i = 0; _i < 2; ++_i) \
        __builtin_amdgcn_global_load_lds((const unsigned*)((const char*)(gbase) + (voff)[_i]), (PG8_LAS unsigned*)(lds + (bufoff) + ldsw + _i * 8192), 16, 0, 0); } while (0)
#define PG8_LDA(dst, b, h) do { _Pragma("unroll") for (int m = 0; m < 4; ++m) _Pragma("unroll") for (int k = 0; k < 2; ++k) dst[m][k] = *(const PG8_LAS bf16x8*)(lds + PG8_SA(b, h) + aoff + m * 2048 + k * 1024); } while (0)
#define PG8_LDB(dst, b, h) do { _Pragma("unroll") for (int n = 0; n < 2; ++n) _Pragma("unroll") for (int k = 0; k < 2; ++k) dst[n][k] = *(const PG8_LAS bf16x8*)(lds + PG8_SB(b, h) + boff + n * 2048 + k * 1024); } while (0)
#define PG8_MMA(ai, bj, At, Bt) do { __builtin_amdgcn_s_setprio(1); _Pragma("unroll") for (int m = 0; m < 4; ++m) _Pragma("unroll") for (int n = 0; n < 2; ++n) _Pragma("unroll") for (int k = 0; k < 2; ++k) \
        acc[ai][bj][m][n] = __builtin_amdgcn_mfma_f32_16x16x32_bf16(Bt[n][k], At[m][k], acc[ai][bj][m][n], 0, 0, 0); __builtin_amdgcn_s_setprio(0); } while (0)
#define PG8_WAIT_V(n) asm volatile("s_waitcnt vmcnt(" #n ")" ::: "memory")
#define PG8_WAIT_L(n) asm volatile("s_waitcnt lgkmcnt(" #n ")" ::: "memory")
#define PG8_BAR __builtin_amdgcn_s_barrier()
#define PG8_SCHED __builtin_amdgcn_sched_barrier(0)
    Unit cur, nxt; int ui = 0;
    if (!S.next(0, cur)) return;
    f32x4 acc[2][2][4][2];
#pragma unroll
    for (int a = 0; a < 2; ++a)
#pragma unroll
        for (int b = 0; b < 2; ++b)
#pragma unroll
            for (int m = 0; m < 4; ++m)
#pragma unroll
                for (int n = 0; n < 2; ++n) acc[a][b][m][n] = (f32x4){0.f, 0.f, 0.f, 0.f};
    bf16x8 At[4][2], B0[2][2], B1[2][2];
    const char* cA = (const char*)g.A + (size_t)cur.pm * tstep; const char* cB = (const char*)g.Bt + (size_t)cur.pn * tstep;
    S.a_ready(cur);
    if constexpr (SP2) {
        PG8_STAGE(PG8_SB(0, 0), cB, voffB); PG8_STAGE(PG8_SB(0, 1), cB + hstep, voffB); PG8_STAGE(PG8_SA(0, 0), cA, voffA); PG8_STAGE(PG8_SA(0, 1), cA + hstep, voffA);
        if (wr == 1) PG8_BAR;
        PG8_WAIT_V(2); PG8_BAR;
        PG8_STAGE(PG8_SB(1, 0), cB + kstep, voffB); PG8_STAGE(PG8_SA(1, 0), cA + kstep, voffA); PG8_STAGE(PG8_SB(1, 1), cB + hstep + kstep, voffB);
        PG8_WAIT_V(6); PG8_BAR;
    } else {
        PG8_STAGE(PG8_SB(0, 0), cB, voffB); PG8_STAGE(PG8_SA(0, 0), cA, voffA); PG8_STAGE(PG8_SB(0, 1), cB + hstep, voffB); PG8_STAGE(PG8_SA(0, 1), cA + hstep, voffA);
        if (wr == 1) PG8_BAR;
        PG8_WAIT_V(4); PG8_BAR;
        PG8_STAGE(PG8_SB(1, 0), cB + kstep, voffB); PG8_STAGE(PG8_SA(1, 0), cA + kstep, voffA); PG8_STAGE(PG8_SB(1, 1), cB + hstep + kstep, voffB);
        PG8_WAIT_V(6); PG8_BAR;
    }
    for (;;) {
        const bool has_next = S.next(ui + 1, nxt);
        const char* nA = has_next ? (const char*)g.A + (size_t)nxt.pm * tstep : cA; const char* nB = has_next ? (const char*)g.Bt + (size_t)nxt.pn * tstep : cB;
        for (int t = 0; t < nt; t += 2) {
            const bool last = (t == nt - 2);
            const char* a1 = cA + (size_t)(t + 1) * kstep;
            const char* a2 = last ? nA : cA + (size_t)(t + 2) * kstep; const char* b2 = last ? nB : cB + (size_t)(t + 2) * kstep;
            const char* a3 = a2 + kstep; const char* b3 = b2 + kstep;
            if (last && has_next) S.a_ready(nxt);
            if constexpr (SP2) {
            PG8_LDB(B0, 0, 0); PG8_LDB(B1, 0, 1); PG8_SCHED; PG8_LDA(At, 0, 0); PG8_STAGE(PG8_SA(1, 1), a1 + hstep, voffA);
            PG8_WAIT_V(8); PG8_WAIT_L(0); PG8_BAR; PG8_MMA(0, 0, At, B0); PG8_MMA(0, 1, At, B1); PG8_BAR; PG8_SCHED;
            PG8_LDA(At, 0, 1); PG8_STAGE(PG8_SB(0, 0), b2, voffB); PG8_STAGE(PG8_SB(0, 1), b2 + hstep, voffB); PG8_STAGE(PG8_SA(0, 0), a2, voffA);
            PG8_WAIT_V(8); PG8_WAIT_L(0); PG8_BAR; PG8_MMA(1, 0, At, B0); PG8_MMA(1, 1, At, B1); PG8_BAR; PG8_SCHED;
            PG8_LDB(B0, 1, 0); PG8_LDB(B1, 1, 1); PG8_SCHED; PG8_LDA(At, 1, 0); PG8_STAGE(PG8_SA(0, 1), a2 + hstep, voffA);
            PG8_WAIT_V(8); PG8_WAIT_L(0); PG8_BAR; PG8_MMA(0, 0, At, B0); PG8_MMA(0, 1, At, B1); PG8_BAR; PG8_SCHED;
            PG8_LDA(At, 1, 1); PG8_STAGE(PG8_SB(1, 0), b3, voffB); PG8_STAGE(PG8_SB(1, 1), b3 + hstep, voffB); PG8_STAGE(PG8_SA(1, 0), a3, voffA);
            PG8_WAIT_V(8); PG8_WAIT_L(0); PG8_BAR; PG8_MMA(1, 0, At, B0); PG8_MMA(1, 1, At, B1); PG8_BAR; PG8_SCHED;
            } else {
            PG8_LDB(B0, 0, 0); PG8_SCHED; PG8_LDA(At, 0, 0); PG8_STAGE(PG8_SA(1, 1), a1 + hstep, voffA);
            PG8_WAIT_L(8); PG8_BAR; PG8_WAIT_L(0); PG8_MMA(0, 0, At, B0); PG8_BAR; PG8_SCHED;
            PG8_LDB(B1, 0, 1); PG8_STAGE(PG8_SB(0, 0), b2, voffB);
            PG8_BAR; PG8_WAIT_L(0); PG8_MMA(0, 1, At, B1); PG8_BAR;
            PG8_LDA(At, 0, 1); PG8_STAGE(PG8_SA(0, 0), a2, voffA);
            PG8_BAR; PG8_WAIT_L(0); PG8_MMA(1, 0, At, B0); PG8_BAR; PG8_SCHED;
            PG8_STAGE(PG8_SB(0, 1), b2 + hstep, voffB);
            PG8_WAIT_V(6); PG8_BAR; PG8_MMA(1, 1, At, B1); PG8_BAR;
            PG8_LDB(B0, 1, 0); PG8_SCHED; PG8_LDA(At, 1, 0); PG8_STAGE(PG8_SA(0, 1), a2 + hstep, voffA);
            PG8_WAIT_L(8); PG8_BAR; PG8_WAIT_L(0); PG8_MMA(0, 0, At, B0); PG8_BAR; PG8_SCHED;
            PG8_LDB(B1, 1, 1); PG8_STAGE(PG8_SB(1, 0), b3, voffB);
            PG8_BAR; PG8_WAIT_L(0); PG8_MMA(0, 1, At, B1); PG8_BAR;
            PG8_LDA(At, 1, 1); PG8_STAGE(PG8_SA(1, 0), a3, voffA);
            PG8_BAR; PG8_WAIT_L(0); PG8_MMA(1, 0, At, B0); PG8_BAR; PG8_SCHED;
            PG8_STAGE(PG8_SB(1, 1), b3 + hstep, voffB);
            PG8_WAIT_V(6); PG8_BAR; PG8_MMA(1, 1, At, B1); PG8_BAR;
            }
        }
        if constexpr (ALIGN_EPI) { if (wr == 0) PG8_BAR; }
        if constexpr (!Epi::AFTER_DRAIN) { E(acc, cur, wr, wc, fr, fq); S.done(cur); }
        if (!has_next) break;
#pragma unroll
        for (int a = 0; a < 2; ++a)
#pragma unroll
            for (int b = 0; b < 2; ++b)
#pragma unroll
                for (int m = 0; m < 4; ++m)
#pragma unroll
                    for (int n = 0; n < 2; ++n) acc[a][b][m][n] = (f32x4){0.f, 0.f, 0.f, 0.f};
        cur = nxt; cA = nA; cB = nB; ++ui;
        if constexpr (ALIGN_EPI) { if (wr == 1) PG8_BAR; }
    }
    PG8_WAIT_V(0);
    if constexpr (!ALIGN_EPI) { if (wr == 0) PG8_BAR; }
    PG8_BAR;
    if constexpr (Epi::AFTER_DRAIN) { E.fused(acc, cur, wr, wc, fr, fq, lds, wid, lane); S.done(cur); }
#undef PG8_SA
#undef PG8_SB
#undef PG8_STAGE
#undef PG8_LDA
#undef PG8_LDB
#undef PG8_MMA
#undef PG8_WAIT_V
#undef PG8_WAIT_L
#undef PG8_BAR
#undef PG8_SCHED
}
}
#define GAS __attribute__((address_space(1)))
#define LAS __attribute__((address_space(3)))
typedef unsigned short bf16;
typedef unsigned v4u __attribute__((ext_vector_type(4)));
typedef float f32x4 __attribute__((ext_vector_type(4)));
typedef short bf16x8 __attribute__((ext_vector_type(8)));
typedef GAS unsigned gu32;
typedef GAS unsigned long long gu64;
#define RLX_AGENT __ATOMIC_RELAXED, __HIP_MEMORY_SCOPE_AGENT
#define LDS_WAIT() asm volatile("s_waitcnt lgkmcnt(0)" ::: "memory")
#define VM_WAIT() asm volatile("s_waitcnt vmcnt(0)" ::: "memory")
__device__ __forceinline__ unsigned long long rt() { return __builtin_amdgcn_s_memrealtime(); }
__device__ __forceinline__ unsigned f2bf(float f) { unsigned u = __builtin_bit_cast(unsigned, f); return (u + 0x7fffu + ((u >> 16) & 1u)) >> 16; }
__device__ __forceinline__ unsigned pk2(float lo, float hi) { return f2bf(lo) | (f2bf(hi) << 16); }

#define XB_TMO      128
#define XB_XCNT(j)  (256  + 64 * (j))
#define XB_XSUB(j)  (1280 + 64 * (j))
#define XB_XGEN(j)  (2304 + 64 * (j))
#define XB_TOP      3328
#define XB_TOPGEN   3392
#define XCD_BAR_WORDS 3456
#define XB_SPIN_CAP (1u << 18)

__device__ __forceinline__ unsigned xb_ld(unsigned* p)              { return __hip_atomic_load(p, __ATOMIC_RELAXED, __HIP_MEMORY_SCOPE_AGENT); }
__device__ __forceinline__ unsigned xb_add(unsigned* p, unsigned v) { return __hip_atomic_fetch_add(p, v, __ATOMIC_RELAXED, __HIP_MEMORY_SCOPE_AGENT); }
__device__ __forceinline__ unsigned xb_xcc_id() { return (unsigned)__builtin_amdgcn_s_getreg((3 << 11) | 20) & 0xFu; }
#define XB_SPIN(cond, bar) do { unsigned _sp = 0; while (cond) { __builtin_amdgcn_s_sleep(1); \
    if ((++_sp & 255u) == 0u) { if (xb_ld(&(bar)[XB_TMO])) break; if (_sp > XB_SPIN_CAP) { atomicAdd(&(bar)[XB_TMO], 1u); break; } } } } while (0)

struct XcdBarrier {
    unsigned* bar; unsigned x;
    volatile LAS unsigned* st;
};

__device__ __forceinline__ XcdBarrier xcd_barrier_post(unsigned* bar, volatile LAS unsigned* st) {
    XcdBarrier b; b.bar = bar; b.x = xb_xcc_id(); b.st = st;
    if (threadIdx.x == 0) (void)xb_add(&bar[XB_XCNT(b.x)], 1u);
    return b;
}
__device__ __forceinline__ void xcd_barrier_complete(unsigned* bar, unsigned x, unsigned& nloc, unsigned& nx) {
    const unsigned G = gridDim.x * gridDim.y * gridDim.z;
    unsigned sum, cnt, mine, sp = 0u;
    for (;;) {
        sum = 0u; cnt = 0u; mine = 0u;
#pragma unroll
        for (unsigned j = 0; j < 16; ++j) { const unsigned c = xb_ld(&bar[XB_XCNT(j)]); sum += c; cnt += (c > 0u) ? 1u : 0u; mine = (j == x) ? c : mine; }
        if (sum == G) break;
        __builtin_amdgcn_s_sleep(1);
        if ((++sp & 255u) == 0u) { if (xb_ld(&bar[XB_TMO])) break; if (sp > XB_SPIN_CAP) { atomicAdd(&bar[XB_TMO], 1u); break; } }
    }
    nloc = mine > 0u ? mine : 1u; nx = cnt > 0u ? cnt : 1u;
}

__device__ __forceinline__ void xcd_barrier(const XcdBarrier& b) {
    asm volatile("s_waitcnt vmcnt(0)" ::: "memory");
    __syncthreads();
    if (threadIdx.x == 0) {
        unsigned* bar = b.bar;
        __builtin_amdgcn_s_waitcnt(0);
        unsigned nloc = b.st[0], nx = b.st[1];
        if (nloc == 0u) { xcd_barrier_complete(bar, b.x, nloc, nx); b.st[0] = nloc; b.st[1] = nx; }
        const unsigned old = xb_add(&bar[XB_XSUB(b.x)], 1u);
        const unsigned gen = old / nloc;
        if (old + 1u == (gen + 1u) * nloc) {
            __builtin_amdgcn_fence(__ATOMIC_RELEASE, "agent");
            asm volatile("s_waitcnt vmcnt(0)" ::: "memory");
            const unsigned og = xb_add(&bar[XB_TOP], 1u);
            const unsigned tg = og / nx;
            if (og + 1u == (tg + 1u) * nx) xb_add(&bar[XB_TOPGEN], 1u);
            else XB_SPIN(xb_ld(&bar[XB_TOPGEN]) == tg, bar);
            __builtin_amdgcn_fence(__ATOMIC_ACQUIRE, "agent");
            xb_add(&bar[XB_XGEN(b.x)], 1u);
            asm volatile("s_waitcnt vmcnt(0)" ::: "memory");
        } else {
            XB_SPIN(xb_ld(&bar[XB_XGEN(b.x)]) == gen, bar);
            __builtin_amdgcn_fence(__ATOMIC_ACQUIRE, "agent");
            asm volatile("s_waitcnt vmcnt(0)" ::: "memory");
        }
    }
    __syncthreads();
}

#define DI __device__ __forceinline__
constexpr int NWAVES = 8;
constexpr int D = 2048, NB = 16, SEQ = 2048, CTXL = 256, DEPTH = 4;
constexpr int TLAT = NB * SEQ, TCTX = NB * CTXL, TT = TLAT + TCTX;
constexpr int FFN = 5632, NMODC = 6 * D;
constexpr int ATT_IN = 2560;
constexpr int SSD_DI = 4096, SSD_CONV = 6144, SSD_INP = 10496  , SSD_INS = 10368;
constexpr int HG_IN = 10240;
constexpr float RMS_EPS = 1e-6f, LOG2E = 1.4426950408889634f;
constexpr float QSCALE = 0.125f * LOG2E;
typedef float f32x16 __attribute__((ext_vector_type(16)));
typedef float f32x2v __attribute__((ext_vector_type(2)));
typedef unsigned u32x2 __attribute__((ext_vector_type(2)));
typedef short s16x4 __attribute__((ext_vector_type(4)));

constexpr size_t MiB = 1u << 20;
constexpr size_t WS_CTL = 0, CTL_ZERO_BYTES = 1 * MiB;
constexpr size_t WS_MODP = 1 * MiB;
constexpr size_t WS_MOD = 28 * MiB;
constexpr size_t WS_TAB = 32 * MiB;
constexpr size_t WS_H = 33 * MiB;
constexpr size_t WS_W = 65 * MiB;
constexpr size_t W_FFN_IN = (size_t)2 * FFN * D * 2, W_FFN_OUT = (size_t)D * FFN * 2;
constexpr size_t WS_WFFN = WS_W;
constexpr size_t W_ATT_IN = (size_t)ATT_IN * D * 2, W_ATT_OUT = (size_t)D * D * 2;
constexpr size_t WS_WATT = WS_WFFN + 4 * (W_FFN_IN + W_FFN_OUT);
constexpr size_t W_SSD_IN = (size_t)SSD_INP * D * 2, W_SSD_OUT = (size_t)D * SSD_DI * 2;
constexpr size_t WS_WSSD = WS_WATT + 2 * (W_ATT_IN + W_ATT_OUT);
constexpr size_t W_HG_IN = (size_t)HG_IN * D * 2, W_HG_OUT = (size_t)D * D * 2;
constexpr size_t WS_WHG = WS_WSSD + W_SSD_IN + W_SSD_OUT;
constexpr size_t WS_WEND = WS_WHG + W_HG_IN + W_HG_OUT;
constexpr size_t WS_U2 = 470 * MiB;
constexpr size_t WS_BIG = 758 * MiB;
constexpr size_t WS_END = 1496 * MiB;
static_assert(WS_WEND <= WS_U2, "weights fit");
constexpr size_t A_KB = WS_BIG;
constexpr size_t A_QB = A_KB + (size_t)TT * 256 * 2;
constexpr size_t A_VTL = A_QB + (size_t)TT * D * 2;
constexpr size_t A_VTC = A_VTL + (size_t)NB * 4 * 64 * SEQ * 2;
constexpr size_t A_O = A_VTC + (size_t)NB * 4 * 64 * CTXL * 2;
constexpr size_t A_Y = A_O + (size_t)TT * D * 2;
static_assert(A_Y + (size_t)TT * D * 4 <= WS_END, "attn map");
constexpr size_t S_XBC = WS_BIG;
constexpr size_t S_Z = S_XBC + (size_t)TT * SSD_CONV * 2;
constexpr size_t S_DT = S_Z + (size_t)TT * SSD_DI * 2;
static_assert(S_DT + (size_t)TT * 128 * 4 <= WS_END, "ssd map");
constexpr size_t H_LG = WS_BIG;
constexpr size_t H_V = H_LG + (size_t)2 * TT * D * 2;
constexpr size_t H_Q = H_V + (size_t)TT * D * 2;
constexpr size_t H_OG = H_Q + (size_t)TT * D * 2;
static_assert(H_OG + (size_t)TT * D * 2 <= WS_END, "hgrn map");
constexpr size_t F_H = WS_BIG;
constexpr size_t F_Y = F_H + (size_t)TT * FFN * 2;
static_assert(F_Y + (size_t)TT * D * 4 <= WS_END, "ffn map");
constexpr int CW_BAR = 4096;

constexpr int RING_BYTES = 131072;
constexpr int LDSCTL_OFF = RING_BYTES, MISC_OFF = LDSCTL_OFF + 320;
constexpr int LDS_BYTES = 147456;

typedef __bf16 bf16x2_t __attribute__((ext_vector_type(2)));
DI unsigned cvtpk(float lo, float hi) { f32x2v v = {lo, hi}; bf16x2_t b = __builtin_convertvector(v, bf16x2_t); return __builtin_bit_cast(unsigned, b); }
DI int lane_id() { int l; asm volatile("v_mbcnt_lo_u32_b32 %0, -1, 0\n\tv_mbcnt_hi_u32_b32 %0, -1, %0" : "=v"(l)); return l; }
DI float bf2f(unsigned short b) { return __uint_as_float((unsigned)b << 16); }
DI float bflo(unsigned w) { return __uint_as_float(w << 16); }
DI float bfhi(unsigned w) { return __uint_as_float(w & 0xffff0000u); }
DI unsigned short f2bf16(float f) { return (unsigned short)(cvtpk(f, 0.f) & 0xffffu); }
DI unsigned pkh(float lo, float hi) { return (unsigned)__builtin_bit_cast(unsigned short, (_Float16)lo) | ((unsigned)__builtin_bit_cast(unsigned short, (_Float16)hi) << 16); }
DI float silu_f(float x) { return x * __builtin_amdgcn_rcpf(1.f + __builtin_amdgcn_exp2f(-x * LOG2E)); }
DI float wave_sum(float v) {
#pragma unroll
    for (int o = 1; o < 64; o <<= 1) v += __shfl_xor(v, o);
    return v;
}
DI int crow(int r, int h) { return (r & 3) + 8 * (r >> 2) + 4 * h; }
DI f32x16 mfma32(bf16x8 a, bf16x8 b, f32x16 c) { return __builtin_amdgcn_mfma_f32_32x32x16_bf16(a, b, c, 0, 0, 0); }
DI bf16x8 lds_frag(LAS unsigned char* p) { return *(LAS bf16x8*)p; }
DI float swap_max(float m) { auto rr = __builtin_amdgcn_permlane32_swap(__float_as_uint(m), __float_as_uint(m), false, false); return fmaxf(__uint_as_float(rr[0]), __uint_as_float(rr[1])); }
DI float swap_sum(float m) { auto rr = __builtin_amdgcn_permlane32_swap(__float_as_uint(m), __float_as_uint(m), false, false); return __uint_as_float(rr[0]) + __uint_as_float(rr[1]); }
DI bf16x8 pack8(const f32x16& x, int s) {
    v4u p; p.x = cvtpk(x[8 * s], x[8 * s + 1]); p.y = cvtpk(x[8 * s + 2], x[8 * s + 3]);
    p.z = cvtpk(x[8 * s + 4], x[8 * s + 5]); p.w = cvtpk(x[8 * s + 6], x[8 * s + 7]);
    return __builtin_bit_cast(bf16x8, p);
}

using pg8::Unit; using pg8::HALF; using pg8::BM;
struct EpiF32 {
    static constexpr bool PERM = false, AFTER_DRAIN = false;
    float* C; int ldc;
    DI void operator()(const f32x4 (&acc)[2][2][4][2], const Unit& u, int wr, int wc, int fr, int fq) const {
        const int row0 = u.pm * BM + wr * 64 + fr, col0 = u.pn * BM + wc * 32 + 4 * fq;
#pragma unroll
        for (int ai = 0; ai < 2; ++ai)
#pragma unroll
            for (int m = 0; m < 4; ++m) { float* rowp = C + (size_t)(row0 + ai * HALF + m * 16) * ldc + col0;
#pragma unroll
                for (int bj = 0; bj < 2; ++bj)
#pragma unroll
                    for (int n = 0; n < 2; ++n) *(f32x4*)(rowp + bj * HALF + n * 16) = acc[ai][bj][m][n]; }
    }
};
struct EpiSwiglu {
    static constexpr bool PERM = true, AFTER_DRAIN = false;
    bf16* H;
    DI void operator()(const f32x4 (&acc)[2][2][4][2], const Unit& u, int wr, int wc, int fr, int fq) const {
        const int row0 = u.pm * BM + wr * 64 + fr, col0 = u.pn * 128 + wc * 32 + 8 * fq;
#pragma unroll
        for (int ai = 0; ai < 2; ++ai)
#pragma unroll
            for (int m = 0; m < 4; ++m) {
                float o[8];
#pragma unroll
                for (int n = 0; n < 2; ++n)
#pragma unroll
                    for (int j = 0; j < 4; ++j) o[4 * n + j] = silu_f(acc[ai][0][m][n][j]) * acc[ai][1][m][n][j];
                v4u w; w.x = cvtpk(o[0], o[1]); w.y = cvtpk(o[2], o[3]); w.z = cvtpk(o[4], o[5]); w.w = cvtpk(o[6], o[7]);
                *(v4u*)(H + (size_t)(row0 + ai * HALF + m * 16) * FFN + col0) = w; }
    }
};
struct EpiAttn {
    static constexpr bool PERM = false, AFTER_DRAIN = false;
    bf16* Kb; bf16* Qb; bf16* VtL; bf16* VtC; const float* rope;
    DI void operator()(const f32x4 (&acc)[2][2][4][2], const Unit& u, int wr, int wc, int fr, int fq) const {
        const int pn = u.pn;
#pragma unroll
        for (int ai = 0; ai < 2; ++ai)
#pragma unroll
            for (int m = 0; m < 4; ++m) {
                const int row = u.pm * BM + ai * HALF + wr * 64 + m * 16 + fr;
                const bool lat = u.pm < TLAT / BM; const int s = row & 2047;
                if (pn == 1) {
                    bf16* base; size_t pitch;
                    if (lat) { base = VtL + (size_t)(row >> 11) * (4 * 64 * SEQ) + s; pitch = SEQ; }
                    else { const int rc = row - TLAT; base = VtC + (size_t)(rc >> 8) * (4 * 64 * CTXL) + (rc & 255); pitch = CTXL; }
#pragma unroll
                    for (int bj = 0; bj < 2; ++bj)
#pragma unroll
                        for (int n = 0; n < 2; ++n)
#pragma unroll
                            for (int j = 0; j < 4; ++j) { const int col = 128 * bj + 32 * wc + 16 * n + 4 * fq + j; base[(size_t)col * pitch] = f2bf16(acc[ai][bj][m][n][j]); }
                } else {
                    const int pos = (wc & 1) ? (s & 63) : (s >> 6);
                    const f32x4* rp = (const f32x4*)(rope + (pos * 16 + 4 * fq) * 2);
                    const f32x4 c01 = rp[0], c23 = rp[1];
                    const float cs[4] = {c01[0], c01[2], c23[0], c23[2]}, sn[4] = {c01[1], c01[3], c23[1], c23[3]};
#pragma unroll
                    for (int bj = 0; bj < 2; ++bj) {
                        const f32x4 t1 = acc[ai][bj][m][0], t2 = acc[ai][bj][m][1]; float o1[4], o2[4];
#pragma unroll
                        for (int j = 0; j < 4; ++j) { o1[j] = lat ? t1[j] * cs[j] - t2[j] * sn[j] : t1[j]; o2[j] = lat ? t2[j] * cs[j] + t1[j] * sn[j] : t2[j]; }
                        bf16* dst; float sc;
                        if (pn == 0) { dst = Kb + (size_t)row * 256 + 128 * bj + 32 * wc + 4 * fq; sc = 1.f; }
                        else { dst = Qb + (size_t)row * D + (pn - 2) * 256 + 128 * bj + 32 * wc + 4 * fq; sc = QSCALE; }
                        u32x2 w1, w2; w1.x = cvtpk(o1[0] * sc, o1[1] * sc); w1.y = cvtpk(o1[2] * sc, o1[3] * sc);
                        w2.x = cvtpk(o2[0] * sc, o2[1] * sc); w2.y = cvtpk(o2[2] * sc, o2[3] * sc);
                        *(u32x2*)dst = w1; *(u32x2*)(dst + 16) = w2;
                    }
                }
                asm volatile("" ::: "memory");
            }
    }
};
struct EpiSsd {
    static constexpr bool PERM = true, AFTER_DRAIN = false;
    bf16* XBC; bf16* Z; float* DT; const float* dt_bias;
    DI void operator()(const f32x4 (&acc)[2][2][4][2], const Unit& u, int wr, int wc, int fr, int fq) const {
        const int pn = u.pn, row0 = u.pm * BM + wr * 64 + fr, cl = wc * 32 + 8 * fq;
        if (pn < 40) {
            bf16* base; int ldc;
            if (pn < 24) { base = XBC + pn * 256; ldc = SSD_CONV; } else { base = Z + (pn - 24) * 256; ldc = SSD_DI; }
#pragma unroll
            for (int ai = 0; ai < 2; ++ai)
#pragma unroll
                for (int m = 0; m < 4; ++m) { bf16* rowp = base + (size_t)(row0 + ai * HALF + m * 16) * ldc + cl;
#pragma unroll
                    for (int bj = 0; bj < 2; ++bj) { const f32x4 v0 = acc[ai][bj][m][0], v1 = acc[ai][bj][m][1]; v4u w;
                        w.x = cvtpk(v0[0], v0[1]); w.y = cvtpk(v0[2], v0[3]); w.z = cvtpk(v1[0], v1[1]); w.w = cvtpk(v1[2], v1[3]);
                        *(v4u*)(rowp + bj * HALF) = w; }
                    asm volatile("" ::: "memory"); }
        } else {
            const f32x4 b0 = *(const f32x4*)(dt_bias + cl), b1 = *(const f32x4*)(dt_bias + cl + 4);
#pragma unroll
            for (int ai = 0; ai < 2; ++ai)
#pragma unroll
                for (int m = 0; m < 4; ++m) { float* rowp = DT + (size_t)(row0 + ai * HALF + m * 16) * 128 + cl;
#pragma unroll
                    for (int n = 0; n < 2; ++n) { f32x4 v = acc[ai][0][m][n] + (n ? b1 : b0), o;
#pragma unroll
                        for (int j = 0; j < 4; ++j) { const float x = v[j]; o[j] = fmaxf(x, 0.f) + log1pf(__expf(-fabsf(x))); }
                        *(f32x4*)(rowp + 4 * n) = o; }
                    asm volatile("" ::: "memory"); }
        }
    }
};
struct EpiHgrn {
    static constexpr bool PERM = true, AFTER_DRAIN = false;
    _Float16* LG; bf16* VQG; const float* lbv;
    DI void operator()(const f32x4 (&acc)[2][2][4][2], const Unit& u, int wr, int wc, int fr, int fq) const {
        const int pn = u.pn, row0 = u.pm * BM + wr * 64 + fr, cl = wc * 32 + 8 * fq;
        if (pn < 16) {
            const int dir = pn >> 3, cb = (pn & 7) * 256;
#pragma unroll
            for (int bj = 0; bj < 2; ++bj) {
                const f32x4 l0 = *(const f32x4*)(lbv + dir * D + cb + bj * HALF + cl), l1 = *(const f32x4*)(lbv + dir * D + cb + bj * HALF + cl + 4);
#pragma unroll
                for (int ai = 0; ai < 2; ++ai)
#pragma unroll
                    for (int m = 0; m < 4; ++m) { float o[8];
#pragma unroll
                        for (int n = 0; n < 2; ++n)
#pragma unroll
                            for (int j = 0; j < 4; ++j) { const float f = acc[ai][bj][m][n][j], lb = n ? l1[j] : l0[j];
                                const float sg = __builtin_amdgcn_rcpf(1.f + __builtin_amdgcn_exp2f(-f * LOG2E)); const float g = lb + (1.f - lb) * sg;
                                o[4 * n + j] = __builtin_amdgcn_logf(g) * 0.6931471805599453f; }
                        v4u w; w.x = pkh(o[0], o[1]); w.y = pkh(o[2], o[3]); w.z = pkh(o[4], o[5]); w.w = pkh(o[6], o[7]);
                        *(v4u*)(LG + ((size_t)dir * TT + row0 + ai * HALF + m * 16) * D + cb + bj * HALF + cl) = w;
                        asm volatile("" ::: "memory"); }
            }
        } else {
            const int t = (pn - 16) >> 3, cb = (pn & 7) * 256; bf16* base = VQG + (size_t)t * TT * D + cb;
#pragma unroll
            for (int ai = 0; ai < 2; ++ai)
#pragma unroll
                for (int m = 0; m < 4; ++m) { bf16* rowp = base + (size_t)(row0 + ai * HALF + m * 16) * D + cl;
#pragma unroll
                    for (int bj = 0; bj < 2; ++bj) { f32x4 v0 = acc[ai][bj][m][0], v1 = acc[ai][bj][m][1];
                        if (t == 1) {
#pragma unroll
                            for (int j = 0; j < 4; ++j) { v0[j] = silu_f(v0[j]); v1[j] = silu_f(v1[j]); } }
                        v4u w; w.x = cvtpk(v0[0], v0[1]); w.y = cvtpk(v0[2], v0[3]); w.z = cvtpk(v1[0], v1[1]); w.w = cvtpk(v1[2], v1[3]);
                        *(v4u*)(rowp + bj * HALF) = w; }
                    asm volatile("" ::: "memory"); }
        }
    }
};

struct Frame {
    LAS unsigned char* lds;
    volatile LAS unsigned* MISC;
    gu32* ctl;
    int wave, G, gw, NGW;
};

DI void mod_partial_phase(const Frame& F, const float* c, const float* cctx, const float* ada_w, float* modp) {
    const int lane = lane_id();
    for (int it = F.gw; it < 4 * 48 * 8; it += F.NGW) {
        const int ks = it & 7, cb = (it >> 3) % 48, l = it / (8 * 48);
        f32x4 acc[17];
#pragma unroll
        for (int b = 0; b < 17; ++b) acc[b] = (f32x4){0.f, 0.f, 0.f, 0.f};
        const float* W = ada_w + (size_t)l * D * NMODC + cb * 256 + lane * 4;
        for (int kb = 0; kb < 4; ++kb) {
            const int k0 = ks * 256 + kb * 64;
            float sv[17];
#pragma unroll
            for (int b = 0; b < 16; ++b) { const float x = c[b * D + k0 + lane]; sv[b] = x / (1.f + __expf(-x)); }
            { const float x = cctx[k0 + lane]; sv[16] = x / (1.f + __expf(-x)); }
            for (int jj = 0; jj < 64; jj += 8) {
                f32x4 w[8];
#pragma unroll
                for (int q = 0; q < 8; ++q) w[q] = *(const f32x4*)(W + (size_t)(k0 + jj + q) * NMODC);
#pragma unroll
                for (int q = 0; q < 8; ++q)
#pragma unroll
                    for (int b = 0; b < 17; ++b) { const float s = __int_as_float(__builtin_amdgcn_readlane(__float_as_int(sv[b]), jj + q)); acc[b] += w[q] * s; }
            }
        }
#pragma unroll
        for (int b = 0; b < 17; ++b) *(f32x4*)(modp + (((size_t)ks * 4 + l) * 17 + b) * NMODC + cb * 256 + lane * 4) = acc[b];
    }
}

DI int srcmap(int kind, int n) {
    if (kind == 0) return n;
    if (kind == 1) { const int t = n >> 8, w = n & 255; return w < 128 ? 128 * t + w : FFN + 128 * t + (w - 128); }
    if (n < SSD_CONV) return n;
    if (n < SSD_CONV + SSD_DI) return n + 128;
    if (n < SSD_INS) return n - SSD_DI;
    return -1;
}
DI void conv_item(const float* W, int K, int Nsrc, int Ndst, bf16* WT, int kind, LAS float* scr, int item, int lane) {
    const int nblk = Ndst / 32, kb = item / nblk, nb = item % nblk, k0 = 64 * kb, n0 = 32 * nb, s0 = srcmap(kind, n0);
#pragma unroll 8
    for (int i = 0; i < 32; ++i) { const int kk = 2 * i + (lane >> 5); scr[kk * 33 + (lane & 31)] = s0 >= 0 ? W[(size_t)(k0 + kk) * Nsrc + s0 + (lane & 31)] : 0.f; }
    LDS_WAIT(); asm volatile("" ::: "memory");
    const int c = lane & 7;
#pragma unroll
    for (int j = 0; j < 4; ++j) { const int n = (lane >> 3) + 8 * j; const LAS float* s = scr + (8 * c) * 33 + n;
        v4u o; o.x = pk2(s[0 * 33], s[1 * 33]); o.y = pk2(s[2 * 33], s[3 * 33]); o.z = pk2(s[4 * 33], s[5 * 33]); o.w = pk2(s[6 * 33], s[7 * 33]);
        *(GAS v4u*)(WT + (size_t)(n0 + n) * K + k0 + 8 * c) = o; }
    LDS_WAIT(); asm volatile("" ::: "memory");
}
template <int OFF> DI const float* inp_load() { const float* p; asm volatile("s_load_dwordx2 %0, %1, %2\n\ts_waitcnt lgkmcnt(0)" : "=s"(p) : "s"(__builtin_amdgcn_kernarg_segment_ptr()), "n"(OFF)); return p; }
#define INP(k) inp_load<(k) * 8>()
DI void prologue_phase(const Frame& F, unsigned char* ws) {
    LAS float* scr = (LAS float*)(F.lds + F.wave * 16384);
    const int lane = lane_id(); const int gt = F.gw * 64 + lane, NGT = F.NGW * 64;
    { const float* modp = (const float*)(ws + WS_MODP); float* mod = (float*)(ws + WS_MOD); const float* ada_b = INP(5);
      for (int i = gt; i < 4 * 17 * NMODC / 4; i += NGT) {
          const int e = i * 4, l = e / (17 * NMODC), n = e % NMODC;
          f32x4 s = *(const f32x4*)(ada_b + l * NMODC + n);
#pragma unroll
          for (int ks = 0; ks < 8; ++ks) s += *(const f32x4*)(modp + (size_t)ks * 4 * 17 * NMODC + e);
          *(f32x4*)(mod + e) = s; } }
    { float* tab = (float*)(ws + WS_TAB);
      if (gt < 1024) { const int pos = gt >> 4, p = gt & 15; const float invf = powf(10000.f, -(float)p / 16.f); const float ang = (float)pos * invf; tab[2 * gt] = cosf(ang); tab[2 * gt + 1] = sinf(ang); }
      float* lbv = (float*)(ws + WS_TAB + 16384); const float* lbr = INP(21);
      if (gt < 2 * D) { const int dir = gt >> 11, d = gt & 2047; float v[4], mx = -1e30f;
#pragma unroll
          for (int l = 0; l < 4; ++l) { v[l] = lbr[(dir * 4 + l) * D + d]; mx = fmaxf(mx, v[l]); }
          float e[4], sum = 0.f;
#pragma unroll
          for (int l = 0; l < 4; ++l) { e[l] = expf(v[l] - mx); sum += e[l]; }
          lbv[gt] = (e[1] + e[2]) / sum; } }
    { const f32x4* src = (const f32x4*)INP(2); f32x4* dst = (f32x4*)(ws + WS_H);
      for (int i = gt; i < TCTX * D / 4; i += NGT) dst[i] = src[i]; }
    constexpr int I_FI = (D / 64) * (2 * FFN / 32), I_FO = (FFN / 64) * (D / 32), I_AI = (D / 64) * (ATT_IN / 32), I_AO = (D / 64) * (D / 32);
    constexpr int I_SI = (D / 64) * (SSD_INP / 32), I_SO = (SSD_DI / 64) * (D / 32), I_HI = (D / 64) * (HG_IN / 32), I_HO = I_AO;
    constexpr int NITEMS = 4 * (I_FI + I_FO) + 2 * (I_AI + I_AO) + I_SI + I_SO + I_HI + I_HO;
    for (int it = F.gw; it < NITEMS; it += F.NGW) {
        int r = it;
        if (r < 4 * (I_FI + I_FO)) { const int l = r / (I_FI + I_FO); r -= l * (I_FI + I_FO); bf16* wb = (bf16*)(ws + WS_WFFN + (size_t)l * (W_FFN_IN + W_FFN_OUT));
            if (r < I_FI) conv_item(INP(7) + (size_t)l * D * 2 * FFN, D, 2 * FFN, 2 * FFN, wb, 1, scr, r, lane);
            else conv_item(INP(8) + (size_t)l * FFN * D, FFN, D, D, (bf16*)((unsigned char*)wb + W_FFN_IN), 0, scr, r - I_FI, lane);
            continue; }
        r -= 4 * (I_FI + I_FO);
        if (r < 2 * (I_AI + I_AO)) { const int j = r / (I_AI + I_AO); r -= j * (I_AI + I_AO); bf16* wb = (bf16*)(ws + WS_WATT + (size_t)j * (W_ATT_IN + W_ATT_OUT));
            if (r < I_AI) conv_item(INP(9) + (size_t)j * D * ATT_IN, D, ATT_IN, ATT_IN, wb, 0, scr, r, lane);
            else conv_item(INP(10) + (size_t)j * D * D, D, D, D, (bf16*)((unsigned char*)wb + W_ATT_IN), 0, scr, r - I_AI, lane);
            continue; }
        r -= 2 * (I_AI + I_AO);
        if (r < I_SI) { conv_item(INP(12), D, SSD_INS, SSD_INP, (bf16*)(ws + WS_WSSD), 2, scr, r, lane); continue; } r -= I_SI;
        if (r < I_SO) { conv_item(INP(19), SSD_DI, D, D, (bf16*)(ws + WS_WSSD + W_SSD_IN), 0, scr, r, lane); continue; } r -= I_SO;
        if (r < I_HI) { conv_item(INP(20), D, HG_IN, HG_IN, (bf16*)(ws + WS_WHG), 0, scr, r, lane); continue; } r -= I_HI;
        conv_item(INP(23), D, D, D, (bf16*)(ws + WS_WHG + W_HG_IN), 0, scr, r, lane);
    }
}

template <bool HAS_Y, bool HAS_U>
DI void norm_phase(const Frame& F, int nrows, const float* y, const float* xs_lat, const float* xs_ctx, float* xd_lat, float* xd_ctx,
                   const float* mod_a, int gate_idx, const float* gpost, const float* mod_b, int shift_idx, const float* gpre, bf16* u) {
    const int lane = lane_id();
    for (int it = F.gw; it < nrows / 8; it += F.NGW) {
        const int r0 = it * 8, mb = r0 < TLAT ? (r0 >> 11) : 16;
        f32x4 GG[8], AA[8], SH[8];
#pragma unroll
        for (int k = 0; k < 8; ++k) { const int col = 4 * lane + 256 * k;
            if (HAS_Y) GG[k] = *(const f32x4*)(mod_a + (size_t)mb * NMODC + gate_idx * D + col) * *(const f32x4*)(gpost + col);
            if (HAS_U) { AA[k] = *(const f32x4*)(gpre + col) * (*(const f32x4*)(mod_b + (size_t)mb * NMODC + (shift_idx + 1) * D + col) + 1.f);
                         SH[k] = *(const f32x4*)(mod_b + (size_t)mb * NMODC + shift_idx * D + col); } }
        for (int rr = 0; rr < 8; ++rr) {
            const int row = r0 + rr; const bool lat = row < TLAT;
            const float* xs = lat ? xs_lat + (size_t)row * D : xs_ctx + (size_t)(row - TLAT) * D;
            f32x4 x[8];
#pragma unroll
            for (int k = 0; k < 8; ++k) x[k] = *(const f32x4*)(xs + 4 * lane + 256 * k);
            if (HAS_Y) {
                f32x4 yv[8]; float ss = 0.f;
#pragma unroll
                for (int k = 0; k < 8; ++k) { yv[k] = *(const f32x4*)(y + (size_t)row * D + 4 * lane + 256 * k); ss += (yv[k][0] * yv[k][0] + yv[k][1] * yv[k][1]) + (yv[k][2] * yv[k][2] + yv[k][3] * yv[k][3]); }
                const float rs = 1.f / sqrtf(wave_sum(ss) * (1.f / D) + RMS_EPS);
                float* xd = lat ? xd_lat + (size_t)row * D : xd_ctx + (size_t)(row - TLAT) * D;
#pragma unroll
                for (int k = 0; k < 8; ++k) { x[k] += GG[k] * yv[k] * rs; *(f32x4*)(xd + 4 * lane + 256 * k) = x[k]; }
            }
            if (HAS_U) {
                float ss = 0.f;
#pragma unroll
                for (int k = 0; k < 8; ++k) ss += (x[k][0] * x[k][0] + x[k][1] * x[k][1]) + (x[k][2] * x[k][2] + x[k][3] * x[k][3]);
                const float rs = 1.f / sqrtf(wave_sum(ss) * (1.f / D) + RMS_EPS);
#pragma unroll
                for (int k = 0; k < 8; ++k) { const f32x4 o = x[k] * rs * AA[k] + SH[k]; u32x2 w; w.x = cvtpk(o[0], o[1]); w.y = cvtpk(o[2], o[3]);
                    *(u32x2*)(u + (size_t)row * D + 4 * lane + 256 * k) = w; }
            }
        }
    }
}

constexpr int AT_KP = 144, AT_VP = 648, AT_LV = 320 * AT_KP;
DI void attn_phase(const Frame& F, const bf16* Kb, const bf16* Qb, const bf16* VtL, const bf16* VtC, const float* sink, bf16* O, bool need_ctx) {
    const int lane0 = lane_id(), wid = F.wave;
    LAS unsigned char* ldsK = F.lds; LAS unsigned char* ldsV = F.lds + AT_LV;
    const int nunits = need_ctx ? 2304 : 2048;
    for (int un = blockIdx.x; un < nunits; un += F.G) {
        int lane = lane0; asm volatile("" : "+v"(lane));
        const int tid = wid * 64 + lane, r32 = lane & 31, h = lane >> 5;
        const bool cq = un >= 2048; int b, qblk, kvh;
        if (!cq) { kvh = un & 3; qblk = (un >> 2) & 31; b = un >> 7; } else { const int v = un - 2048; kvh = v & 3; qblk = (v >> 2) & 3; b = v >> 4; }
        const int q0 = qblk * 64, hq = kvh * 8 + wid;
        const size_t qrow0 = cq ? (size_t)(TLAT + b * CTXL + q0) : (size_t)(b * SEQ + q0);
        bf16x8 qf[2][4];
#pragma unroll
        for (int rb = 0; rb < 2; ++rb)
#pragma unroll
            for (int d0 = 0; d0 < 4; ++d0) qf[rb][d0] = *(const bf16x8*)(Qb + (qrow0 + 32 * rb + r32) * D + hq * 64 + 16 * d0 + 8 * h);
        const float sk = sink[hq] * LOG2E;
        float m_[2], l_[2]; f32x16 o[2][2];
#pragma unroll
        for (int rb = 0; rb < 2; ++rb) { m_[rb] = sk; l_[rb] = h == 0 ? 1.f : 0.f;
#pragma unroll
            for (int db = 0; db < 2; ++db)
#pragma unroll
                for (int i = 0; i < 16; ++i) o[rb][db][i] = 0.f; }
        for (int pass = cq ? 1 : 0; pass < 2; ++pass) {
            __syncthreads();
            if (pass == 0) {
                for (int idx = tid; idx < 2560; idx += 512) { const int row = idx >> 3, part = idx & 7, s = q0 - 128 + row; v4u v = (v4u){0u, 0u, 0u, 0u};
                    if (s >= 0 && s < SEQ) v = *(const v4u*)(Kb + (size_t)(b * SEQ + s) * 256 + kvh * 64 + part * 8);
                    *(LAS v4u*)(ldsK + row * AT_KP + part * 16) = v; }
                for (int idx = tid; idx < 2560; idx += 512) { const int d = idx / 40, part = idx % 40, s0 = q0 - 128 + part * 8; v4u v = (v4u){0u, 0u, 0u, 0u};
                    if (s0 >= 0 && s0 < SEQ) v = *(const v4u*)(VtL + ((size_t)((b * 4 + kvh) * 64 + d)) * SEQ + s0);
                    *(LAS u32x2*)(ldsV + d * AT_VP + part * 16) = (u32x2){v.x, v.y}; *(LAS u32x2*)(ldsV + d * AT_VP + part * 16 + 8) = (u32x2){v.z, v.w}; }
            } else {
                for (int idx = tid; idx < 2048; idx += 512) { const int row = idx >> 3, part = idx & 7;
                    const v4u v = *(const v4u*)(Kb + (size_t)(TLAT + b * CTXL + row) * 256 + kvh * 64 + part * 8);
                    *(LAS v4u*)(ldsK + row * AT_KP + part * 16) = v; }
                for (int idx = tid; idx < 2048; idx += 512) { const int d = idx >> 5, part = idx & 31;
                    const v4u v = *(const v4u*)(VtC + ((size_t)((b * 4 + kvh) * 64 + d)) * CTXL + part * 8);
                    *(LAS u32x2*)(ldsV + d * AT_VP + part * 16) = (u32x2){v.x, v.y}; *(LAS u32x2*)(ldsV + d * AT_VP + part * 16 + 8) = (u32x2){v.z, v.w}; }
            }
            __syncthreads();
#pragma unroll
            for (int rb = 0; rb < 2; ++rb) {
                const int ntile = pass == 0 ? 9 : 8, kt0 = pass == 0 ? rb : 0;
                const int r = 32 * rb + r32;
                const int lo = max(r, 128 - q0), hi = min(r + 256, 2047 + 128 - q0);
                for (int t = 0; t < ntile; ++t) {
                    const int kt = kt0 + t;
                    f32x16 p;
#pragma unroll
                    for (int i = 0; i < 16; ++i) p[i] = 0.f;
#pragma unroll
                    for (int d0 = 0; d0 < 4; ++d0) p = mfma32(lds_frag(ldsK + (32 * kt + r32) * AT_KP + 32 * d0 + 16 * h), qf[rb][d0], p);
                    if (pass == 0) {
#pragma unroll
                        for (int i = 0; i < 16; ++i) { const int c = 32 * kt + crow(i, h); if (c < lo || c > hi) p[i] = -INFINITY; }
                    }
                    float tm = p[0];
#pragma unroll
                    for (int i = 1; i < 16; ++i) tm = fmaxf(tm, p[i]);
                    tm = swap_max(tm);
                    const float mn = fmaxf(m_[rb], tm), alpha = __builtin_amdgcn_exp2f(m_[rb] - mn);
                    m_[rb] = mn; float ls = 0.f;
#pragma unroll
                    for (int i = 0; i < 16; ++i) { p[i] = __builtin_amdgcn_exp2f(p[i] - mn); ls += p[i]; }
                    l_[rb] = l_[rb] * alpha + ls;
#pragma unroll
                    for (int db = 0; db < 2; ++db)
#pragma unroll
                        for (int i = 0; i < 16; ++i) o[rb][db][i] *= alpha;
                    const bf16x8 pf0 = pack8(p, 0), pf1 = pack8(p, 1);
#pragma unroll
                    for (int db = 0; db < 2; ++db) {
#pragma unroll
                        for (int s = 0; s < 2; ++s) {
                            LAS unsigned char* vp = ldsV + (32 * db + r32) * AT_VP + (32 * kt + 16 * s + 4 * h) * 2;
                            const s16x4 vlo = *(LAS s16x4*)vp, vhi = *(LAS s16x4*)(vp + 16);
                            const bf16x8 vf = (bf16x8){vlo[0], vlo[1], vlo[2], vlo[3], vhi[0], vhi[1], vhi[2], vhi[3]};
                            o[rb][db] = mfma32(vf, s == 0 ? pf0 : pf1, o[rb][db]);
                        }
                    }
                }
            }
        }
#pragma unroll
        for (int rb = 0; rb < 2; ++rb) {
            const float inv = 1.f / swap_sum(l_[rb]);
            bf16* orow = O + (qrow0 + 32 * rb + r32) * D + hq * 64;
#pragma unroll
            for (int db = 0; db < 2; ++db)
#pragma unroll
                for (int g4 = 0; g4 < 4; ++g4) { u32x2 w; w.x = cvtpk(o[rb][db][4 * g4] * inv, o[rb][db][4 * g4 + 1] * inv); w.y = cvtpk(o[rb][db][4 * g4 + 2] * inv, o[rb][db][4 * g4 + 3] * inv);
                    *(u32x2*)(orow + 32 * db + 8 * g4 + 4 * h) = w; }
        }
    }
    __syncthreads();
}

DI void ssd_conv_phase(const Frame& F, bf16* XBC, const float* cw, const float* cb) {
    const int lane = lane_id();
    for (int it = F.gw; it < 32 * 48; it += F.NGW) {
        const int seq = it / 48, col = (it % 48) * 128 + lane * 2;
        const int L = seq < 16 ? SEQ : CTXL; const size_t rowbase = seq < 16 ? (size_t)seq * SEQ : (size_t)TLAT + (size_t)(seq - 16) * CTXL;
        const f32x2v w0 = *(const f32x2v*)(cw + col), w1 = *(const f32x2v*)(cw + SSD_CONV + col), w2 = *(const f32x2v*)(cw + 2 * SSD_CONV + col), bb = *(const f32x2v*)(cb + col);
        unsigned* base = (unsigned*)(XBC + rowbase * SSD_CONV + col);
        unsigned prev = 0u;
        for (int t0 = 0; t0 < L; t0 += 32) {
            unsigned raw[33];
#pragma unroll
            for (int i = 0; i < 32; ++i) raw[i] = base[(size_t)(t0 + i) * (SSD_CONV / 2)];
            raw[32] = (t0 + 32 < L) ? base[(size_t)(t0 + 32) * (SSD_CONV / 2)] : 0u;
#pragma unroll
            for (int i = 0; i < 32; ++i) {
                const unsigned a = i == 0 ? prev : raw[i - 1], b = raw[i], c = raw[i + 1];
                const float o0 = bb.x + w0.x * bflo(a) + w1.x * bflo(b) + w2.x * bflo(c);
                const float o1 = bb.y + w0.y * bfhi(a) + w1.y * bfhi(b) + w2.y * bfhi(c);
                base[(size_t)(t0 + i) * (SSD_CONV / 2)] = cvtpk(silu_f(o0), silu_f(o1));
            }
            prev = raw[31];
        }
    }
}

constexpr int SL_XT = 0, SL_XD = 9216, SL_BM = 18432, SL_BT = 35840, SL_CM = 54272, SL_MM = 71680, SL_SL = 80896, SL_AC = 98304, SL_EA = 98560;
DI void ssd_scan_phase(const Frame& F, const bf16* XBC, const float* DT, const float* a_log, bf16* Y) {
    const int lane0 = lane_id(), wid = F.wave, tid0 = wid * 64 + lane0;
    LAS unsigned char* L = F.lds;
    for (int un = blockIdx.x; un < NB * 64; un += F.G) {
        const int b = un >> 6, hd = un & 63, grp = hd >> 3;
#ifndef SSD_DIRS
#define SSD_DIRS 2
#endif
        for (int dir = 0; dir < SSD_DIRS; ++dir) {
            const float a = -__expf(a_log[dir * 64 + hd]);
            __syncthreads();
            for (int i = tid0; i < 64 * 272 / 4; i += 512) ((LAS unsigned*)(L + SL_SL))[i] = 0u;
            f32x16 sacc[2];
#pragma unroll
            for (int pt = 0; pt < 2; ++pt)
#pragma unroll
                for (int i = 0; i < 16; ++i) sacc[pt][i] = 0.f;
            for (int step = 0; step < 36; ++step) {
                int lane = lane0; asm volatile("" : "+v"(lane));
                const int tid = wid * 64 + lane, r32 = lane & 31, h = lane >> 5;
                size_t rowbase;
                if (dir == 0) rowbase = step < 4 ? (size_t)(TLAT + b * CTXL + 64 * step) : (size_t)(b * SEQ + 64 * (step - 4));
                else rowbase = step < 4 ? (size_t)(TLAT + b * CTXL + 64 * (3 - step)) : (size_t)(b * SEQ + 64 * (35 - step));
                const float dtv = DT[(rowbase + (dir ? 63 - lane : lane)) * 128 + dir * 64 + hd];
                float ac = dtv * a;
#pragma unroll
                for (int off = 1; off < 64; off <<= 1) { const float t = __shfl_up(ac, off); if (lane >= off) ac += t; }
                const float tot = __int_as_float(__builtin_amdgcn_readlane(__float_as_int(ac), 63));
                __syncthreads();
                if (wid == 0) { ((LAS float*)(L + SL_AC))[lane] = ac; ((LAS float*)(L + SL_EA))[lane] = __expf(ac); }
                {
                    unsigned xt[4], xd[4];
#pragma unroll
                    for (int jj = 0; jj < 8; jj += 2) {
                        float v[2], w[2];
#pragma unroll
                        for (int e = 0; e < 2; ++e) { const int j = 8 * wid + jj + e, tj = dir ? 63 - j : j;
                            const float xv = bf2f(XBC[(rowbase + tj) * SSD_CONV + hd * 64 + lane]);
                            const float dj = __int_as_float(__builtin_amdgcn_readlane(__float_as_int(dtv), j)), aj = __int_as_float(__builtin_amdgcn_readlane(__float_as_int(ac), j));
                            v[e] = xv * dj; w[e] = v[e] * __expf(tot - aj); }
                        xt[jj >> 1] = cvtpk(v[0], v[1]); xd[jj >> 1] = cvtpk(w[0], w[1]);
                    }
                    *(LAS v4u*)(L + SL_XT + lane * 144 + wid * 16) = (v4u){xt[0], xt[1], xt[2], xt[3]};
                    *(LAS v4u*)(L + SL_XD + lane * 144 + wid * 16) = (v4u){xd[0], xd[1], xd[2], xd[3]};
                }
                {
                    const int n = tid & 127, jq = tid >> 7; unsigned pk[8];
#pragma unroll
                    for (int jj = 0; jj < 16; jj += 2) { unsigned short v[2];
#pragma unroll
                        for (int e = 0; e < 2; ++e) { const int j = 16 * jq + jj + e, tj = dir ? 63 - j : j; v[e] = XBC[(rowbase + tj) * SSD_CONV + SSD_DI + grp * 128 + n];
                            *(LAS unsigned short*)(L + SL_BM + j * 272 + n * 2) = v[e]; }
                        pk[jj >> 1] = (unsigned)v[0] | ((unsigned)v[1] << 16); }
                    *(LAS v4u*)(L + SL_BT + n * 144 + jq * 32) = (v4u){pk[0], pk[1], pk[2], pk[3]};
                    *(LAS v4u*)(L + SL_BT + n * 144 + jq * 32 + 16) = (v4u){pk[4], pk[5], pk[6], pk[7]};
                }
#pragma unroll
                for (int q = 0; q < 2; ++q) { const int idx = tid + 512 * q, j = idx >> 4, part = idx & 15, tj = dir ? 63 - j : j;
                    *(LAS v4u*)(L + SL_CM + j * 272 + part * 16) = *(const v4u*)(XBC + (rowbase + tj) * SSD_CONV + SSD_DI + 1024 + grp * 128 + part * 8); }
                __syncthreads();
                f32x16 yacc;
                if (wid >= 4) {
                    const int w4 = wid - 4, jt = w4 >> 1, it = w4 & 1, i = 32 * it + r32;
                    f32x16 g;
#pragma unroll
                    for (int q = 0; q < 16; ++q) g[q] = 0.f;
                    if (jt <= it) {
#pragma unroll
                        for (int ks = 0; ks < 8; ++ks) g = mfma32(lds_frag(L + SL_BM + (32 * jt + r32) * 272 + 32 * ks + 16 * h), lds_frag(L + SL_CM + i * 272 + 32 * ks + 16 * h), g);
                        const float ai = ((LAS float*)(L + SL_AC))[i];
#pragma unroll
                        for (int q = 0; q < 16; ++q) { const int j = 32 * jt + crow(q, h); const float aj = ((LAS float*)(L + SL_AC))[j]; g[q] = j <= i ? g[q] * __expf(ai - aj) : 0.f; }
                    }
#pragma unroll
                    for (int g4 = 0; g4 < 4; ++g4) { u32x2 w; w.x = cvtpk(g[4 * g4], g[4 * g4 + 1]); w.y = cvtpk(g[4 * g4 + 2], g[4 * g4 + 3]);
                        *(LAS u32x2*)(L + SL_MM + i * 144 + (32 * jt + 8 * g4 + 4 * h) * 2) = w; }
                } else {
                    const int it = wid >> 1, pt = wid & 1;
#pragma unroll
                    for (int q = 0; q < 16; ++q) yacc[q] = 0.f;
#pragma unroll
                    for (int ks = 0; ks < 8; ++ks) yacc = mfma32(lds_frag(L + SL_CM + (32 * it + r32) * 272 + 32 * ks + 16 * h), lds_frag(L + SL_SL + (32 * pt + r32) * 272 + 32 * ks + 16 * h), yacc);
#pragma unroll
                    for (int q = 0; q < 16; ++q) yacc[q] *= ((LAS float*)(L + SL_EA))[32 * it + crow(q, h)];
                }
                __syncthreads();
                if (wid < 4) {
                    const int it = wid >> 1, pt = wid & 1;
#pragma unroll
                    for (int ks = 0; ks < 4; ++ks) yacc = mfma32(lds_frag(L + SL_MM + (32 * it + r32) * 144 + 32 * ks + 16 * h), lds_frag(L + SL_XT + (32 * pt + r32) * 144 + 32 * ks + 16 * h), yacc);
#pragma unroll
                    for (int q = 0; q < 16; ++q) { const int i = 32 * it + crow(q, h), ti = dir ? 63 - i : i;
                        bf16* yp = Y + (rowbase + ti) * SSD_DI + hd * 64 + 32 * pt + r32; float v = yacc[q];
                        if (dir) v += bf2f(*yp);
                        *yp = f2bf16(v); }
                } else {
                    const int w4 = wid - 4; const float cd = __expf(tot);
#pragma unroll
                    for (int pt = 0; pt < 2; ++pt) {
#pragma unroll
                        for (int q = 0; q < 16; ++q) sacc[pt][q] *= cd;
#pragma unroll
                        for (int ks = 0; ks < 4; ++ks) sacc[pt] = mfma32(lds_frag(L + SL_BT + (32 * w4 + r32) * 144 + 32 * ks + 16 * h), lds_frag(L + SL_XD + (32 * pt + r32) * 144 + 32 * ks + 16 * h), sacc[pt]);
#pragma unroll
                        for (int g4 = 0; g4 < 4; ++g4) { u32x2 w; w.x = cvtpk(sacc[pt][4 * g4], sacc[pt][4 * g4 + 1]); w.y = cvtpk(sacc[pt][4 * g4 + 2], sacc[pt][4 * g4 + 3]);
                            *(LAS u32x2*)(L + SL_SL + (32 * pt + r32) * 272 + (32 * w4 + 8 * g4 + 4 * h) * 2) = w; }
                    }
                }
            }
            asm volatile("s_waitcnt vmcnt(0)" ::: "memory");
        }
    }
    __syncthreads();
}

DI void ssd_fin_phase(const Frame& F, bf16* Y, const bf16* XBC, const bf16* Z, const float* dsk, const float* nw) {
    const int lane = lane_id();
    for (int row = F.gw; row < TT; row += F.NGW) {
#pragma unroll 2
        for (int k = 0; k < 8; ++k) {
            const int col = 512 * k + 8 * lane;
            const v4u yv = *(const v4u*)(Y + (size_t)row * SSD_DI + col), xv = *(const v4u*)(XBC + (size_t)row * SSD_CONV + col), zv = *(const v4u*)(Z + (size_t)row * SSD_DI + col);
            const float dd = dsk[col >> 6]; float t[8]; float ss = 0.f;
#pragma unroll
            for (int e = 0; e < 4; ++e) { const unsigned yw = yv[e], xw = xv[e], zw = zv[e];
                t[2 * e] = (bflo(yw) + dd * bflo(xw)) * silu_f(bflo(zw)); t[2 * e + 1] = (bfhi(yw) + dd * bfhi(xw)) * silu_f(bfhi(zw));
                ss += t[2 * e] * t[2 * e] + t[2 * e + 1] * t[2 * e + 1]; }
            const float rs = 1.f / sqrtf(wave_sum(ss) * (1.f / 512.f) + RMS_EPS);
            const f32x4 n0 = *(const f32x4*)(nw + col), n1 = *(const f32x4*)(nw + col + 4);
            v4u o; o.x = cvtpk(t[0] * rs * n0[0], t[1] * rs * n0[1]); o.y = cvtpk(t[2] * rs * n0[2], t[3] * rs * n0[3]);
            o.z = cvtpk(t[4] * rs * n1[0], t[5] * rs * n1[1]); o.w = cvtpk(t[6] * rs * n1[2], t[7] * rs * n1[3]);
            *(v4u*)(Y + (size_t)row * SSD_DI + col) = o;
        }
    }
}

constexpr int HL_QT = 0, HL_KT = 17408, HL_KD = 34816, HL_VT = 53248, HL_AM = 71680, HL_ST = 80896, HL_EG = 115712, HL_TOT = 116224;
DI void hgrn_scan_phase(const Frame& F, const _Float16* LG, const bf16* V, const bf16* Q, float* O) {
    const int lane0 = lane_id(), wid = F.wave, tid0 = wid * 64 + lane0;
    LAS unsigned char* L = F.lds;
    for (int un = blockIdx.x; un < NB * 16; un += F.G) {
        const int b = un >> 4, hd = un & 15;
        for (int dir = 0; dir < 2; ++dir) {
            __syncthreads();
            for (int i = tid0; i < 128 * 272 / 4; i += 512) ((LAS unsigned*)(L + HL_ST))[i] = 0u;
            f32x16 sacc[2];
#pragma unroll
            for (int q = 0; q < 2; ++q)
#pragma unroll
                for (int i = 0; i < 16; ++i) sacc[q][i] = 0.f;
            const _Float16* LGd = LG + (size_t)dir * TT * D;
            for (int step = 0; step < 36; ++step) {
                size_t rowbase;
                if (dir == 0) rowbase = step < 4 ? (size_t)(TLAT + b * CTXL + 64 * step) : (size_t)(b * SEQ + 64 * (step - 4));
                else rowbase = step < 4 ? (size_t)(TLAT + b * CTXL + 64 * (3 - step)) : (size_t)(b * SEQ + 64 * (35 - step));
                int lane = lane0; asm volatile("" : "+v"(lane));
                const int tid = wid * 64 + lane, r32 = lane & 31, h = lane >> 5;
                const int d = tid & 127, part = tid >> 7;
                __syncthreads();
                {
                    unsigned pk[8];
#pragma unroll
                    for (int e = 0; e < 16; e += 2) { const int i0 = 16 * part + e, t0 = dir ? 63 - i0 : i0, t1 = dir ? 62 - i0 : i0 + 1;
                        pk[e >> 1] = (unsigned)V[(rowbase + t0) * D + hd * 128 + d] | ((unsigned)V[(rowbase + t1) * D + hd * 128 + d] << 16); }
                    *(LAS v4u*)(L + HL_VT + d * 144 + part * 32) = (v4u){pk[0], pk[1], pk[2], pk[3]};
                    *(LAS v4u*)(L + HL_VT + d * 144 + part * 32 + 16) = (v4u){pk[4], pk[5], pk[6], pk[7]};
                }
                float gc[16];
                { float run = 0.f;
#pragma unroll
                  for (int e = 0; e < 16; ++e) { const int i = 16 * part + e, ti = dir ? 63 - i : i; run += (float)LGd[(rowbase + ti) * D + hd * 128 + d]; gc[e] = run; }
                  ((LAS float*)(L + HL_TOT))[part * 128 + d] = run; }
                __syncthreads();
                {
                    const float t0 = ((LAS float*)(L + HL_TOT))[d], t1 = ((LAS float*)(L + HL_TOT))[128 + d], t2 = ((LAS float*)(L + HL_TOT))[256 + d], t3 = ((LAS float*)(L + HL_TOT))[384 + d];
                    const float pre = part == 0 ? 0.f : (part == 1 ? t0 : (part == 2 ? t0 + t1 : t0 + t1 + t2)), gtot = (t0 + t1) + (t2 + t3);
                    if (part == 0) ((LAS float*)(L + HL_EG))[d] = __expf(gtot);
                    unsigned pk[8];
#pragma unroll
                    for (int e = 0; e < 16; e += 2) { float kd2[2];
#pragma unroll
                        for (int q = 0; q < 2; ++q) { const int i = 16 * part + e + q, ti = dir ? 63 - i : i; const float g = gc[e + q] + pre, lgv = (e + q) ? gc[e + q] - gc[e + q - 1] : gc[0], kk = 1.f - __expf(lgv);
                            const float qv = bf2f(Q[(rowbase + ti) * D + hd * 128 + d]);
                            *(LAS unsigned short*)(L + HL_QT + i * 272 + d * 2) = f2bf16(qv * __expf(g));
                            *(LAS unsigned short*)(L + HL_KT + i * 272 + d * 2) = f2bf16(kk * __expf(-g));
                            kd2[q] = kk * __expf(gtot - g); }
                        pk[e >> 1] = cvtpk(kd2[0], kd2[1]);
                        asm volatile("" ::: "memory"); }
                    *(LAS v4u*)(L + HL_KD + d * 144 + part * 32) = (v4u){pk[0], pk[1], pk[2], pk[3]};
                    *(LAS v4u*)(L + HL_KD + d * 144 + part * 32 + 16) = (v4u){pk[4], pk[5], pk[6], pk[7]};
                }
                __syncthreads();
                const int it = wid >> 2, vt = wid & 3;
                f32x16 oacc;
#pragma unroll
                for (int q = 0; q < 16; ++q) oacc[q] = 0.f;
                if (wid < 4) {
                    const int jt = wid >> 1, it2 = wid & 1, i = 32 * it2 + r32;
                    f32x16 g;
#pragma unroll
                    for (int q = 0; q < 16; ++q) g[q] = 0.f;
                    if (jt <= it2) {
#pragma unroll
                        for (int ks = 0; ks < 8; ++ks) g = mfma32(lds_frag(L + HL_KT + (32 * jt + r32) * 272 + 32 * ks + 16 * h), lds_frag(L + HL_QT + i * 272 + 32 * ks + 16 * h), g);
#pragma unroll
                        for (int q = 0; q < 16; ++q) { const int j = 32 * jt + crow(q, h); if (j > i) g[q] = 0.f; }
                    }
#pragma unroll
                    for (int g4 = 0; g4 < 4; ++g4) { u32x2 w; w.x = cvtpk(g[4 * g4], g[4 * g4 + 1]); w.y = cvtpk(g[4 * g4 + 2], g[4 * g4 + 3]);
                        *(LAS u32x2*)(L + HL_AM + i * 144 + (32 * jt + 8 * g4 + 4 * h) * 2) = w; }
                }
#pragma unroll
                for (int ks = 0; ks < 8; ++ks) oacc = mfma32(lds_frag(L + HL_QT + (32 * it + r32) * 272 + 32 * ks + 16 * h), lds_frag(L + HL_ST + (32 * vt + r32) * 272 + 32 * ks + 16 * h), oacc);
                __syncthreads();
#pragma unroll
                for (int ks = 0; ks < 4; ++ks) oacc = mfma32(lds_frag(L + HL_AM + (32 * it + r32) * 144 + 32 * ks + 16 * h), lds_frag(L + HL_VT + (32 * vt + r32) * 144 + 32 * ks + 16 * h), oacc);
#pragma unroll
                for (int q = 0; q < 16; ++q) { const int i = 32 * it + crow(q, h), ti = dir ? 63 - i : i;
                    float* op = O + (rowbase + ti) * D + hd * 128 + 32 * vt + r32; float v = oacc[q];
                    if (dir) v += *op;
                    *op = v; }
#pragma unroll
                for (int q = 0; q < 2; ++q) { const int dt = 2 * (wid >> 2) + q;
#pragma unroll
                    for (int g4 = 0; g4 < 4; ++g4) { const f32x4 eg = *(LAS f32x4*)(L + HL_EG + (32 * dt + 8 * g4 + 4 * h) * 4);
#pragma unroll
                        for (int e = 0; e < 4; ++e) sacc[q][4 * g4 + e] *= eg[e]; }
#pragma unroll
                    for (int ks = 0; ks < 4; ++ks) sacc[q] = mfma32(lds_frag(L + HL_KD + (32 * dt + r32) * 144 + 32 * ks + 16 * h), lds_frag(L + HL_VT + (32 * vt + r32) * 144 + 32 * ks + 16 * h), sacc[q]);
#pragma unroll
                    for (int g4 = 0; g4 < 4; ++g4) { u32x2 w; w.x = cvtpk(sacc[q][4 * g4], sacc[q][4 * g4 + 1]); w.y = cvtpk(sacc[q][4 * g4 + 2], sacc[q][4 * g4 + 3]);
                        *(LAS u32x2*)(L + HL_ST + (32 * vt + r32) * 272 + (32 * dt + 8 * g4 + 4 * h) * 2) = w; }
                }
            }
            asm volatile("s_waitcnt vmcnt(0)" ::: "memory");
        }
    }
    __syncthreads();
}

DI void hgrn_fin_phase(const Frame& F, const float* O, const bf16* OG, const float* nw, bf16* Gp) {
    const int lane = lane_id();
    for (int row = F.gw; row < TT; row += F.NGW) {
#pragma unroll 2
        for (int k = 0; k < 8; ++k) {
            const int col = 256 * k + 4 * lane;
            const f32x4 ov = *(const f32x4*)(O + (size_t)row * D + col); const u32x2 gv = *(const u32x2*)(OG + (size_t)row * D + col); const f32x4 nv = *(const f32x4*)(nw + col);
            float ss = (ov[0] * ov[0] + ov[1] * ov[1]) + (ov[2] * ov[2] + ov[3] * ov[3]);
#pragma unroll
            for (int o = 1; o < 32; o <<= 1) ss += __shfl_xor(ss, o);
            const float rs = 1.f / sqrtf(ss * (1.f / 128.f) + RMS_EPS);
            u32x2 w; w.x = cvtpk(ov[0] * rs * nv[0] * silu_f(bflo(gv.x)), ov[1] * rs * nv[1] * silu_f(bfhi(gv.x)));
            w.y = cvtpk(ov[2] * rs * nv[2] * silu_f(bflo(gv.y)), ov[3] * rs * nv[3] * silu_f(bfhi(gv.y)));
            *(u32x2*)(Gp + (size_t)row * D + col) = w;
        }
    }
}

#ifndef EN_MODP
#define EN_MODP 1
#endif
#ifndef EN_PRO
#define EN_PRO 1
#endif
#ifndef EN_NORM
#define EN_NORM 1
#endif
#ifndef EN_G1
#define EN_G1 1
#endif
#ifndef EN_ATT
#define EN_ATT 1
#endif
#ifndef EN_CONV
#define EN_CONV 1
#endif
#ifndef EN_HSCAN
#define EN_HSCAN 1
#endif
#ifndef EN_SSCAN
#define EN_SSCAN 1
#endif
#ifndef EN_FIN
#define EN_FIN 1
#endif
#ifndef EN_G2
#define EN_G2 1
#endif
#ifndef EN_G3
#define EN_G3 1
#endif
#ifndef EN_G4
#define EN_G4 1
#endif
#ifndef EN_G1A
#define EN_G1A 1
#endif
#ifndef EN_G1S
#define EN_G1S 1
#endif
#ifndef EN_G1H
#define EN_G1H 1
#endif
#ifndef MK_ONE_LAUNCH
#define MK_ONE_LAUNCH 1
#endif
#ifndef MK_LAYERS
#define MK_LAYERS 4
#endif
constexpr int PH_MODP = 0, PH_PRO = 1, PH_N0 = 2, PH_L0 = 3, PH_PER = 9, PH_END = PH_L0 + PH_PER * DEPTH;
struct Args { const float* in[24]; float* out; unsigned char* ws; int lo, hi; };
static_assert(sizeof(Args) == 26 * 8 + 8, "no padding");

__global__ void __launch_bounds__(NWAVES * 64, 2) trunk_fwd(Args args) {
    extern __shared__ __attribute__((aligned(16))) unsigned char lds_raw[];
    Frame F;
    F.lds = (LAS unsigned char*)lds_raw;
    F.MISC = (volatile LAS unsigned*)(F.lds + MISC_OFF);
    F.wave = __builtin_amdgcn_readfirstlane((int)threadIdx.x >> 6);
    F.G = gridDim.x; F.gw = blockIdx.x * NWAVES + F.wave; F.NGW = F.G * NWAVES;
    unsigned char* ws = args.ws;
    F.ctl = (gu32*)(ws + WS_CTL);
    for (int u = threadIdx.x; u < (LDS_BYTES - LDSCTL_OFF) / 4; u += NWAVES * 64) ((LAS unsigned*)(F.lds + LDSCTL_OFF))[u] = 0u;
    __syncthreads();
    XcdBarrier bar = xcd_barrier_post((unsigned*)(F.ctl + CW_BAR), F.MISC + 8);
    const int lo = args.lo, hi = args.hi;
#define IN(k) (lo <= (k) && (k) < hi)
#define SEAM(k) do { if ((k) + 1 < hi) xcd_barrier(bar); } while (0)
    float* out = args.out;
    float* hres = (float*)(ws + WS_H);
    float* mod = (float*)(ws + WS_MOD);
        bf16* U = (bf16*)(ws + WS_U2);
    const float* rope = (const float*)(ws + WS_TAB);
    const float* lbv = (const float*)(ws + WS_TAB + 16384);

    if (EN_MODP && IN(PH_MODP)) { mod_partial_phase(F, INP(1), INP(3), INP(4), (float*)(ws + WS_MODP)); SEAM(PH_MODP); }
    if (EN_PRO && IN(PH_PRO)) { prologue_phase(F, ws); SEAM(PH_PRO); }
    if (EN_NORM && IN(PH_N0)) {
        norm_phase<false, true>(F, TT, nullptr, INP(0), INP(2), nullptr, nullptr, nullptr, 0, nullptr, mod, 0, INP(6), U);
        SEAM(PH_N0);
    }
    for (int l = 0; l < MK_LAYERS; ++l) {
        const int base = PH_L0 + PH_PER * l, kind = l % 3, j = l / 3;
        const float* modl = mod + (size_t)l * 17 * NMODC;
        const int M2 = l < DEPTH - 1 ? TT : TLAT;
        if (EN_G1 && IN(base + 0)) {
            pg8::StaticOrder S;
            if (kind == 0) { if (EN_G1A) {
                pg8::Gemm g{U, (const bf16*)(ws + WS_WATT + (size_t)j * (W_ATT_IN + W_ATT_OUT)), TT, ATT_IN, D}; S.init(TT, ATT_IN, F.G, (int)blockIdx.x);
                EpiAttn E{(bf16*)(ws + A_KB), (bf16*)(ws + A_QB), (bf16*)(ws + A_VTL), (bf16*)(ws + A_VTC), rope};
                pg8::gemm_phase<EpiAttn, pg8::StaticOrder, true, true>(F.lds, g, S, E, F.wave); }
            } else if (kind == 1) { if (EN_G1S) {
                pg8::Gemm g{U, (const bf16*)(ws + WS_WSSD), TT, SSD_INP, D}; S.init(TT, SSD_INP, F.G, (int)blockIdx.x);
                EpiSsd E{(bf16*)(ws + S_XBC), (bf16*)(ws + S_Z), (float*)(ws + S_DT), INP(15)};
                pg8::gemm_phase<EpiSsd, pg8::StaticOrder, true, true>(F.lds, g, S, E, F.wave); }
            } else if (EN_G1H) {
                pg8::Gemm g{U, (const bf16*)(ws + WS_WHG), TT, HG_IN, D}; S.init(TT, HG_IN, F.G, (int)blockIdx.x);
                EpiHgrn E{(_Float16*)(ws + H_LG), (bf16*)(ws + H_V), lbv};
                pg8::gemm_phase<EpiHgrn, pg8::StaticOrder, true, true>(F.lds, g, S, E, F.wave);
            }
            SEAM(base + 0);
        }
        if (IN(base + 1)) {
            if (kind == 0) { if (EN_ATT) attn_phase(F, (const bf16*)(ws + A_KB), (const bf16*)(ws + A_QB), (const bf16*)(ws + A_VTL), (const bf16*)(ws + A_VTC), INP(11) + j * 32, (bf16*)(ws + A_O), l < DEPTH - 1); }
            else if (kind == 1) { if (EN_CONV) ssd_conv_phase(F, (bf16*)(ws + S_XBC), INP(13), INP(14)); }
            else if (EN_HSCAN) hgrn_scan_phase(F, (const _Float16*)(ws + H_LG), (const bf16*)(ws + H_V), (const bf16*)(ws + H_Q), (float*)(ws + WS_U2));
            SEAM(base + 1);
        }
        if (kind != 0 && IN(base + 2)) {
            if (kind == 1) { if (EN_SSCAN) ssd_scan_phase(F, (const bf16*)(ws + S_XBC), (const float*)(ws + S_DT), INP(16), (bf16*)(ws + WS_U2)); }
            else if (EN_FIN) hgrn_fin_phase(F, (const float*)(ws + WS_U2), (const bf16*)(ws + H_OG), INP(22), (bf16*)(ws + H_LG));
            SEAM(base + 2);
        }
        if (kind == 1 && IN(base + 3)) {
            if (EN_FIN) ssd_fin_phase(F, (bf16*)(ws + WS_U2), (const bf16*)(ws + S_XBC), (const bf16*)(ws + S_Z), INP(17), INP(18));
            SEAM(base + 3);
        }
        float* ymix = (float*)(ws + (kind == 0 ? A_Y : (kind == 1 ? S_XBC : H_V)));
        if (EN_G2 && IN(base + 4)) {
            const bf16* A2 = (const bf16*)(ws + (kind == 0 ? A_O : (kind == 1 ? WS_U2 : H_LG)));
            const bf16* W2 = (const bf16*)(ws + (kind == 0 ? WS_WATT + (size_t)j * (W_ATT_IN + W_ATT_OUT) + W_ATT_IN : (kind == 1 ? WS_WSSD + W_SSD_IN : WS_WHG + W_HG_IN)));
            pg8::Gemm g{A2, W2, M2, D, kind == 1 ? SSD_DI : D}; pg8::StaticOrder S; S.init(M2, D, F.G, (int)blockIdx.x);
            EpiF32 E{ymix, D};
            pg8::gemm_phase<EpiF32, pg8::StaticOrder, true, true>(F.lds, g, S, E, F.wave);
            SEAM(base + 4);
        }
        if (EN_NORM && IN(base + 5)) {
            norm_phase<true, true>(F, M2, ymix, l == 0 ? INP(0) : out, hres, out, hres, modl, 2, INP(6) + (l * 4 + 1) * D, modl, 3, INP(6) + (l * 4 + 2) * D, U);
            SEAM(base + 5);
        }
        const unsigned char* wffn = ws + WS_WFFN + (size_t)l * (W_FFN_IN + W_FFN_OUT);
        if (EN_G3 && IN(base + 6)) {
            pg8::Gemm g{U, (const bf16*)wffn, M2, 2 * FFN, D}; pg8::StaticOrder S; S.init(M2, 2 * FFN, F.G, (int)blockIdx.x);
            EpiSwiglu E{(bf16*)(ws + F_H)};
            pg8::gemm_phase<EpiSwiglu, pg8::StaticOrder, true, true>(F.lds, g, S, E, F.wave);
            SEAM(base + 6);
        }
        if (EN_G4 && IN(base + 7)) {
            pg8::Gemm g{(const bf16*)(ws + F_H), (const bf16*)(wffn + W_FFN_IN), M2, D, FFN}; pg8::StaticOrder S; S.init(M2, D, F.G, (int)blockIdx.x);
            EpiF32 E{(float*)(ws + F_Y), D};
            pg8::gemm_phase<EpiF32, pg8::StaticOrder, true, true>(F.lds, g, S, E, F.wave);
            SEAM(base + 7);
        }
        if (EN_NORM && IN(base + 8)) {
            if (l < DEPTH - 1) norm_phase<true, true>(F, M2, (const float*)(ws + F_Y), out, hres, out, hres, modl, 5, INP(6) + (l * 4 + 3) * D, modl + 17 * NMODC, 0, INP(6) + ((l + 1) * 4 + 0) * D, U);
            else norm_phase<true, false>(F, M2, (const float*)(ws + F_Y), out, hres, out, hres, modl, 5, INP(6) + (l * 4 + 3) * D, nullptr, 0, nullptr, nullptr);
            SEAM(base + 8);
        }
    }
#undef IN
#undef SEAM
}

extern "C" void kernel_launch(void* const* d_in, const int* in_sizes, int n_in, void* d_out, int out_size, void* d_ws, size_t ws_size, hipStream_t stream) {
    static int grid = 0;
    if (grid == 0) {
        if (n_in != 24 || in_sizes[0] != TLAT * D || out_size != TLAT * D || ws_size < WS_END) {
            fprintf(stderr, "kernel_launch: unexpected shapes: n_in %d in0 %d out %d ws %zu (need %zu)\n", n_in, n_in > 0 ? in_sizes[0] : -1, out_size, ws_size, (size_t)WS_END); grid = -1; return; }
        int dev = 0, cus = 0, per_cu = 0;
        if (hipGetDevice(&dev) != hipSuccess || hipDeviceGetAttribute(&cus, hipDeviceAttributeMultiprocessorCount, dev) != hipSuccess) { grid = -1; return; }
        if (hipFuncSetAttribute((const void*)trunk_fwd, hipFuncAttributeMaxDynamicSharedMemorySize, LDS_BYTES) != hipSuccess) { fprintf(stderr, "kernel_launch: hipFuncSetAttribute failed\n"); grid = -1; return; }
        if (hipOccupancyMaxActiveBlocksPerMultiprocessor(&per_cu, (const void*)trunk_fwd, NWAVES * 64, LDS_BYTES) != hipSuccess || per_cu < 1)
            fprintf(stderr, "kernel_launch: occupancy query reports %d\n", per_cu);
        (void)hipGetLastError();
        grid = cus;
    }
    if (grid < 0) return;
    if (hipMemsetAsync((char*)d_ws + WS_CTL, 0, CTL_ZERO_BYTES, stream) != hipSuccess) return;
    Args a{};
    for (int i = 0; i < 24; ++i) a.in[i] = (const float*)d_in[i];
    a.out = (float*)d_out; a.ws = (unsigned char*)d_ws;
#if MK_ONE_LAUNCH
    a.lo = 0; a.hi = PH_L0 + PH_PER * MK_LAYERS;
    hipLaunchKernelGGL(trunk_fwd, dim3(grid), dim3(NWAVES * 64), LDS_BYTES, stream, a);
#else
    for (int id = 0; id < PH_L0 + PH_PER * MK_LAYERS; ++id) {
        if (id >= PH_L0) { const int loc = (id - PH_L0) % PH_PER, kind = ((id - PH_L0) / PH_PER) % 3; if ((loc == 2 && kind == 0) || (loc == 3 && kind != 1)) continue; }
        a.lo = id; a.hi = id + 1;
        hipLaunchKernelGGL(trunk_fwd, dim3(grid), dim3(NWAVES * 64), LDS_BYTES, stream, a);
    }
#endif
}
```

```cpp
#include <hip/hip_runtime.h>
#include <cstdio>
#include <cstdint>
#include <cmath>
namespace pg8 {
#define PG8_LAS __attribute__((address_space(3)))
typedef unsigned short bf16_t;
typedef short bf16x8 __attribute__((ext_vector_type(8)));
typedef float f32x4 __attribute__((ext_vector_type(4)));
typedef unsigned u32x4 __attribute__((ext_vector_type(4)));
constexpr int BM = 256, BK = 64, HALF = 128, HTB = HALF * BK * 2  , STAGE_BYTES = 8 * HTB, NXCD = 8, WGM = 4;

__host__ __device__ __forceinline__ int lds_byte(int r, int c) { const int st = (r >> 4) * 2 + (c >> 5), rr = r & 15, cc = c & 31, ob = rr * 64 + cc * 2; return st * 1024 + (ob ^ (((ob >> 9) & 1) << 5)); }
__host__ __device__ __forceinline__ void stage_rc(int b, int& R, int& C) { const int st = b / 1024, sb = b % 1024, swz = sb ^ (((sb >> 9) & 1) << 5); R = (st >> 1) * 16 + swz / 64; C = (st & 1) * 32 + (swz % 64) / 2; }
__host__ __device__ __forceinline__ int perm32(int rho) { const int n = rho >> 4, i = rho & 15; return 8 * (i >> 2) + 4 * n + (i & 3); }

struct Unit { int pm, pn; int koff = 0; int nt = 0; };
struct Gemm { const bf16_t* A; const bf16_t* Bt; int M, N, K; int ldk = 0; };

struct StaticOrder {
    int nM, nN, nwg, G, c; int rev = 0;
    __host__ __device__ void init(int M, int N, int G_, int c_) { nM = M / BM; nN = N / BM; nwg = nM * nN; G = G_; c = c_; }
    __host__ __device__ bool next(int i, Unit& u) const {
        const long L = (long)i * G + c; if (L >= nwg) return false;
        int wgid = (int)L; { const int q = nwg / NXCD, r = nwg % NXCD, xcd = wgid % NXCD, cnt = q + (xcd < r ? 1 : 0); int off = wgid / NXCD; if (rev) off = cnt - 1 - off; wgid = (xcd < r ? xcd * (q + 1) : r * (q + 1) + (xcd - r) * q) + off; }
        const int nig = WGM * nN, gid = wgid / nig, fm = gid * WGM, gsz = (nM - fm) < WGM ? (nM - fm) : WGM;
        u.pm = fm + ((wgid % nig) % gsz); u.pn = (wgid % nig) / gsz; return true;
    }
    __host__ __device__ bool idle_last() const { const int r = nwg % G; return r != 0 && c >= r; }
    __device__ __forceinline__ void a_ready(const Unit&) const {}
    __device__ __forceinline__ void done(const Unit&) const {}
};

__device__ __forceinline__ unsigned cvt_pk_bf16(float lo, float hi) { unsigned r; asm volatile("v_cvt_pk_bf16_f32 %0, %1, %2" : "=v"(r) : "v"(lo), "v"(hi)); return r; }
typedef float f32x2 __attribute__((ext_vector_type(2)));
struct NoSide { struct Tok {}; __device__ __forceinline__ Tok pre() { return Tok{}; } __device__ __forceinline__ void post(const Tok&) {} __device__ __forceinline__ void tail() {} };
template <class Epi, class Sched, bool ALIGN_EPI = false, bool SP2 = false, class Side = NoSide>
__device__ __forceinline__ void gemm_phase(PG8_LAS unsigned char* lds, const Gemm g, const Sched& S, const Epi& E, const int wave_id, Side& side) {
    int lane_; asm volatile("v_mbcnt_lo_u32_b32 %0, -1, 0\n\tv_mbcnt_hi_u32_b32 %0, -1, %0" : "=v"(lane_));
    const int tid_ = wave_id * 64 + lane_;
    const int tid = tid_, wid = __builtin_amdgcn_readfirstlane(tid >> 6), lane = tid & 63, wr = wid >> 2, wc = wid & 3, fr = lane & 15, fq = lane >> 4;
    const int K = g.ldk ? g.ldk : g.K, nt = g.K / BK;
    unsigned voffA[2], voffB[2];
#pragma unroll
    for (int i = 0; i < 2; ++i) { int R, C; stage_rc(tid * 16 + i * 8192, R, C); const int Rb = Epi::PERM ? ((R & ~31) + perm32(R & 31)) : R;
        voffA[i] = (unsigned)(R * K + C) * 2u; voffB[i] = (unsigned)(Rb * K + C) * 2u; }
    const size_t kstep = (size_t)(BK * 2);
    const size_t hstep = (size_t)HALF * K * 2;
    const size_t tstep = 2 * hstep;
    const unsigned ldsw = (unsigned)wid * 1024u;
    const int aoff = lds_byte(wr * 64 + fr, fq * 8), boff = lds_byte(wc * 32 + fr, fq * 8);
#define PG8_SA(b, h) (((b) * 2 + (h)) * HTB)
#define PG8_SB(b, h) ((4 + (b) * 2 + (h)) * HTB)
#define PG8_STAGE(bufoff, gbase, voff) do { _Pragma("unroll") for (int _i = 0; _i < 2; ++_i) \
        __builtin_amdgcn_global_load_lds((const unsigned*)((const char*)(gbase) + (voff)[_i]), (PG8_LAS unsigned*)(lds + (bufoff) + ldsw + _i * 8192), 16, 0, 0); } while (0)
#define PG8_LDA(dst, b, h) do { _Pragma("unroll") for (int m = 0; m < 4; ++m) _Pragma("unroll") for (int k = 0; k < 2; ++k) dst[m][k] = *(const PG8_LAS bf16x8*)(lds + PG8_SA(b, h) + aoff + m * 2048 + k * 1024); } while (0)
#define PG8_LDB(dst, b, h) do { _Pragma("unroll") for (int n = 0; n < 2; ++n) _Pragma("unroll") for (int k = 0; k < 2; ++k) dst[n][k] = *(const PG8_LAS bf16x8*)(lds + PG8_SB(b, h) + boff + n * 2048 + k * 1024); } while (0)
#define PG8_MMA(ai, bj, At, Bt) do { __builtin_amdgcn_s_setprio(1); _Pragma("unroll") for (int m = 0; m < 4; ++m) _Pragma("unroll") for (int n = 0; n < 2; ++n) _Pragma("unroll") for (int k = 0; k < 2; ++k) \
        acc[ai][bj][m][n] = __builtin_amdgcn_mfma_f32_16x16x32_bf16(Bt[n][k], At[m][k], acc[ai][bj][m][n], 0, 0, 0); __builtin_amdgcn_s_setprio(0); } while (0)
#define PG8_WAIT_V(n) asm volatile("s_waitcnt vmcnt(" #n ")" ::: "memory")
#define PG8_WAIT_L(n) asm volatile("s_waitcnt lgkmcnt(" #n ")" ::: "memory")
#define PG8_BAR __builtin_amdgcn_s_barrier()
#define PG8_SCHED __builtin_amdgcn_sched_barrier(0)
    Unit cur, nxt; int ui = 0;
    if (!S.next(0, cur)) return;
    f32x4 acc[2][2][4][2];
#pragma unroll
    for (int a = 0; a < 2; ++a)
#pragma unroll
        for (int b = 0; b < 2; ++b)
#pragma unroll
            for (int m = 0; m < 4; ++m)
#pragma unroll
                for (int n = 0; n < 2; ++n) acc[a][b][m][n] = (f32x4){0.f, 0.f, 0.f, 0.f};
    bf16x8 At[4][2], B0[2][2], B1[2][2];
    const char* cA = (const char*)g.A + (size_t)cur.pm * tstep + (size_t)cur.koff * 2; const char* cB = (const char*)g.Bt + (size_t)cur.pn * tstep + (size_t)cur.koff * 2;
    S.a_ready(cur);
    if constexpr (SP2) {
        PG8_STAGE(PG8_SB(0, 0), cB, voffB); PG8_STAGE(PG8_SB(0, 1), cB + hstep, voffB); PG8_STAGE(PG8_SA(0, 0), cA, voffA); PG8_STAGE(PG8_SA(0, 1), cA + hstep, voffA);
        if (wr == 1) PG8_BAR;
        PG8_WAIT_V(2); PG8_BAR;
        PG8_STAGE(PG8_SB(1, 0), cB + kstep, voffB); PG8_STAGE(PG8_SA(1, 0), cA + kstep, voffA); PG8_STAGE(PG8_SB(1, 1), cB + hstep + kstep, voffB);
        PG8_WAIT_V(6); PG8_BAR;
    } else {
        PG8_STAGE(PG8_SB(0, 0), cB, voffB); PG8_STAGE(PG8_SA(0, 0), cA, voffA); PG8_STAGE(PG8_SB(0, 1), cB + hstep, voffB); PG8_STAGE(PG8_SA(0, 1), cA + hstep, voffA);
        if (wr == 1) PG8_BAR;
        PG8_WAIT_V(4); PG8_BAR;
        PG8_STAGE(PG8_SB(1, 0), cB + kstep, voffB); PG8_STAGE(PG8_SA(1, 0), cA + kstep, voffA); PG8_STAGE(PG8_SB(1, 1), cB + hstep + kstep, voffB);
        PG8_WAIT_V(6); PG8_BAR;
    }
    for (;;) {
        const bool has_next = S.next(ui + 1, nxt);
        const char* nA = has_next ? (const char*)g.A + (size_t)nxt.pm * tstep + (size_t)nxt.koff * 2 : cA; const char* nB = has_next ? (const char*)g.Bt + (size_t)nxt.pn * tstep + (size_t)nxt.koff * 2 : cB;
        for (int t = 0; t < nt; t += 2) {
            const bool last = (t == nt - 2);
            const char* a1 = cA + (size_t)(t + 1) * kstep;
            const char* a2 = last ? nA : cA + (size_t)(t + 2) * kstep; const char* b2 = last ? nB : cB + (size_t)(t + 2) * kstep;
            const char* a3 = a2 + kstep; const char* b3 = b2 + kstep;
            if (last && has_next) S.a_ready(nxt);
            if constexpr (SP2) {
            PG8_LDB(B0, 0, 0); PG8_LDB(B1, 0, 1); PG8_SCHED; PG8_LDA(At, 0, 0); PG8_STAGE(PG8_SA(1, 1), a1 + hstep, voffA);
            PG8_WAIT_V(8); PG8_WAIT_L(0); PG8_BAR; PG8_MMA(0, 0, At, B0); PG8_MMA(0, 1, At, B1); PG8_BAR; PG8_SCHED;
            PG8_LDA(At, 0, 1); PG8_STAGE(PG8_SB(0, 0), b2, voffB); PG8_STAGE(PG8_SB(0, 1), b2 + hstep, voffB); PG8_STAGE(PG8_SA(0, 0), a2, voffA);
            PG8_WAIT_V(8); PG8_WAIT_L(0); PG8_BAR; PG8_MMA(1, 0, At, B0); PG8_MMA(1, 1, At, B1); PG8_BAR; PG8_SCHED;
            PG8_LDB(B0, 1, 0); PG8_LDB(B1, 1, 1); PG8_SCHED; PG8_LDA(At, 1, 0); PG8_STAGE(PG8_SA(0, 1), a2 + hstep, voffA);
            PG8_WAIT_V(8); PG8_WAIT_L(0); PG8_BAR; PG8_MMA(0, 0, At, B0); PG8_MMA(0, 1, At, B1); PG8_BAR; PG8_SCHED;
            PG8_LDA(At, 1, 1); PG8_STAGE(PG8_SB(1, 0), b3, voffB); PG8_STAGE(PG8_SB(1, 1), b3 + hstep, voffB); PG8_STAGE(PG8_SA(1, 0), a3, voffA);
            PG8_WAIT_V(8); PG8_WAIT_L(0); PG8_BAR; PG8_MMA(1, 0, At, B0); PG8_MMA(1, 1, At, B1); PG8_BAR; PG8_SCHED;
            } else {
            PG8_LDB(B0, 0, 0); PG8_SCHED; PG8_LDA(At, 0, 0); PG8_STAGE(PG8_SA(1, 1), a1 + hstep, voffA);
            PG8_WAIT_L(8); PG8_BAR; PG8_WAIT_L(0); PG8_MMA(0, 0, At, B0); PG8_BAR; PG8_SCHED;
            PG8_LDB(B1, 0, 1); PG8_STAGE(PG8_SB(0, 0), b2, voffB);
            PG8_BAR; PG8_WAIT_L(0); PG8_MMA(0, 1, At, B1); PG8_BAR;
            PG8_LDA(At, 0, 1); PG8_STAGE(PG8_SA(0, 0), a2, voffA);
            PG8_BAR; PG8_WAIT_L(0); PG8_MMA(1, 0, At, B0); PG8_BAR; PG8_SCHED;
            PG8_STAGE(PG8_SB(0, 1), b2 + hstep, voffB);
            PG8_WAIT_V(6); PG8_BAR; PG8_MMA(1, 1, At, B1); PG8_BAR;
            PG8_LDB(B0, 1, 0); PG8_SCHED; PG8_LDA(At, 1, 0); PG8_STAGE(PG8_SA(0, 1), a2 + hstep, voffA);
            PG8_WAIT_L(8); PG8_BAR; PG8_WAIT_L(0); PG8_MMA(0, 0, At, B0); PG8_BAR; PG8_SCHED;
            PG8_LDB(B1, 1, 1); PG8_STAGE(PG8_SB(1, 0), b3, voffB);
            PG8_BAR; PG8_WAIT_L(0); PG8_MMA(0, 1, At, B1); PG8_BAR;
            PG8_LDA(At, 1, 1); PG8_STAGE(PG8_SA(1, 0), a3, voffA);
            PG8_BAR; PG8_WAIT_L(0); PG8_MMA(1, 0, At, B0); PG8_BAR; PG8_SCHED;
            PG8_STAGE(PG8_SB(1, 1), b3 + hstep, voffB);
            PG8_WAIT_V(6); PG8_BAR; PG8_MMA(1, 1, At, B1); PG8_BAR;
            }
        }
        if constexpr (ALIGN_EPI) { if (wr == 0) PG8_BAR; }
        const typename Side::Tok tok = side.pre();
        if constexpr (!Epi::AFTER_DRAIN) { E(acc, cur, wr, wc, fr, fq); S.done(cur); }
        side.post(tok);
        if (!has_next) break;
#pragma unroll
        for (int a = 0; a < 2; ++a)
#pragma unroll
            for (int b = 0; b < 2; ++b)
#pragma unroll
                for (int m = 0; m < 4; ++m)
#pragma unroll
                    for (int n = 0; n < 2; ++n) acc[a][b][m][n] = (f32x4){0.f, 0.f, 0.f, 0.f};
        cur = nxt; cA = nA; cB = nB; ++ui;
        if constexpr (ALIGN_EPI) { if (wr == 1) PG8_BAR; }
    }
    PG8_WAIT_V(0);
    if constexpr (!ALIGN_EPI) { if (wr == 0) PG8_BAR; }
    PG8_BAR;
    if constexpr (Epi::AFTER_DRAIN) { E.fused(acc, cur, wr, wc, fr, fq, lds, wid, lane); S.done(cur); }
    side.tail();
#undef PG8_SA
#undef PG8_SB
#undef PG8_STAGE
#undef PG8_LDA
#undef PG8_LDB
#undef PG8_MMA
#undef PG8_WAIT_V
#undef PG8_WAIT_L
#undef PG8_BAR
#undef PG8_SCHED
}
}
#define GAS __attribute__((address_space(1)))
#define LAS __attribute__((address_space(3)))
typedef unsigned short bf16;
typedef unsigned v4u __attribute__((ext_vector_type(4)));
typedef float f32x4 __attribute__((ext_vector_type(4)));
typedef short bf16x8 __attribute__((ext_vector_type(8)));
typedef GAS unsigned gu32;
typedef GAS unsigned long long gu64;
#define RLX_AGENT __ATOMIC_RELAXED, __HIP_MEMORY_SCOPE_AGENT
#define LDS_WAIT() asm volatile("s_waitcnt lgkmcnt(0)" ::: "memory")
#define VM_WAIT() asm volatile("s_waitcnt vmcnt(0)" ::: "memory")
__device__ __forceinline__ unsigned long long rt() { return __builtin_amdgcn_s_memrealtime(); }
__device__ __forceinline__ unsigned f2bf(float f) { unsigned u = __builtin_bit_cast(unsigned, f); return (u + 0x7fffu + ((u >> 16) & 1u)) >> 16; }
__device__ __forceinline__ unsigned pk2(float lo, float hi) { return f2bf(lo) | (f2bf(hi) << 16); }

#define XB_TMO      128
#define XB_XCNT(j)  (256  + 64 * (j))
#define XB_XSUB(j)  (1280 + 64 * (j))
#define XB_XGEN(j)  (2304 + 64 * (j))
#define XB_TOP      3328
#define XB_TOPGEN   3392
#define XCD_BAR_WORDS 3456
#define XB_SPIN_CAP (1u << 18)

__device__ __forceinline__ unsigned xb_ld(unsigned* p)              { return __hip_atomic_load(p, __ATOMIC_RELAXED, __HIP_MEMORY_SCOPE_AGENT); }
__device__ __forceinline__ unsigned xb_add(unsigned* p, unsigned v) { return __hip_atomic_fetch_add(p, v, __ATOMIC_RELAXED, __HIP_MEMORY_SCOPE_AGENT); }
__device__ __forceinline__ unsigned xb_xcc_id() { return (unsigned)__builtin_amdgcn_s_getreg((3 << 11) | 20) & 0xFu; }
#define XB_SPIN(cond, bar) do { unsigned _sp = 0; while (cond) { __builtin_amdgcn_s_sleep(1); \
    if ((++_sp & 255u) == 0u) { if (xb_ld(&(bar)[XB_TMO])) break; if (_sp > XB_SPIN_CAP) { atomicAdd(&(bar)[XB_TMO], 1u); break; } } } } while (0)

struct XcdBarrier {
    unsigned* bar; unsigned x;
    volatile LAS unsigned* st;
};

__device__ __forceinline__ XcdBarrier xcd_barrier_post(unsigned* bar, volatile LAS unsigned* st) {
    XcdBarrier b; b.bar = bar; b.x = xb_xcc_id(); b.st = st;
    if (threadIdx.x == 0) (void)xb_add(&bar[XB_XCNT(b.x)], 1u);
    return b;
}
__device__ __forceinline__ void xcd_barrier_complete(unsigned* bar, unsigned x, unsigned& nloc, unsigned& nx) {
    const unsigned G = gridDim.x * gridDim.y * gridDim.z;
    unsigned sum, cnt, mine, sp = 0u;
    for (;;) {
        sum = 0u; cnt = 0u; mine = 0u;
#pragma unroll
        for (unsigned j = 0; j < 16; ++j) { const unsigned c = xb_ld(&bar[XB_XCNT(j)]); sum += c; cnt += (c > 0u) ? 1u : 0u; mine = (j == x) ? c : mine; }
        if (sum == G) break;
        __builtin_amdgcn_s_sleep(1);
        if ((++sp & 255u) == 0u) { if (xb_ld(&bar[XB_TMO])) break; if (sp > XB_SPIN_CAP) { atomicAdd(&bar[XB_TMO], 1u); break; } }
    }
    nloc = mine > 0u ? mine : 1u; nx = cnt > 0u ? cnt : 1u;
}

__device__ __forceinline__ void xcd_barrier(const XcdBarrier& b) {
    asm volatile("s_waitcnt vmcnt(0)" ::: "memory");
    __syncthreads();
    if (threadIdx.x == 0) {
        unsigned* bar = b.bar;
        __builtin_amdgcn_s_waitcnt(0);
        unsigned nloc = b.st[0], nx = b.st[1];
        if (nloc == 0u) { xcd_barrier_complete(bar, b.x, nloc, nx); b.st[0] = nloc; b.st[1] = nx; }
        const unsigned old = xb_add(&bar[XB_XSUB(b.x)], 1u);
        const unsigned gen = old / nloc;
        if (old + 1u == (gen + 1u) * nloc) {
            __builtin_amdgcn_fence(__ATOMIC_RELEASE, "agent");
            asm volatile("s_waitcnt vmcnt(0)" ::: "memory");
            const unsigned og = xb_add(&bar[XB_TOP], 1u);
            const unsigned tg = og / nx;
            if (og + 1u == (tg + 1u) * nx) xb_add(&bar[XB_TOPGEN], 1u);
            else XB_SPIN(xb_ld(&bar[XB_TOPGEN]) == tg, bar);
            __builtin_amdgcn_fence(__ATOMIC_ACQUIRE, "agent");
            xb_add(&bar[XB_XGEN(b.x)], 1u);
            asm volatile("s_waitcnt vmcnt(0)" ::: "memory");
        } else {
            XB_SPIN(xb_ld(&bar[XB_XGEN(b.x)]) == gen, bar);
            __builtin_amdgcn_fence(__ATOMIC_ACQUIRE, "agent");
            asm volatile("s_waitcnt vmcnt(0)" ::: "memory");
        }
    }
    __syncthreads();
}

#define DI __device__ __forceinline__
constexpr int NWAVES = 8;
constexpr int D = 2048, NB = 16, SEQ = 2048, CTXL = 256, DEPTH = 4;
constexpr int TLAT = NB * SEQ, TCTX = NB * CTXL, TT = TLAT + TCTX;
constexpr int FFN = 5632, NMODC = 6 * D;
constexpr int ATT_IN = 2560;
constexpr int SSD_DI = 4096, SSD_CONV = 6144, SSD_INP = 10496  , SSD_INS = 10368;
constexpr int HG_IN = 10240;
constexpr float RMS_EPS = 1e-6f, LOG2E = 1.4426950408889634f;
constexpr float QSCALE = 0.125f * LOG2E;
typedef float f32x16 __attribute__((ext_vector_type(16)));
typedef float f32x2v __attribute__((ext_vector_type(2)));
typedef unsigned u32x2 __attribute__((ext_vector_type(2)));
typedef short s16x4 __attribute__((ext_vector_type(4)));

constexpr size_t MiB = 1u << 20;
constexpr size_t WS_CTL = 0, CTL_ZERO_BYTES = 1 * MiB;
constexpr size_t WS_MODP = 1 * MiB;
constexpr size_t WS_MOD = 28 * MiB;
constexpr size_t WS_TAB = 32 * MiB;
constexpr size_t WS_H = 33 * MiB;
constexpr size_t WS_W = 65 * MiB;
constexpr size_t W_FFN_IN = (size_t)2 * FFN * D * 2, W_FFN_OUT = (size_t)D * FFN * 2;
constexpr size_t WS_WFFN = WS_W;
constexpr size_t W_ATT_IN = (size_t)ATT_IN * D * 2, W_ATT_OUT = (size_t)D * D * 2;
constexpr size_t WS_WATT = WS_WFFN + 4 * (W_FFN_IN + W_FFN_OUT);
constexpr size_t W_SSD_IN = (size_t)SSD_INP * D * 2, W_SSD_OUT = (size_t)D * SSD_DI * 2;
constexpr size_t WS_WSSD = WS_WATT + 2 * (W_ATT_IN + W_ATT_OUT);
constexpr size_t W_HG_IN = (size_t)HG_IN * D * 2, W_HG_OUT = (size_t)D * D * 2;
constexpr size_t WS_WHG = WS_WSSD + W_SSD_IN + W_SSD_OUT;
constexpr size_t WS_WEND = WS_WHG + W_HG_IN + W_HG_OUT;
constexpr size_t WS_U2 = 470 * MiB;
constexpr size_t WS_BIG = 758 * MiB;
constexpr size_t WS_END = 1496 * MiB;
static_assert(WS_WEND <= WS_U2, "weights fit");
constexpr size_t A_KB = WS_BIG;
constexpr size_t A_QB = A_KB + (size_t)TT * 256 * 2;
constexpr size_t A_VTL = A_QB + (size_t)TT * D * 2;
constexpr size_t A_VTC = A_VTL + (size_t)NB * 4 * 64 * SEQ * 2;
constexpr size_t A_O = A_VTC + (size_t)NB * 4 * 64 * CTXL * 2;
constexpr size_t A_Y = A_O + (size_t)TT * D * 2;
static_assert(A_Y + (size_t)TT * D * 4 <= WS_END, "attn map");
constexpr size_t S_XBC = WS_BIG;
constexpr size_t S_Z = S_XBC + (size_t)TT * SSD_CONV * 2;
constexpr size_t S_DT = S_Z + (size_t)TT * SSD_DI * 2;
static_assert(S_DT + (size_t)TT * 128 * 4 <= WS_END, "ssd map");
constexpr size_t H_LG = WS_BIG;
constexpr size_t H_V = H_LG + (size_t)2 * TT * D * 2;
constexpr size_t H_Q = H_V + (size_t)TT * D * 2;
constexpr size_t H_OG = H_Q + (size_t)TT * D * 2;
static_assert(H_OG + (size_t)TT * D * 2 <= WS_END, "hgrn map");
constexpr size_t F_H = WS_BIG;
constexpr size_t F_Y = F_H + (size_t)TT * FFN * 2;
static_assert(F_Y + (size_t)TT * D * 4 <= WS_END, "ffn map");
constexpr int CW_PCNT = 140032, CW_PDONE = 170000;
constexpr int CW_BAR = 4096;

constexpr int RING_BYTES = 131072;
constexpr int LDSCTL_OFF = RING_BYTES, MISC_OFF = LDSCTL_OFF + 320;
constexpr int LDS_BYTES = 163840;
constexpr int CONV_SCR_OFF = 135168, CONV_SCR_WAVE = 3584;

typedef __bf16 bf16x2_t __attribute__((ext_vector_type(2)));
DI unsigned cvtpk(float lo, float hi) { f32x2v v = {lo, hi}; bf16x2_t b = __builtin_convertvector(v, bf16x2_t); return __builtin_bit_cast(unsigned, b); }
DI int lane_id() { int l; asm volatile("v_mbcnt_lo_u32_b32 %0, -1, 0\n\tv_mbcnt_hi_u32_b32 %0, -1, %0" : "=v"(l)); return l; }
DI float bf2f(unsigned short b) { return __uint_as_float((unsigned)b << 16); }
DI float bflo(unsigned w) { return __uint_as_float(w << 16); }
DI float bfhi(unsigned w) { return __uint_as_float(w & 0xffff0000u); }
DI unsigned short f2bf16(float f) { return (unsigned short)(cvtpk(f, 0.f) & 0xffffu); }
DI unsigned pkh(float lo, float hi) { return (unsigned)__builtin_bit_cast(unsigned short, (_Float16)lo) | ((unsigned)__builtin_bit_cast(unsigned short, (_Float16)hi) << 16); }
DI float silu_f(float x) { return x * __builtin_amdgcn_rcpf(1.f + __builtin_amdgcn_exp2f(-x * LOG2E)); }
DI float wave_sum(float v) {
#pragma unroll
    for (int o = 1; o < 64; o <<= 1) v += __shfl_xor(v, o);
    return v;
}
DI int crow(int r, int h) { return (r & 3) + 8 * (r >> 2) + 4 * h; }
DI f32x16 mfma32(bf16x8 a, bf16x8 b, f32x16 c) { return __builtin_amdgcn_mfma_f32_32x32x16_bf16(a, b, c, 0, 0, 0); }
DI bf16x8 lds_frag(LAS unsigned char* p) { return *(LAS bf16x8*)p; }
DI float swap_max(float m) { auto rr = __builtin_amdgcn_permlane32_swap(__float_as_uint(m), __float_as_uint(m), false, false); return fmaxf(__uint_as_float(rr[0]), __uint_as_float(rr[1])); }
DI float swap_sum(float m) { auto rr = __builtin_amdgcn_permlane32_swap(__float_as_uint(m), __float_as_uint(m), false, false); return __uint_as_float(rr[0]) + __uint_as_float(rr[1]); }
DI bf16x8 pack8(const f32x16& x, int s) {
    v4u p; p.x = cvtpk(x[8 * s], x[8 * s + 1]); p.y = cvtpk(x[8 * s + 2], x[8 * s + 3]);
    p.z = cvtpk(x[8 * s + 4], x[8 * s + 5]); p.w = cvtpk(x[8 * s + 6], x[8 * s + 7]);
    return __builtin_bit_cast(bf16x8, p);
}

typedef short v4i16_t __attribute__((ext_vector_type(4)));
DI s16x4 tr16(LAS unsigned char* p) { return __builtin_bit_cast(s16x4, __builtin_amdgcn_ds_read_tr16_b64_v4i16((LAS v4i16_t*)p)); }
DI bf16x8 cat8(s16x4 lo, s16x4 hi) { return (bf16x8){lo[0], lo[1], lo[2], lo[3], hi[0], hi[1], hi[2], hi[3]}; }

using pg8::Unit; using pg8::HALF; using pg8::BM;
struct EpiF32 {
    static constexpr bool PERM = false, AFTER_DRAIN = false;
    float* C; int ldc;
    DI void operator()(const f32x4 (&acc)[2][2][4][2], const Unit& u, int wr, int wc, int fr, int fq) const {
        const int row0 = u.pm * BM + wr * 64 + fr, col0 = u.pn * BM + wc * 32 + 4 * fq;
#pragma unroll
        for (int ai = 0; ai < 2; ++ai)
#pragma unroll
            for (int m = 0; m < 4; ++m) { float* rowp = C + (size_t)(row0 + ai * HALF + m * 16) * ldc + col0;
#pragma unroll
                for (int bj = 0; bj < 2; ++bj)
#pragma unroll
                    for (int n = 0; n < 2; ++n) *(f32x4*)(rowp + bj * HALF + n * 16) = acc[ai][bj][m][n]; }
    }
};
struct EpiBf16Y {
    static constexpr bool PERM = true, AFTER_DRAIN = false;
    bf16* C;
    DI void operator()(const f32x4 (&acc)[2][2][4][2], const Unit& u, int wr, int wc, int fr, int fq) const {
        const int row0 = u.pm * BM + wr * 64 + fr, col0 = u.pn * BM + wc * 32 + 8 * fq;
#pragma unroll
        for (int ai = 0; ai < 2; ++ai)
#pragma unroll
            for (int m = 0; m < 4; ++m) { bf16* rowp = C + (size_t)(row0 + ai * HALF + m * 16) * D + col0;
#pragma unroll
                for (int bj = 0; bj < 2; ++bj) { const f32x4 v0 = acc[ai][bj][m][0], v1 = acc[ai][bj][m][1]; v4u w;
                    w.x = cvtpk(v0[0], v0[1]); w.y = cvtpk(v0[2], v0[3]); w.z = cvtpk(v1[0], v1[1]); w.w = cvtpk(v1[2], v1[3]);
                    *(v4u*)(rowp + bj * HALF) = w; }
                asm volatile("" ::: "memory"); }
    }
};
#ifndef NT_DEFER
#define NT_DEFER 0
#endif
#ifndef NT_WT
#define NT_WT 0
#endif
struct EpiBf16YWT {
    static constexpr bool PERM = true, AFTER_DRAIN = false;
    bf16* C;
    DI void operator()(const f32x4 (&acc)[2][2][4][2], const Unit& u, int wr, int wc, int fr, int fq) const {
        const int row0 = u.pm * BM + wr * 64 + fr, col0 = u.pn * BM + wc * 32 + 8 * fq;
#pragma unroll
        for (int ai = 0; ai < 2; ++ai)
#pragma unroll
            for (int m = 0; m < 4; ++m) { bf16* rowp = C + (size_t)(row0 + ai * HALF + m * 16) * D + col0;
#pragma unroll
                for (int bj = 0; bj < 2; ++bj) { const f32x4 v0 = acc[ai][bj][m][0], v1 = acc[ai][bj][m][1];
                    const unsigned long long lo = (unsigned long long)cvtpk(v0[0], v0[1]) | ((unsigned long long)cvtpk(v0[2], v0[3]) << 32), hi = (unsigned long long)cvtpk(v1[0], v1[1]) | ((unsigned long long)cvtpk(v1[2], v1[3]) << 32);
                    unsigned long long* q = (unsigned long long*)(rowp + bj * HALF);
                    if (NT_WT) { __hip_atomic_store(q, lo, __ATOMIC_RELAXED, __HIP_MEMORY_SCOPE_AGENT); __hip_atomic_store(q + 1, hi, __ATOMIC_RELAXED, __HIP_MEMORY_SCOPE_AGENT); }
                    else *(v4u*)q = (v4u){(unsigned)lo, (unsigned)(lo >> 32), (unsigned)hi, (unsigned)(hi >> 32)}; }
                asm volatile("" ::: "memory"); }
    }
};
struct CountOrder : pg8::StaticOrder {
    unsigned* cnt; mutable int prev = -1;
    DI bool next(int i, Unit& u) const {
        if (!pg8::StaticOrder::next(i, u)) return false;
        const int fm = u.pm & ~3, idx = (u.pm & 3) + 4 * u.pn;
        u.pm = fm + 2 * (idx >> 4) + (idx & 1); u.pn = (idx & 15) >> 1; return true;
    }
    int xcc;
    DI void publish(int pm) const { if (pm >= 0 && (threadIdx.x & 63) == 0) __hip_atomic_fetch_add(cnt + pm * 16 + xcc, 1u, __ATOMIC_RELAXED, __HIP_MEMORY_SCOPE_AGENT); }
    DI void done(const Unit& u) const { if (NT_DEFER) { publish(prev); prev = u.pm; } else { asm volatile("s_waitcnt vmcnt(0)" ::: "memory"); publish(u.pm); } }
    DI void flush() const { asm volatile("s_waitcnt vmcnt(0)" ::: "memory"); publish(prev); prev = -1; }
};
struct SplitTailOrder {
    int G, c, khalf, call;
    DI void init(int K, int G_, int c_, int call_) { G = G_; c = c_; khalf = K / 2; call = call_; }
    DI bool next(int i, Unit& u) const {
        constexpr int nN = D / BM, nwg = (TLAT / BM) * nN;
        const int L = i * G + c;
        if (call == 0) { if (L >= nwg) return false; const int q = nwg / 8, xcd = L % 8, off = L / 8, wgid = xcd * q + off, nig = 8 * nN;
            u.pm = (wgid / nig) * 8 + (wgid % nig) % 8; u.pn = (wgid % nig) / 8; u.koff = 0; return true; }
        if (L >= 256) return false;
        const int t = L >> 1; u.pm = TLAT / BM + (t >> 3); u.pn = t & 7; u.koff = (L & 1) * khalf; return true;
    }
    DI void a_ready(const Unit&) const {}
    DI void done(const Unit&) const {}
};
struct EpiYSplit {
    static constexpr bool PERM = true, AFTER_DRAIN = false;
    bf16* C; float* P; int split;
    DI void operator()(const f32x4 (&acc)[2][2][4][2], const Unit& u, int wr, int wc, int fr, int fq) const {
        const int row0 = u.pm * BM + wr * 64 + fr, col0 = u.pn * BM + wc * 32 + 8 * fq;
        if (!split) {
#pragma unroll
            for (int ai = 0; ai < 2; ++ai)
#pragma unroll
                for (int m = 0; m < 4; ++m) { bf16* rowp = C + (size_t)(row0 + ai * HALF + m * 16) * D + col0;
#pragma unroll
                    for (int bj = 0; bj < 2; ++bj) { const f32x4 v0 = acc[ai][bj][m][0], v1 = acc[ai][bj][m][1]; v4u w;
                        w.x = cvtpk(v0[0], v0[1]); w.y = cvtpk(v0[2], v0[3]); w.z = cvtpk(v1[0], v1[1]); w.w = cvtpk(v1[2], v1[3]);
                        *(v4u*)(rowp + bj * HALF) = w; }
                    asm volatile("" ::: "memory"); }
        } else {
            float* Pb = P + (u.koff ? (size_t)TCTX * D : 0);
#pragma unroll
            for (int ai = 0; ai < 2; ++ai)
#pragma unroll
                for (int m = 0; m < 4; ++m) { float* rowp = Pb + (size_t)(row0 - TLAT + ai * HALF + m * 16) * D + col0;
#pragma unroll
                    for (int bj = 0; bj < 2; ++bj) { *(f32x4*)(rowp + bj * HALF) = acc[ai][bj][m][0]; *(f32x4*)(rowp + bj * HALF + 4) = acc[ai][bj][m][1]; }
                    asm volatile("" ::: "memory"); }
        }
    }
};
struct EpiSwiglu {
    static constexpr bool PERM = true, AFTER_DRAIN = false;
    bf16* H;
    DI void operator()(const f32x4 (&acc)[2][2][4][2], const Unit& u, int wr, int wc, int fr, int fq) const {
        const int row0 = u.pm * BM + wr * 64 + fr, col0 = u.pn * 128 + wc * 32 + 8 * fq;
#pragma unroll
        for (int ai = 0; ai < 2; ++ai)
#pragma unroll
            for (int m = 0; m < 4; ++m) {
                float o[8];
#pragma unroll
                for (int n = 0; n < 2; ++n)
#pragma unroll
                    for (int j = 0; j < 4; ++j) o[4 * n + j] = silu_f(acc[ai][0][m][n][j]) * acc[ai][1][m][n][j];
                v4u w; w.x = cvtpk(o[0], o[1]); w.y = cvtpk(o[2], o[3]); w.z = cvtpk(o[4], o[5]); w.w = cvtpk(o[6], o[7]);
                *(v4u*)(H + (size_t)(row0 + ai * HALF + m * 16) * FFN + col0) = w; }
    }
};
struct EpiAttn {
    static constexpr bool PERM = false, AFTER_DRAIN = false;
    bf16* Kb; bf16* Qb; bf16* VtL; bf16* VtC; const float* rope;
    DI void operator()(const f32x4 (&acc)[2][2][4][2], const Unit& u, int wr, int wc, int fr, int fq) const {
        const int pn = u.pn;
#pragma unroll
        for (int ai = 0; ai < 2; ++ai)
#pragma unroll
            for (int m = 0; m < 4; ++m) {
                const int row = u.pm * BM + ai * HALF + wr * 64 + m * 16 + fr;
                const bool lat = u.pm < TLAT / BM; const int s = row & 2047;
                if (pn == 1) {
                    bf16* base; size_t pitch;
                    if (lat) { base = VtL + (size_t)(row >> 11) * (4 * 64 * SEQ) + s; pitch = SEQ; }
                    else { const int rc = row - TLAT; base = VtC + (size_t)(rc >> 8) * (4 * 64 * CTXL) + (rc & 255); pitch = CTXL; }
#pragma unroll
                    for (int bj = 0; bj < 2; ++bj)
#pragma unroll
                        for (int n = 0; n < 2; ++n)
#pragma unroll
                            for (int j = 0; j < 4; ++j) { const int col = 128 * bj + 32 * wc + 16 * n + 4 * fq + j; base[(size_t)col * pitch] = f2bf16(acc[ai][bj][m][n][j]); }
                } else {
                    const int pos = (wc & 1) ? (s & 63) : (s >> 6);
                    const f32x4* rp = (const f32x4*)(rope + (pos * 16 + 4 * fq) * 2);
                    const f32x4 c01 = rp[0], c23 = rp[1];
                    const float cs[4] = {c01[0], c01[2], c23[0], c23[2]}, sn[4] = {c01[1], c01[3], c23[1], c23[3]};
#pragma unroll
                    for (int bj = 0; bj < 2; ++bj) {
                        const f32x4 t1 = acc[ai][bj][m][0], t2 = acc[ai][bj][m][1]; float o1[4], o2[4];
#pragma unroll
                        for (int j = 0; j < 4; ++j) { o1[j] = lat ? t1[j] * cs[j] - t2[j] * sn[j] : t1[j]; o2[j] = lat ? t2[j] * cs[j] + t1[j] * sn[j] : t2[j]; }
                        bf16* dst; float sc;
                        if (pn == 0) { dst = Kb + (size_t)row * 256 + 128 * bj + 32 * wc + 4 * fq; sc = 1.f; }
                        else { dst = Qb + (size_t)row * D + (pn - 2) * 256 + 128 * bj + 32 * wc + 4 * fq; sc = QSCALE; }
                        u32x2 w1, w2; w1.x = cvtpk(o1[0] * sc, o1[1] * sc); w1.y = cvtpk(o1[2] * sc, o1[3] * sc);
                        w2.x = cvtpk(o2[0] * sc, o2[1] * sc); w2.y = cvtpk(o2[2] * sc, o2[3] * sc);
                        *(u32x2*)dst = w1; *(u32x2*)(dst + 16) = w2;
                    }
                }
                asm volatile("" ::: "memory");
            }
    }
};
struct EpiSsd {
    static constexpr bool PERM = true, AFTER_DRAIN = false;
    bf16* XBC; bf16* Z; float* DT; const float* dt_bias; bf16* HB;
    DI void operator()(const f32x4 (&acc)[2][2][4][2], const Unit& u, int wr, int wc, int fr, int fq) const {
        const int pn = u.pn, row0 = u.pm * BM + wr * 64 + fr, cl = wc * 32 + 8 * fq;
        if (pn < 40) {
            bf16* base; int ldc;
            if (pn < 24) { base = XBC + pn * 256; ldc = SSD_CONV; } else { base = Z + (pn - 24) * 256; ldc = SSD_DI; }
#pragma unroll
            for (int ai = 0; ai < 2; ++ai)
#pragma unroll
                for (int m = 0; m < 4; ++m) { bf16* rowp = base + (size_t)(row0 + ai * HALF + m * 16) * ldc + cl;
#pragma unroll
                    for (int bj = 0; bj < 2; ++bj) { const f32x4 v0 = acc[ai][bj][m][0], v1 = acc[ai][bj][m][1]; v4u w;
                        w.x = cvtpk(v0[0], v0[1]); w.y = cvtpk(v0[2], v0[3]); w.z = cvtpk(v1[0], v1[1]); w.w = cvtpk(v1[2], v1[3]);
                        *(v4u*)(rowp + bj * HALF) = w;
                        const int rr = (row0 + ai * HALF + m * 16) & 255;
                        if (pn < 24 && (rr == 0 || rr == 255)) *(v4u*)(HB + (size_t)(2 * u.pm + (rr & 1)) * SSD_CONV + pn * 256 + cl + bj * HALF) = w; }
                    asm volatile("" ::: "memory"); }
        } else {
            const f32x4 b0 = *(const f32x4*)(dt_bias + cl), b1 = *(const f32x4*)(dt_bias + cl + 4);
#pragma unroll
            for (int ai = 0; ai < 2; ++ai)
#pragma unroll
                for (int m = 0; m < 4; ++m) { float* rowp = DT + (size_t)(row0 + ai * HALF + m * 16) * 128 + cl;
#pragma unroll
                    for (int n = 0; n < 2; ++n) { f32x4 v = acc[ai][0][m][n] + (n ? b1 : b0), o;
#pragma unroll
                        for (int j = 0; j < 4; ++j) { const float x = v[j]; o[j] = fmaxf(x, 0.f) + log1pf(__expf(-fabsf(x))); }
                        *(f32x4*)(rowp + 4 * n) = o; }
                    asm volatile("" ::: "memory"); }
        }
    }
};
struct EpiHgrn {
    static constexpr bool PERM = true, AFTER_DRAIN = false;
    _Float16* LG; bf16* VQG; const float* lbv;
    DI void operator()(const f32x4 (&acc)[2][2][4][2], const Unit& u, int wr, int wc, int fr, int fq) const {
        const int pn = u.pn, row0 = u.pm * BM + wr * 64 + fr, cl = wc * 32 + 8 * fq;
        if (pn < 16) {
            const int dir = pn >> 3, cb = (pn & 7) * 256;
#pragma unroll
            for (int bj = 0; bj < 2; ++bj) {
                const f32x4 l0 = *(const f32x4*)(lbv + dir * D + cb + bj * HALF + cl), l1 = *(const f32x4*)(lbv + dir * D + cb + bj * HALF + cl + 4);
#pragma unroll
                for (int ai = 0; ai < 2; ++ai)
#pragma unroll
                    for (int m = 0; m < 4; ++m) { float o[8];
#pragma unroll
                        for (int n = 0; n < 2; ++n)
#pragma unroll
                            for (int j = 0; j < 4; ++j) { const float f = acc[ai][bj][m][n][j], lb = n ? l1[j] : l0[j];
                                const float e = __builtin_amdgcn_exp2f(-f * LOG2E);
                                o[4 * n + j] = (1.f - lb) * e * __builtin_amdgcn_rcpf(1.f + e); }
                        v4u w; w.x = pkh(o[0], o[1]); w.y = pkh(o[2], o[3]); w.z = pkh(o[4], o[5]); w.w = pkh(o[6], o[7]);
                        *(v4u*)(LG + ((size_t)dir * TT + row0 + ai * HALF + m * 16) * D + cb + bj * HALF + cl) = w;
                        asm volatile("" ::: "memory"); }
            }
        } else {
            const int t = (pn - 16) >> 3, cb = (pn & 7) * 256; bf16* base = VQG + (size_t)t * TT * D + cb;
#pragma unroll
            for (int ai = 0; ai < 2; ++ai)
#pragma unroll
                for (int m = 0; m < 4; ++m) { bf16* rowp = base + (size_t)(row0 + ai * HALF + m * 16) * D + cl;
#pragma unroll
                    for (int bj = 0; bj < 2; ++bj) { f32x4 v0 = acc[ai][bj][m][0], v1 = acc[ai][bj][m][1];
                        if (t == 1) {
#pragma unroll
                            for (int j = 0; j < 4; ++j) { v0[j] = silu_f(v0[j]); v1[j] = silu_f(v1[j]); } }
                        v4u w; w.x = cvtpk(v0[0], v0[1]); w.y = cvtpk(v0[2], v0[3]); w.z = cvtpk(v1[0], v1[1]); w.w = cvtpk(v1[2], v1[3]);
                        *(v4u*)(rowp + bj * HALF) = w; }
                    asm volatile("" ::: "memory"); }
        }
    }
};

struct Frame {
    LAS unsigned char* lds;
    volatile LAS unsigned* MISC;
    gu32* ctl;
    int wave, G, gw, NGW;
};

DI void mod_partial_phase(const Frame& F, const float* c, const float* cctx, const float* ada_w, float* modp) {
    const int lane = lane_id();
    for (int it = F.gw; it < 4 * 48 * 8; it += F.NGW) {
        const int cb = it % 48, ks = (it / 48) & 7, l = it / (8 * 48);
        f32x4 acc[17];
#pragma unroll
        for (int b = 0; b < 17; ++b) acc[b] = (f32x4){0.f, 0.f, 0.f, 0.f};
        const float* W = ada_w + (size_t)l * D * NMODC + cb * 256 + lane * 4;
        for (int kb = 0; kb < 4; ++kb) {
            const int k0 = ks * 256 + kb * 64;
            float sv[17];
#pragma unroll
            for (int b = 0; b < 16; ++b) { const float x = c[b * D + k0 + lane]; sv[b] = x / (1.f + __expf(-x)); }
            { const float x = cctx[k0 + lane]; sv[16] = x / (1.f + __expf(-x)); }
            for (int jj = 0; jj < 64; jj += 8) {
                f32x4 w[8];
#pragma unroll
                for (int q = 0; q < 8; ++q) w[q] = *(const f32x4*)(W + (size_t)(k0 + jj + q) * NMODC);
#pragma unroll
                for (int q = 0; q < 8; ++q)
#pragma unroll
                    for (int b = 0; b < 17; ++b) { const float s = __int_as_float(__builtin_amdgcn_readlane(__float_as_int(sv[b]), jj + q)); acc[b] += w[q] * s; }
            }
        }
#pragma unroll
        for (int b = 0; b < 17; ++b) *(f32x4*)(modp + (((size_t)ks * 4 + l) * 17 + b) * NMODC + cb * 256 + lane * 4) = acc[b];
    }
}

DI int srcmap(int kind, int n) {
    if (kind == 0) return n;
    if (kind == 1) { const int t = n >> 8, w = n & 255; return w < 128 ? 128 * t + w : FFN + 128 * t + (w - 128); }
    if (n < SSD_CONV) return n;
    if (n < SSD_CONV + SSD_DI) return n + 128;
    if (n < SSD_INS) return n - SSD_DI;
    return -1;
}
struct ConvItem { const float* src; bf16* dst; int Nsrc, K; };
DI ConvItem conv_decode(const float* W, int K, int Nsrc, int Ndst, bf16* WT, int kind, int item) {
    const int nblk = Ndst / 32, kb = item / nblk, nb = item % nblk, k0 = 64 * kb, n0 = 32 * nb, s0 = srcmap(kind, n0);
    return ConvItem{s0 >= 0 ? W + (size_t)k0 * Nsrc + s0 : nullptr, WT + (size_t)n0 * K + k0, Nsrc, K};
}
DI void conv_load(const ConvItem& c, f32x4 (&v)[8], int lane) {
    const float* src = c.src + (size_t)(lane >> 3) * c.Nsrc + 4 * (lane & 7);
#pragma unroll
    for (int i = 0; i < 8; ++i) v[i] = c.src ? *(const f32x4*)(src + (size_t)(8 * i) * c.Nsrc) : (f32x4){0.f, 0.f, 0.f, 0.f};
}
DI void conv_finish(const ConvItem& c, const f32x4 (&v)[8], LAS unsigned char* scr, int lane) {
    const int r32 = lane & 31, h = lane >> 5, q4 = (lane & 15) >> 2, p4 = lane & 3, blk = (lane >> 4) & 1;
    bf16* dst = c.dst + (size_t)r32 * c.K + 8 * h;
#pragma unroll
    for (int half = 0; half < 2; ++half) {
#pragma unroll
        for (int i = 0; i < 4; ++i) *(LAS u32x2*)(scr + (8 * i + (lane >> 3)) * 80 + 8 * (lane & 7)) = (u32x2){cvtpk(v[4 * half + i][0], v[4 * half + i][1]), cvtpk(v[4 * half + i][2], v[4 * half + i][3])};
        LDS_WAIT(); asm volatile("" ::: "memory");
#pragma unroll
        for (int cc = 0; cc < 2; ++cc) { LAS unsigned char* p = scr + (16 * cc + 8 * h + q4) * 80 + (16 * blk + 4 * p4) * 2;
            const bf16x8 o = cat8(tr16(p), tr16(p + 4 * 80)); *(GAS bf16x8*)(dst + 16 * (2 * half + cc)) = o; }
        LDS_WAIT(); asm volatile("" ::: "memory");
    }
}
DI ConvItem conv16_decode(const float* W, int K, int Nsrc, int Ndst, bf16* WT, int kind, int item) {
    const int nblk = Ndst / 16, kb = item / nblk, nb = item % nblk, k0 = 64 * kb, n0 = 16 * nb, s0 = srcmap(kind, n0);
    return ConvItem{s0 >= 0 ? W + (size_t)k0 * Nsrc + s0 : nullptr, WT + (size_t)n0 * K + k0, Nsrc, K};
}
DI void conv16_load(const ConvItem& c, f32x4 (&v)[4], int lane) {
    const float* src = c.src + (size_t)(lane >> 2) * c.Nsrc + 4 * (lane & 3);
#pragma unroll
    for (int i = 0; i < 4; ++i) v[i] = c.src ? *(const f32x4*)(src + (size_t)(16 * i) * c.Nsrc) : (f32x4){0.f, 0.f, 0.f, 0.f};
}
DI void conv16_finish(bf16* dst0, int K, const f32x4 (&v)[4], LAS unsigned char* scr, int lane) {
#pragma unroll
    for (int i = 0; i < 4; ++i) *(LAS u32x2*)(scr + (16 * i + (lane >> 2)) * 40 + 8 * (lane & 3)) = (u32x2){cvtpk(v[i][0], v[i][1]), cvtpk(v[i][2], v[i][3])};
    LDS_WAIT(); asm volatile("" ::: "memory");
    const int n = lane & 15, kq = lane >> 4, q4 = (lane & 15) >> 2, p4 = lane & 3;
    bf16* dst = dst0 + (size_t)n * K + 8 * kq;
#pragma unroll
    for (int cc = 0; cc < 2; ++cc) { LAS unsigned char* p = scr + (32 * cc + 8 * kq + q4) * 40 + 8 * p4;
        const bf16x8 o = cat8(tr16(p), tr16(p + 4 * 40)); *(GAS bf16x8*)(dst + 32 * cc) = o; }
    LDS_WAIT(); asm volatile("" ::: "memory");
}
template <int OFF> DI const float* inp_load() { const GAS float* p; asm volatile("s_load_dwordx2 %0, %1, %2\n\ts_waitcnt lgkmcnt(0)" : "=s"(p) : "s"(__builtin_amdgcn_kernarg_segment_ptr()), "n"(OFF)); return (const float*)p; }
#define INP(k) inp_load<(k) * 8>()

constexpr int I_FI = (D / 64) * (2 * FFN / 32), I_FO = (FFN / 64) * (D / 32), I_AI = (D / 64) * (ATT_IN / 32), I_AO = (D / 64) * (D / 32);
constexpr int I_SI = (D / 64) * (SSD_INP / 32), I_SO = (SSD_DI / 64) * (D / 32), I_HI = (D / 64) * (HG_IN / 32), I_HO = I_AO;
template <bool N16> DI int conv_group_items(int l) { if (N16) return 2 * conv_group_items<false>(l); const int k = l % 3; return I_FI + I_FO + (k == 0 ? I_AI + I_AO : (k == 1 ? I_SI + I_SO : I_HI + I_HO)); }
template <bool N16> DI ConvItem conv_group_decode(unsigned char* ws, int l, int r) {
    constexpr int S = N16 ? 2 : 1;
#define CDEC(...) (N16 ? conv16_decode(__VA_ARGS__) : conv_decode(__VA_ARGS__))
    bf16* wf = (bf16*)(ws + WS_WFFN + (size_t)l * (W_FFN_IN + W_FFN_OUT));
    if (r < S * I_FI) return CDEC(INP(7) + (size_t)l * D * 2 * FFN, D, 2 * FFN, 2 * FFN, wf, 1, r);
    r -= S * I_FI;
    if (r < S * I_FO) return CDEC(INP(8) + (size_t)l * FFN * D, FFN, D, D, (bf16*)((unsigned char*)wf + W_FFN_IN), 0, r);
    r -= S * I_FO;
    const int k = l % 3, j = l / 3;
    if (k == 0) { bf16* wb = (bf16*)(ws + WS_WATT + (size_t)j * (W_ATT_IN + W_ATT_OUT));
        if (r < S * I_AI) return CDEC(INP(9) + (size_t)j * D * ATT_IN, D, ATT_IN, ATT_IN, wb, 0, r);
        return CDEC(INP(10) + (size_t)j * D * D, D, D, D, (bf16*)((unsigned char*)wb + W_ATT_IN), 0, r - S * I_AI); }
    if (k == 1) {
        if (r < S * I_SI) return CDEC(INP(12), D, SSD_INS, SSD_INP, (bf16*)(ws + WS_WSSD), 2, r);
        return CDEC(INP(19), SSD_DI, D, D, (bf16*)(ws + WS_WSSD + W_SSD_IN), 0, r - S * I_SI); }
    if (r < S * I_HI) return CDEC(INP(20), D, HG_IN, HG_IN, (bf16*)(ws + WS_WHG), 0, r);
    return CDEC(INP(23), D, D, D, (bf16*)(ws + WS_WHG + W_HG_IN), 0, r - S * I_HI);
#undef CDEC
}
#ifndef BG_CONV
#define BG_CONV 1
#endif
#ifndef BG_SSD
#define BG_SSD 4
#endif
#ifndef BG_HG
#define BG_HG 1
#endif
#ifndef BG_ATT
#define BG_ATT 1
#endif
struct BgConv {
    int l, it;
    DI static unsigned char* wsp() { return (unsigned char*)inp_load<200>(); }
    DI static int wave() { return __builtin_amdgcn_readfirstlane((int)threadIdx.x >> 6); }
    DI static LAS unsigned char* scrp() { extern __shared__ __attribute__((aligned(16))) unsigned char lds_raw[]; return (LAS unsigned char*)lds_raw + CONV_SCR_OFF + wave() * CONV_SCR_WAVE; }
    DI int end() const { return (BG_CONV && l < DEPTH) ? conv_group_items<true>(l) : 0; }
    DI void init(int layer) { l = layer; it = (int)blockIdx.x * NWAVES + wave(); }
    DI void tail() {}
    struct Tok { f32x4 v[4]; };
    DI Tok pre() { Tok t; if (it < end()) { const ConvItem c = conv_group_decode<true>(wsp(), l, it); conv16_load(c, t.v, lane_id()); } return t; }
    DI void post(const Tok& t) { if (it < end()) { const ConvItem c = conv_group_decode<true>(wsp(), l, it); conv16_finish(c.dst, c.K, t.v, scrp(), lane_id()); it += (int)gridDim.x * NWAVES; } }
    DI void drain() {
        unsigned char* ws = wsp(); LAS unsigned char* scr = scrp(); const int step = (int)gridDim.x * NWAVES, e = end();
        while (it < e) {
            const int lane = lane_id();
            const ConvItem c0 = conv_group_decode<true>(ws, l, it); f32x4 v0[4]; conv16_load(c0, v0, lane);
            const int it1 = it + step;
            if (it1 < e) { const ConvItem c1 = conv_group_decode<true>(ws, l, it1); f32x4 v1[4]; conv16_load(c1, v1, lane);
                conv16_finish(c0.dst, c0.K, v0, scr, lane); conv16_finish(c1.dst, c1.K, v1, scr, lane); }
            else conv16_finish(c0.dst, c0.K, v0, scr, lane);
            it += 2 * step;
        }
    }
};
DI void prologue_phase(const Frame& F, unsigned char* ws) {
    LAS unsigned char* scr = F.lds + CONV_SCR_OFF + F.wave * CONV_SCR_WAVE;
    const int lane = lane_id(); const int gt = F.gw * 64 + lane, NGT = F.NGW * 64;
    { const float* modp = (const float*)(ws + WS_MODP); float* mod = (float*)(ws + WS_MOD); const float* ada_b = INP(5);
      for (int i = gt; i < 4 * 17 * NMODC / 4; i += NGT) {
          const int e = i * 4, l = e / (17 * NMODC), n = e % NMODC;
          f32x4 s = *(const f32x4*)(ada_b + l * NMODC + n);
#pragma unroll
          for (int ks = 0; ks < 8; ++ks) s += *(const f32x4*)(modp + (size_t)ks * 4 * 17 * NMODC + e);
          *(f32x4*)(mod + e) = s; } }
    { float* tab = (float*)(ws + WS_TAB);
      if (gt < 1024) { const int pos = gt >> 4, p = gt & 15; const float invf = powf(10000.f, -(float)p / 16.f); const float ang = (float)pos * invf; tab[2 * gt] = cosf(ang); tab[2 * gt + 1] = sinf(ang); }
      float* lbv = (float*)(ws + WS_TAB + 16384); const float* lbr = INP(21);
      if (gt < 2 * D) { const int dir = gt >> 11, d = gt & 2047; float v[4], mx = -1e30f;
#pragma unroll
          for (int l = 0; l < 4; ++l) { v[l] = lbr[(dir * 4 + l) * D + d]; mx = fmaxf(mx, v[l]); }
          float e[4], sum = 0.f;
#pragma unroll
          for (int l = 0; l < 4; ++l) { e[l] = expf(v[l] - mx); sum += e[l]; }
          lbv[gt] = (e[1] + e[2]) / sum; } }
    for (int l = 0; l < (BG_CONV ? (BG_ATT ? 1 : 2) : DEPTH); ++l) {
        const int NIT = conv_group_items<false>(l);
        if (F.gw < NIT) {
            ConvItem cur = conv_group_decode<false>(ws, l, F.gw); f32x4 v[8]; conv_load(cur, v, lane);
            for (int it = F.gw; it < NIT; it += F.NGW) {
                const int nit = it + F.NGW; ConvItem nxt = cur; f32x4 vn[8];
                if (nit < NIT) { nxt = conv_group_decode<false>(ws, l, nit); conv_load(nxt, vn, lane); }
                conv_finish(cur, v, scr, lane);
                cur = nxt;
#pragma unroll
                for (int i = 0; i < 8; ++i) v[i] = vn[i];
            }
        }
    }
}

template <int MODE, bool YSC1 = false>
DI void norm_range(int wbeg, int wend, int nrows, const bf16* y, const float* ysplit, const float* xin_lat, const float* xin_ctx, bf16* xb_lat, bf16* xb_ctx, bf16* xd_lat, float* out_f32,
                   const float* mod_a, int gate_idx, const float* gpost, const float* mod_b, int shift_idx, const float* gpre, bf16* u) {
    constexpr bool HAS_Y = MODE != 0, HAS_U = MODE != 2;
    const int lane = lane_id();
    unsigned vo2 = (unsigned)lane * 16u, vo4 = (unsigned)lane * 32u;
#define NP_B16(p, m) (*(const v4u*)((const unsigned char*)(p) + vo2 + 1024 * (m)))
#define NP_Y16(p, m) (YSC1 ? ({ const unsigned long long* q_ = (const unsigned long long*)((const unsigned char*)(p) + vo2 + 1024 * (m)); const unsigned long long a_ = __hip_atomic_load(q_, __ATOMIC_RELAXED, __HIP_MEMORY_SCOPE_AGENT), b_ = __hip_atomic_load(q_ + 1, __ATOMIC_RELAXED, __HIP_MEMORY_SCOPE_AGENT); (v4u){(unsigned)a_, (unsigned)(a_ >> 32), (unsigned)b_, (unsigned)(b_ >> 32)}; }) : NP_B16(p, m))
#define NP_B(p, k) (*(const u32x2*)((const unsigned char*)(p) + vo2 + 1024 * ((k) >> 1) + 8 * ((k) & 1)))
#define NP_F(p, k) (*(const f32x4*)((const unsigned char*)(p) + vo4 + 2048 * ((k) >> 1) + 16 * ((k) & 1)))
    for (int r0 = wbeg; r0 < wend;) {
        const int mb = r0 < TLAT ? (r0 >> 11) : 16; const bool lat = r0 < TLAT;
        const int bend = lat ? ((r0 >> 11) + 1) << 11 : nrows, rend = wend < bend ? wend : bend, nr = rend - r0;
        asm volatile("" : "+v"(vo2), "+v"(vo4));
        f32x4 GG[8], AA[8], SH[8];
        { const float* ga = HAS_Y ? mod_a + (size_t)mb * NMODC + gate_idx * D : nullptr; const float* sc = HAS_U ? mod_b + (size_t)mb * NMODC + (shift_idx + 1) * D : nullptr;
          const float* sh = HAS_U ? mod_b + (size_t)mb * NMODC + shift_idx * D : nullptr;
#pragma unroll
          for (int k = 0; k < 8; ++k) {
              if (HAS_Y) GG[k] = NP_F(ga, k) * NP_F(gpost, k);
              if (HAS_U) { AA[k] = NP_F(gpre, k) * (NP_F(sc, k) + 1.f); SH[k] = NP_F(sh, k); } } }
        const size_t rl = lat ? (size_t)r0 : (size_t)(r0 - TLAT);
        bf16* xb = (lat ? xb_lat : xb_ctx) + rl * D;
        bf16* xw = (lat ? xd_lat : xb_ctx) + rl * D;
        const float* xin = MODE == 0 ? (lat ? xin_lat : xin_ctx) + rl * D : nullptr;
        const bf16* yp = HAS_Y ? y + (size_t)r0 * D : nullptr;
        f32x4 xf[8]; u32x2 xr[8], yr[8];
        const float* ysp = (HAS_Y && ysplit && !lat) ? ysplit + rl * D : nullptr;
#define NP_Y(rowoff, k) (ysp ? ({ const f32x4 s_ = NP_F(ysp + (size_t)(rowoff) * D, k) + NP_F(ysp + (size_t)TCTX * D + (size_t)(rowoff) * D, k); (u32x2){cvtpk(s_[0], s_[1]), cvtpk(s_[2], s_[3])}; }) : NP_B(yp + (size_t)(rowoff) * D, k))
#pragma unroll
        for (int k = 0; k < 8; ++k) { if (MODE == 0) xf[k] = NP_F(xin, k); if (HAS_Y && ysp) yr[k] = NP_Y(0, k); }
#pragma unroll
        for (int m = 0; m < 4; ++m) { if (MODE != 0) { const v4u t = NP_B16(xb, m); xr[2 * m] = (u32x2){t.x, t.y}; xr[2 * m + 1] = (u32x2){t.z, t.w}; }
            if (HAS_Y && !ysp) { const v4u t = NP_Y16(yp, m); yr[2 * m] = (u32x2){t.x, t.y}; yr[2 * m + 1] = (u32x2){t.z, t.w}; } }
        for (int rr = 0; rr < nr; ++rr) {
            asm volatile("" : "+v"(vo2), "+v"(vo4));
            f32x4 x[8]; u32x2 yc[8];
#pragma unroll
            for (int k = 0; k < 8; ++k) { x[k] = MODE == 0 ? xf[k] : (f32x4){bflo(xr[k].x), bfhi(xr[k].x), bflo(xr[k].y), bfhi(xr[k].y)};
                if (HAS_Y) yc[k] = yr[k]; }
            if (rr + 1 < nr) {
#pragma unroll
                for (int k = 0; k < 8; ++k) { if (MODE == 0) xf[k] = NP_F(xin + (size_t)(rr + 1) * D, k); if (HAS_Y && ysp) yr[k] = NP_Y(rr + 1, k); }
#pragma unroll
                for (int m = 0; m < 4; ++m) { if (MODE != 0) { const v4u t = NP_B16(xb + (size_t)(rr + 1) * D, m); xr[2 * m] = (u32x2){t.x, t.y}; xr[2 * m + 1] = (u32x2){t.z, t.w}; }
                    if (HAS_Y && !ysp) { const v4u t = NP_Y16(yp + (size_t)(rr + 1) * D, m); yr[2 * m] = (u32x2){t.x, t.y}; yr[2 * m + 1] = (u32x2){t.z, t.w}; } } }
            if (HAS_Y) {
                float ss = 0.f;
#pragma unroll
                for (int k = 0; k < 8; ++k) { const float a0 = bflo(yc[k].x), a1 = bfhi(yc[k].x), a2 = bflo(yc[k].y), a3 = bfhi(yc[k].y); ss += (a0 * a0 + a1 * a1) + (a2 * a2 + a3 * a3); }
                const float rs = 1.f / sqrtf(wave_sum(ss) * (1.f / D) + RMS_EPS);
#pragma unroll
                for (int k = 0; k < 8; ++k) x[k] += GG[k] * (f32x4){bflo(yc[k].x), bfhi(yc[k].x), bflo(yc[k].y), bfhi(yc[k].y)} * rs;
            }
            if (MODE == 2) { float* od = out_f32 + (size_t)(r0 + rr) * D;
#pragma unroll
                for (int k = 0; k < 8; ++k) *(f32x4*)((unsigned char*)od + vo4 + 2048 * (k >> 1) + 16 * (k & 1)) = x[k];
            } else {
#pragma unroll
                for (int m = 0; m < 4; ++m) { const f32x4 xa = x[2 * m], xc = x[2 * m + 1]; *(v4u*)((unsigned char*)(xw + (size_t)rr * D) + vo2 + 1024 * m) = (v4u){cvtpk(xa[0], xa[1]), cvtpk(xa[2], xa[3]), cvtpk(xc[0], xc[1]), cvtpk(xc[2], xc[3])}; }
            }
            if (HAS_U) {
                float ss = 0.f;
#pragma unroll
                for (int k = 0; k < 8; ++k) ss += (x[k][0] * x[k][0] + x[k][1] * x[k][1]) + (x[k][2] * x[k][2] + x[k][3] * x[k][3]);
                const float rs = 1.f / sqrtf(wave_sum(ss) * (1.f / D) + RMS_EPS);
                bf16* up = u + (size_t)(r0 + rr) * D;
#pragma unroll
                for (int m = 0; m < 4; ++m) { const f32x4 oa = x[2 * m] * rs * AA[2 * m] + SH[2 * m], oc = x[2 * m + 1] * rs * AA[2 * m + 1] + SH[2 * m + 1];
                    *(v4u*)((unsigned char*)up + vo2 + 1024 * m) = (v4u){cvtpk(oa[0], oa[1]), cvtpk(oa[2], oa[3]), cvtpk(oc[0], oc[1]), cvtpk(oc[2], oc[3])}; }
            }
        }
        r0 = rend;
    }
#undef NP_B
#undef NP_B16
#undef NP_F
#undef NP_Y
#undef NP_Y16
}
template <int MODE>
DI void norm_phase(const Frame& F, int nrows, const bf16* y, const float* ysplit, const float* xin_lat, const float* xin_ctx, bf16* xb_lat, bf16* xb_ctx, bf16* xd_lat, float* out_f32,
                   const float* mod_a, int gate_idx, const float* gpost, const float* mod_b, int shift_idx, const float* gpre, bf16* u) {
    const int per = (nrows + F.NGW - 1) / F.NGW, wbeg = F.gw * per < nrows ? F.gw * per : nrows, wend = wbeg + per < nrows ? wbeg + per : nrows;
    norm_range<MODE>(wbeg, wend, nrows, y, ysplit, xin_lat, xin_ctx, xb_lat, xb_ctx, xd_lat, out_f32, mod_a, gate_idx, gpost, mod_b, shift_idx, gpre, u);
}

#ifndef NT_ON
#define NT_ON 1
#endif
#ifndef NT_TAIL
#define NT_TAIL 1
#endif
#ifndef NT_N2_WHOLE
#define NT_N2_WHOLE 1
#endif
#ifndef NT_N2
#define NT_N2 3
#endif
static_assert(D / 256 == 8 && pg8::WGM == 4 && ((TT / 256) * (D / 256)) % (16 * pg8::NXCD) == 0, "CountOrder's 16-tile runs");
constexpr int NT_NWG = (TT / 256) * (D / 256), NT_Q = NT_NWG / pg8::NXCD, NT_LAST = (NT_NWG % 256) / pg8::NXCD, NT_SPIN = 800;
DI bool panel_late(int pm) {
    const int g = pm / pg8::WGM; bool late = false;
#pragma unroll
    for (int x = 0; x < pg8::NXCD; ++x) { const int lo = (x * NT_Q + NT_Q - NT_LAST) / (pg8::WGM * (D / 256)), hi = (x * NT_Q + NT_Q - 1) / (pg8::WGM * (D / 256)); late |= (NT_LAST > 0) && g >= lo && g <= hi; }
    return late;
}
template <int WHICH>
struct NormTail {
    int l, idle, k;
    const CountOrder* sc;
    struct Tok {}; DI Tok pre() { return Tok{}; } DI void post(const Tok&) {}
    DI void tail() {
        if (NT_DEFER) sc->flush();
        if (!idle) return;
        const int xa = (int)blockIdx.x % pg8::NXCD, j = k / pg8::NXCD;
        const int pm = 2 * (xa * NT_Q / 16) + j;
        if (j >= 2 * ((NT_Q - NT_LAST) / 16) || pm >= TT / 256) return;
        unsigned char* ws = BgConv::wsp(); unsigned* ctl = (unsigned*)(ws + WS_CTL);
        extern __shared__ __attribute__((aligned(16))) unsigned char lds_raw[];
        volatile LAS unsigned* flag = (volatile LAS unsigned*)((LAS unsigned char*)lds_raw + MISC_OFF) + 16;
        if (threadIdx.x == 0) { unsigned ok = 0u; unsigned* slot = ctl + CW_PCNT + (l * 2 + WHICH) * 4096 + pm * 16;
            for (int sp = 0; sp < NT_SPIN; ++sp) {
                if (__hip_atomic_load(slot + sc->xcc, __ATOMIC_RELAXED, __HIP_MEMORY_SCOPE_AGENT) >= 64u) { ok = 1u; break; }
                if ((sp & 15) == 15) { unsigned tot = 0u; for (int q = 0; q < 16; ++q) tot += __hip_atomic_load(slot + q, __ATOMIC_RELAXED, __HIP_MEMORY_SCOPE_AGENT); if (tot >= 64u && __hip_atomic_load(slot + sc->xcc, __ATOMIC_RELAXED, __HIP_MEMORY_SCOPE_AGENT) < 64u) break; }
                __builtin_amdgcn_s_sleep(8); }
            __builtin_amdgcn_fence(__ATOMIC_ACQUIRE, "agent"); asm volatile("s_waitcnt vmcnt(0)" ::: "memory");
            *flag = ok; }
        __syncthreads();
        const unsigned ok = *flag;
        if (!ok) return;
        const int w = __builtin_amdgcn_readfirstlane((int)threadIdx.x >> 6), kind = l % 3;
        const float* mod = (const float*)(ws + WS_MOD); const float* modl = mod + (size_t)l * 17 * NMODC;
        bf16* xbl = (bf16*)inp_load<192>();
        for (int hf = 0; hf < ((WHICH || kind == 1 || NT_N2_WHOLE) ? 2 : 1); ++hf) {
            const int r0 = pm * 256 + 128 * hf + 16 * w;
            if (WHICH) norm_range<1, NT_WT != 0>(r0, r0 + 16, TT, (const bf16*)(ws + F_Y), nullptr, nullptr, nullptr, xbl, (bf16*)(ws + WS_H), xbl, nullptr,
                                                 modl, 5, INP(6) + (l * 4 + 3) * D, modl + 17 * NMODC, 0, INP(6) + ((l + 1) * 4 + 0) * D, (bf16*)(ws + WS_U2));
            else norm_range<1, NT_WT != 0>(r0, r0 + 16, TT, (const bf16*)(ws + (kind == 0 ? A_Y : (kind == 1 ? S_XBC : H_V))), nullptr, nullptr, nullptr, xbl, (bf16*)(ws + WS_H), xbl, nullptr,
                                           modl, 2, INP(6) + (l * 4 + 1) * D, modl, 3, INP(6) + (l * 4 + 2) * D, (bf16*)(ws + (kind == 1 ? S_Z : WS_U2)));
            __syncthreads();
            if (threadIdx.x == 0) ctl[CW_PDONE + (l * 2 + WHICH) * 512 + 2 * pm + hf] = 1u;
        }
    }
};
DI void norm_rest_phase(const Frame& F, int l, int which, const bf16* y, bf16* xb_lat, bf16* xb_ctx, const float* mod_a, int gate_idx, const float* gpost, const float* mod_b, int shift_idx, const float* gpre, bf16* u) {
    const unsigned* done = (const unsigned*)F.ctl + CW_PDONE + (l * 2 + which) * 512;
    LAS unsigned* list = (LAS unsigned*)F.lds;
    const int lane = lane_id();
    constexpr int NHP = 2 * (TT / 256);
    if (F.wave == 0) { int base = 0;
#pragma unroll
        for (int j = 0; j < (NHP + 63) / 64; ++j) { const int p = lane + 64 * j; const bool nd = p < NHP && done[p < NHP ? p : 0] == 0u; const unsigned long long m = __ballot(nd);
            if (nd) list[base + __popcll(m & ((1ull << lane) - 1ull))] = (unsigned)p; base += __popcll(m); }
        if (lane == 0) list[320] = (unsigned)base; }
    __syncthreads();
    const int P = __builtin_amdgcn_readfirstlane((int)list[320]), R = P * 128;
    const int per = (R + F.NGW - 1) / F.NGW; int cr = F.gw * per < R ? F.gw * per : R; const int cend = cr + per < R ? cr + per : R;
    while (cr < cend) {
        const int o = cr & 127, hp = __builtin_amdgcn_readfirstlane((int)list[cr >> 7]), n = (cend - cr) < (128 - o) ? (cend - cr) : (128 - o), r0 = hp * 128 + o;
        norm_range<1>(r0, r0 + n, TT, y, nullptr, nullptr, nullptr, xb_lat, xb_ctx, xb_lat, nullptr, mod_a, gate_idx, gpost, mod_b, shift_idx, gpre, u);
        cr += n;
    }
    __syncthreads();
}

#ifndef AT_THR
#define AT_THR 16.f
#endif
#ifndef T5_STATIC
#define T5_STATIC 1
#endif
constexpr int AT_KP = 144, AT_VP = 648, AT_LV = 320 * AT_KP;
#define AT_BAR() do { asm volatile("s_waitcnt lgkmcnt(0)" ::: "memory"); __builtin_amdgcn_s_barrier(); asm volatile("" ::: "memory"); } while (0)
DI void attn_phase(const Frame& F, const bf16* Kb, const bf16* Qb, const bf16* VtL, const bf16* VtC, const float* sink, bf16* O, bool need_ctx, BgConv& bg) {
    const int lane0 = lane_id(), wid = F.wave;
    if (T5_STATIC && wid >= 4) __builtin_amdgcn_s_setprio(1);
    LAS unsigned char* ldsK = F.lds; LAS unsigned char* ldsV = F.lds + AT_LV;
    const int nunits = need_ctx ? 2304 : 2048;
    v4u pk[5], pvv[5];
#define AT_LOAD(un_, pass_, tid_) do { const int u_ = (un_); int b_, q0_, kvh_; \
        if (u_ < 2048) { kvh_ = u_ & 3; q0_ = ((u_ >> 2) & 31) * 64; b_ = u_ >> 7; } else { const int v_ = u_ - 2048; kvh_ = v_ & 3; q0_ = ((v_ >> 2) & 3) * 64; b_ = v_ >> 4; } \
        if ((pass_) == 0) { \
            _Pragma("unroll") for (int i_ = 0; i_ < 5; ++i_) { const int idx_ = (tid_) + 512 * i_, row_ = idx_ >> 3, part_ = idx_ & 7, s_ = q0_ - 128 + row_; \
                pk[i_] = (s_ >= 0 && s_ < SEQ) ? *(const v4u*)(Kb + (size_t)(b_ * SEQ + s_) * 256 + kvh_ * 64 + part_ * 8) : (v4u){0u, 0u, 0u, 0u}; \
                const int d_ = idx_ / 40, pv_ = idx_ % 40, s0_ = q0_ - 128 + pv_ * 8; \
                pvv[i_] = (s0_ >= 0 && s0_ < SEQ) ? *(const v4u*)(VtL + ((size_t)((b_ * 4 + kvh_) * 64 + d_)) * SEQ + s0_) : (v4u){0u, 0u, 0u, 0u}; } \
        } else { \
            _Pragma("unroll") for (int i_ = 0; i_ < 4; ++i_) { const int idx_ = (tid_) + 512 * i_; \
                pk[i_] = *(const v4u*)(Kb + (size_t)(TLAT + b_ * CTXL + (idx_ >> 3)) * 256 + kvh_ * 64 + (idx_ & 7) * 8); \
                pvv[i_] = *(const v4u*)(VtC + ((size_t)((b_ * 4 + kvh_) * 64 + (idx_ >> 5))) * CTXL + (idx_ & 31) * 8); } \
        } } while (0)
    int un = blockIdx.x, pass = un >= 2048 ? 1 : 0;
    if (un < nunits) AT_LOAD(un, pass, wid * 64 + lane0);
    bf16x8 qf[2][4]; float m_[2], l_[2]; f32x16 o[2][2];
    while (un < nunits) {
        int lane = lane0; asm volatile("" : "+v"(lane));
        const int tid = wid * 64 + lane, r32 = lane & 31, h = lane >> 5;
        const bool cq = un >= 2048; int b, qblk, kvh;
        if (!cq) { kvh = un & 3; qblk = (un >> 2) & 31; b = un >> 7; } else { const int v = un - 2048; kvh = v & 3; qblk = (v >> 2) & 3; b = v >> 4; }
        const int q0 = qblk * 64, hq = kvh * 8 + wid;
        const size_t qrow0 = cq ? (size_t)(TLAT + b * CTXL + q0) : (size_t)(b * SEQ + q0);
        if (pass == (cq ? 1 : 0)) {
#pragma unroll
            for (int rb = 0; rb < 2; ++rb)
#pragma unroll
                for (int d0 = 0; d0 < 4; ++d0) qf[rb][d0] = *(const bf16x8*)(Qb + (qrow0 + 32 * rb + r32) * D + hq * 64 + 16 * d0 + 8 * h);
            const float sk = sink[hq] * LOG2E;
#pragma unroll
            for (int rb = 0; rb < 2; ++rb) { m_[rb] = sk; l_[rb] = h == 0 ? 1.f : 0.f;
#pragma unroll
                for (int db = 0; db < 2; ++db)
#pragma unroll
                    for (int i = 0; i < 16; ++i) o[rb][db][i] = 0.f; }
        }
        AT_BAR();
        if (pass == 0) {
#pragma unroll
            for (int i = 0; i < 5; ++i) { const int idx = tid + 512 * i; *(LAS v4u*)(ldsK + (idx >> 3) * AT_KP + (idx & 7) * 16) = pk[i];
                const int d = idx / 40, part = idx % 40; *(LAS u32x2*)(ldsV + d * AT_VP + part * 16) = (u32x2){pvv[i].x, pvv[i].y}; *(LAS u32x2*)(ldsV + d * AT_VP + part * 16 + 8) = (u32x2){pvv[i].z, pvv[i].w}; }
        } else {
#pragma unroll
            for (int i = 0; i < 4; ++i) { const int idx = tid + 512 * i; *(LAS v4u*)(ldsK + (idx >> 3) * AT_KP + (idx & 7) * 16) = pk[i];
                const int d = idx >> 5, part = idx & 31; *(LAS u32x2*)(ldsV + d * AT_VP + part * 16) = (u32x2){pvv[i].x, pvv[i].y}; *(LAS u32x2*)(ldsV + d * AT_VP + part * 16 + 8) = (u32x2){pvv[i].z, pvv[i].w}; }
        }
        int nun = un, npass = pass + 1;
        if (npass > 1) { nun = un + F.G; npass = nun >= 2048 ? 1 : 0; }
        if (nun < nunits) AT_LOAD(nun, npass, tid);
        AT_BAR();
        const int nkt = pass == 0 ? 10 : 8;
#pragma unroll 2
        for (int kt = 0; kt < nkt; ++kt) {
#if BG_ATT
            const BgConv::Tok tok = bg.pre();
#endif
            bf16x8 kf[4], vf[2][2];
#pragma unroll
            for (int d0 = 0; d0 < 4; ++d0) kf[d0] = lds_frag(ldsK + (32 * kt + r32) * AT_KP + 32 * d0 + 16 * h);
#pragma unroll
            for (int db = 0; db < 2; ++db)
#pragma unroll
                for (int s = 0; s < 2; ++s) { LAS unsigned char* vp = ldsV + (32 * db + r32) * AT_VP + (32 * kt + 16 * s + 4 * h) * 2;
                    const s16x4 vlo = *(LAS s16x4*)vp, vhi = *(LAS s16x4*)(vp + 16);
                    vf[db][s] = (bf16x8){vlo[0], vlo[1], vlo[2], vlo[3], vhi[0], vhi[1], vhi[2], vhi[3]}; }
#pragma unroll
            for (int rb = 0; rb < 2; ++rb) {
                if (pass == 0 && (kt < rb || kt > 8 + rb)) continue;
                const int t = pass == 0 ? kt - rb : kt;
                const int r = 32 * rb + r32;
                const int lo = max(r, 128 - q0), hi = min(r + 256, 2047 + 128 - q0);
                f32x16 p;
                { const float nm = -m_[rb];
#pragma unroll
                  for (int i = 0; i < 16; ++i) p[i] = nm; }
#pragma unroll
                for (int d0 = 0; d0 < 4; ++d0) p = mfma32(kf[d0], qf[rb][d0], p);
                if (pass == 0 && (t == 0 || t == 8 || q0 < 128 || q0 >= SEQ - 192)) {
#pragma unroll
                    for (int i = 0; i < 16; ++i) { const int c = 32 * kt + crow(i, h); if (c < lo || c > hi) p[i] = -INFINITY; }
                }
                float tm = p[0];
#pragma unroll
                for (int i = 1; i < 16; ++i) tm = fmaxf(tm, p[i]);
                tm = swap_max(tm);
                float alpha = 1.f;
                if (__any(tm > AT_THR)) {
                    const float d = fmaxf(tm, 0.f); alpha = __builtin_amdgcn_exp2f(-d); m_[rb] += d;
#pragma unroll
                    for (int i = 0; i < 16; ++i) p[i] -= d;
#pragma unroll
                    for (int db = 0; db < 2; ++db)
#pragma unroll
                        for (int i = 0; i < 16; ++i) o[rb][db][i] *= alpha; }
                float ls = 0.f;
#pragma unroll
                for (int i = 0; i < 16; ++i) { p[i] = __builtin_amdgcn_exp2f(p[i]); ls += p[i]; }
                l_[rb] = l_[rb] * alpha + ls;
                const bf16x8 pf0 = pack8(p, 0), pf1 = pack8(p, 1);
#pragma unroll
                for (int db = 0; db < 2; ++db)
#pragma unroll
                    for (int s = 0; s < 2; ++s) o[rb][db] = mfma32(vf[db][s], s == 0 ? pf0 : pf1, o[rb][db]);
            }
#if BG_ATT
            bg.post(tok);
#endif
        }
        if (pass == 1) {
#pragma unroll
            for (int rb = 0; rb < 2; ++rb) {
                const float inv = 1.f / swap_sum(l_[rb]);
                bf16* orow = O + (qrow0 + 32 * rb + r32) * D + hq * 64;
#pragma unroll
                for (int db = 0; db < 2; ++db)
#pragma unroll
                    for (int g4 = 0; g4 < 4; ++g4) { u32x2 w; w.x = cvtpk(o[rb][db][4 * g4] * inv, o[rb][db][4 * g4 + 1] * inv); w.y = cvtpk(o[rb][db][4 * g4 + 2] * inv, o[rb][db][4 * g4 + 3] * inv);
                        *(u32x2*)(orow + 32 * db + 8 * g4 + 4 * h) = w; }
            }
        }
        un = nun; pass = npass;
    }
#undef AT_LOAD
    if (T5_STATIC) __builtin_amdgcn_s_setprio(0);
    bg.drain();
    __syncthreads();
}

DI void ssd_conv_phase(const Frame& F, bf16* XBC, const bf16* HB, const float* cw, const float* cb) {
    const int lane = lane_id();
    for (int it = F.gw; it < (TT / 256) * 24; it += F.NGW) {
        const int seg = it / 24, col = (it % 24) * 256 + lane * 4;
        const bool first = seg >= TLAT / 256 || (seg & 7) == 0, last = seg >= TLAT / 256 || (seg & 7) == 7;
        const f32x4 w0 = *(const f32x4*)(cw + col), w1 = *(const f32x4*)(cw + SSD_CONV + col), w2 = *(const f32x4*)(cw + 2 * SSD_CONV + col), bb = *(const f32x4*)(cb + col);
        u32x2* base = (u32x2*)(XBC + (size_t)seg * 256 * SSD_CONV + col);
        u32x2 prev = first ? (u32x2){0u, 0u} : *(const u32x2*)(HB + (size_t)(2 * (seg - 1) + 1) * SSD_CONV + col);
        const u32x2 nxt = last ? (u32x2){0u, 0u} : *(const u32x2*)(HB + (size_t)(2 * (seg + 1)) * SSD_CONV + col);
        for (int t0 = 0; t0 < 256; t0 += 32) {
            u32x2 raw[33];
#pragma unroll
            for (int i = 0; i < 32; ++i) raw[i] = base[(size_t)(t0 + i) * (SSD_CONV / 4)];
            raw[32] = (t0 + 32 < 256) ? base[(size_t)(t0 + 32) * (SSD_CONV / 4)] : nxt;
#pragma unroll
            for (int i = 0; i < 32; ++i) {
                const u32x2 a = i == 0 ? prev : raw[i - 1], b = raw[i], c2 = raw[i + 1];
                const float o0 = bb[0] + w0[0] * bflo(a.x) + w1[0] * bflo(b.x) + w2[0] * bflo(c2.x), o1 = bb[1] + w0[1] * bfhi(a.x) + w1[1] * bfhi(b.x) + w2[1] * bfhi(c2.x);
                const float o2 = bb[2] + w0[2] * bflo(a.y) + w1[2] * bflo(b.y) + w2[2] * bflo(c2.y), o3 = bb[3] + w0[3] * bfhi(a.y) + w1[3] * bfhi(b.y) + w2[3] * bfhi(c2.y);
                base[(size_t)(t0 + i) * (SSD_CONV / 4)] = (u32x2){cvtpk(silu_f(o0), silu_f(o1)), cvtpk(silu_f(o2), silu_f(o3))};
            }
            prev = raw[31];
        }
    }
}

DI void ssd_fin_phase(const Frame& F, bf16* Y, const bf16* Z, const float* nw) {
    const int lane = lane_id();
    for (int row = F.gw; row < TT; row += F.NGW) {
#pragma unroll 2
        for (int k = 0; k < 8; ++k) {
            const int col = 512 * k + 8 * lane;
            const v4u yv = *(const v4u*)(Y + (size_t)row * SSD_DI + col), zv = *(const v4u*)(Z + (size_t)row * SSD_DI + col);
            float t[8]; float ss = 0.f;
#pragma unroll
            for (int e = 0; e < 4; ++e) { const unsigned yw = yv[e], zw = zv[e];
                t[2 * e] = bflo(yw) * silu_f(bflo(zw)); t[2 * e + 1] = bfhi(yw) * silu_f(bfhi(zw));
                ss += t[2 * e] * t[2 * e] + t[2 * e + 1] * t[2 * e + 1]; }
            const float rs = 1.f / sqrtf(wave_sum(ss) * (1.f / 512.f) + RMS_EPS);
            const f32x4 n0 = *(const f32x4*)(nw + col), n1 = *(const f32x4*)(nw + col + 4);
            v4u o; o.x = cvtpk(t[0] * rs * n0[0], t[1] * rs * n0[1]); o.y = cvtpk(t[2] * rs * n0[2], t[3] * rs * n0[3]);
            o.z = cvtpk(t[4] * rs * n1[0], t[5] * rs * n1[1]); o.w = cvtpk(t[6] * rs * n1[2], t[7] * rs * n1[3]);
            *(v4u*)(Y + (size_t)row * SSD_DI + col) = o;
        }
    }
}

DI void hgrn_fin_phase(const Frame& F, const bf16* O, const bf16* OG, const float* nw, bf16* Gp) {
    const int lane = lane_id();
    for (int row = F.gw; row < TT; row += F.NGW) {
#pragma unroll
        for (int k = 0; k < 4; ++k) {
            const int col = 512 * k + 8 * lane;
            const v4u of = *(const v4u*)(O + (size_t)row * D + col), ob = *(const v4u*)(O + (size_t)TT * D + (size_t)row * D + col), gv = *(const v4u*)(OG + (size_t)row * D + col);
            const f32x4 n0 = *(const f32x4*)(nw + col), n1 = *(const f32x4*)(nw + col + 4);
            float o[8]; float ss = 0.f;
#pragma unroll
            for (int e = 0; e < 4; ++e) { o[2 * e] = bflo(of[e]) + bflo(ob[e]); o[2 * e + 1] = bfhi(of[e]) + bfhi(ob[e]); ss += o[2 * e] * o[2 * e] + o[2 * e + 1] * o[2 * e + 1]; }
#pragma unroll
            for (int sft = 1; sft < 16; sft <<= 1) ss += __shfl_xor(ss, sft);
            const float rs = 1.f / sqrtf(ss * (1.f / 128.f) + RMS_EPS);
            v4u w;
#pragma unroll
            for (int e = 0; e < 4; ++e) { const float na = e < 2 ? n0[2 * e] : n1[2 * e - 4], nb = e < 2 ? n0[2 * e + 1] : n1[2 * e - 3];
                w[e] = cvtpk(o[2 * e] * rs * na * silu_f(bflo(gv[e])), o[2 * e + 1] * rs * nb * silu_f(bfhi(gv[e]))); }
            *(v4u*)(Gp + (size_t)row * D + col) = w;
        }
    }
}

#define WGBAR() do { asm volatile("s_waitcnt lgkmcnt(0)" ::: "memory"); __builtin_amdgcn_s_barrier(); asm volatile("" ::: "memory"); } while (0)
constexpr int S2_BM = 0, S2_CM = 17408, S2_GT = 34816, S2_XR = 52224, S2_PW = 89088;
DI size_t scan_rowbase(int dir, int step, int b) {
    if (dir == 0) return step < 4 ? (size_t)(TLAT + b * CTXL + 64 * step) : (size_t)(b * SEQ + 64 * (step - 4));
    return step < 4 ? (size_t)(TLAT + b * CTXL + 64 * (3 - step)) : (size_t)(b * SEQ + 64 * (35 - step));
}
DI void ssd_scan2_phase(const Frame& F, const bf16* XBC, const float* DT, const float* a_log, const float* dsk, bf16* Y, BgConv& bg) {
    const int lane0 = lane_id(), wid = F.wave;
    if (T5_STATIC && wid >= 4) __builtin_amdgcn_s_setprio(1);
    LAS unsigned char* L = F.lds;
    for (int un = blockIdx.x; un < NB * 16; un += F.G) {
        const int b = un >> 4, hg = un & 15, grp = hg >> 1, hd = hg * 4 + (wid >> 1), pt = wid & 1;
        LAS unsigned char* XRh = L + S2_XR + (wid >> 1) * 9216;
        LAS float* PW = (LAS float*)(L + S2_PW + wid * 1024);
        for (int dir = 0; dir < 2; ++dir) {
            const float a = -__expf(a_log[dir * 64 + hd]), dskip = dsk[hd];
            f32x16 st[4];
#pragma unroll
            for (int nb = 0; nb < 4; ++nb)
#pragma unroll
                for (int i = 0; i < 16; ++i) st[nb][i] = 0.f;
            v4u pb[2], pc[2], px[4]; float pdt;
#define S2_LOAD(stp, ln) do { const size_t rb_ = scan_rowbase(dir, (stp), b); const int tid_ = wid * 64 + (ln); \
                _Pragma("unroll") for (int q_ = 0; q_ < 2; ++q_) { const int idx_ = tid_ + 512 * q_, j_ = idx_ >> 4, part_ = idx_ & 15, tj_ = dir ? 63 - j_ : j_; \
                    const bf16* src_ = XBC + (rb_ + tj_) * SSD_CONV + SSD_DI + grp * 128 + part_ * 8; pb[q_] = *(const v4u*)src_; pc[q_] = *(const v4u*)(src_ + 1024); } \
                _Pragma("unroll") for (int q_ = 0; q_ < 4; ++q_) { const int j_ = 32 * (wid & 1) + 8 * q_ + ((ln) >> 3), tj_ = dir ? 63 - j_ : j_; \
                    px[q_] = *(const v4u*)(XBC + (rb_ + tj_) * SSD_CONV + hd * 64 + ((ln) & 7) * 8); } \
                pdt = DT[(rb_ + (dir ? 63 - (ln) : (ln))) * 128 + dir * 64 + hd]; } while (0)
            S2_LOAD(0, lane0);
            for (int step = 0; step < 36; ++step) {
                int lane = lane0; asm volatile("" : "+v"(lane));
                const int tid = wid * 64 + lane, r32 = lane & 31, h = lane >> 5, q4 = (lane & 15) >> 2, p4 = lane & 3, blk = (lane >> 4) & 1;
                const size_t rowbase = scan_rowbase(dir, step, b);
                WGBAR();
#pragma unroll
                for (int q = 0; q < 2; ++q) { const int idx = tid + 512 * q, j = idx >> 4, part = idx & 15;
                    *(LAS v4u*)(L + S2_BM + j * 272 + part * 16) = pb[q]; *(LAS v4u*)(L + S2_CM + j * 272 + part * 16) = pc[q]; }
#pragma unroll
                for (int q = 0; q < 4; ++q) { const int j = 32 * (wid & 1) + 8 * q + (lane >> 3); *(LAS v4u*)(XRh + j * 144 + (lane & 7) * 16) = px[q]; }
                const float dtv = pdt; float ac = dtv * a;
#pragma unroll
                for (int off = 1; off < 64; off <<= 1) { const float t = __shfl_up(ac, off); if (lane >= off) ac += t; }
                const float tot = __int_as_float(__builtin_amdgcn_readlane(__float_as_int(ac), 63));
                { const float la = ac * LOG2E; PW[lane] = la; PW[64 + lane] = __builtin_amdgcn_exp2f(la); PW[128 + lane] = la - __builtin_amdgcn_logf(dtv); PW[192 + lane] = dtv * __expf(tot - ac); }
                if (step + 1 < 36) S2_LOAD(step + 1, lane);
                WGBAR();
#if BG_SSD == 1
                const BgConv::Tok tok = bg.pre();
#endif
                v4u yold[2][2];
                unsigned yoff[2];
#pragma unroll
                for (int it = 0; it < 2; ++it) { const int i = 32 * it + r32, ti = dir ? 63 - i : i; yoff[it] = (unsigned)(((rowbase + ti) * SSD_DI + hd * 64 + 32 * pt + 8 * h) * 2); }
                if (dir) {
#pragma unroll
                    for (int it = 0; it < 2; ++it)
#pragma unroll
                        for (int pr = 0; pr < 2; ++pr) yold[it][pr] = *(const v4u*)((const unsigned char*)Y + yoff[it] + 32 * pr);
                }
                if (wid < 3) {
                    const int jt = wid >> 1, it = wid == 0 ? 0 : 1, i = 32 * it + r32;
                    f32x16 g;
#pragma unroll
                    for (int q = 0; q < 16; ++q) g[q] = 0.f;
#pragma unroll
                    for (int ks = 0; ks < 8; ++ks) g = mfma32(lds_frag(L + S2_BM + (32 * jt + r32) * 272 + 32 * ks + 16 * h), lds_frag(L + S2_CM + i * 272 + 32 * ks + 16 * h), g);
#pragma unroll
                    for (int g4 = 0; g4 < 4; ++g4) *(LAS f32x4*)(L + S2_GT + i * 272 + (32 * jt + 8 * g4 + 4 * h) * 4) = (f32x4){g[4 * g4], g[4 * g4 + 1], g[4 * g4 + 2], g[4 * g4 + 3]};
                }
                f32x16 yacc[2];
#pragma unroll
                for (int it = 0; it < 2; ++it)
#pragma unroll
                    for (int q = 0; q < 16; ++q) yacc[it][q] = 0.f;
#pragma unroll
                for (int nb = 0; nb < 4; ++nb)
#pragma unroll
                    for (int s = 0; s < 2; ++s) { const bf16x8 bfr = pack8(st[nb], s);
#pragma unroll
                        for (int it = 0; it < 2; ++it) { LAS unsigned char* cp = L + S2_CM + (32 * it + r32) * 272 + (32 * nb + 16 * s + 4 * h) * 2;
                            yacc[it] = mfma32(bfr, cat8(*(LAS s16x4*)cp, *(LAS s16x4*)(cp + 16)), yacc[it]); } }
#pragma unroll
                for (int it = 0; it < 2; ++it) { const float ea = PW[64 + 32 * it + r32];
#pragma unroll
                    for (int q = 0; q < 16; ++q) yacc[it][q] *= ea; }
                WGBAR();
#if BG_SSD == 2
                const BgConv::Tok tok = bg.pre();
#endif
#pragma unroll
                for (int it = 0; it < 2; ++it) { const int i = 32 * it + r32; const float aci = PW[i];
#pragma unroll
                    for (int s = 0; s < 4; ++s) { if (s >= 2 * (it + 1)) continue;
                        const int j0 = 16 * s + 8 * h;
                        const f32x4 g0 = *(LAS f32x4*)(L + S2_GT + i * 272 + j0 * 4), g1 = *(LAS f32x4*)(L + S2_GT + i * 272 + j0 * 4 + 16);
                        const f32x4 a0 = *(LAS f32x4*)(PW + 128 + j0), a1 = *(LAS f32x4*)(PW + 128 + j0 + 4);
                        float m[8];
#pragma unroll
                        for (int e = 0; e < 4; ++e) { m[e] = (j0 + e <= i) ? g0[e] * __builtin_amdgcn_exp2f(aci - a0[e]) : 0.f; m[4 + e] = (j0 + 4 + e <= i) ? g1[e] * __builtin_amdgcn_exp2f(aci - a1[e]) : 0.f; }
                        v4u mp; mp.x = cvtpk(m[0], m[1]); mp.y = cvtpk(m[2], m[3]); mp.z = cvtpk(m[4], m[5]); mp.w = cvtpk(m[6], m[7]);
                        LAS unsigned char* xp = XRh + (16 * s + 8 * h + q4) * 144 + (32 * pt + 16 * blk + 4 * p4) * 2;
                        yacc[it] = mfma32(cat8(tr16(xp), tr16(xp + 4 * 144)), __builtin_bit_cast(bf16x8, mp), yacc[it]); } }
#if BG_SSD == 4
                const BgConv::Tok tok = bg.pre();
#endif
#pragma unroll
                for (int it = 0; it < 2; ++it)
#pragma unroll
                    for (int pr = 0; pr < 2; ++pr) {
                        float va[4], vb[4];
#pragma unroll
                        for (int e2 = 0; e2 < 4; ++e2) { va[e2] = yacc[it][8 * pr + e2]; vb[e2] = yacc[it][8 * pr + 4 + e2]; }
                        if (dir) {
                            const auto s0 = __builtin_amdgcn_permlane32_swap(yold[it][pr].x, yold[it][pr].z, false, false), s1 = __builtin_amdgcn_permlane32_swap(yold[it][pr].y, yold[it][pr].w, false, false);
                            va[0] += bflo(s0[0]); va[1] += bfhi(s0[0]); va[2] += bflo(s1[0]); va[3] += bfhi(s1[0]);
                            vb[0] += bflo(s0[1]); vb[1] += bfhi(s0[1]); vb[2] += bflo(s1[1]); vb[3] += bfhi(s1[1]);
                        } else {
                            const u32x2 xa = *(LAS u32x2*)(XRh + (32 * it + r32) * 144 + (32 * pt + 16 * pr + 4 * h) * 2), xb = *(LAS u32x2*)(XRh + (32 * it + r32) * 144 + (32 * pt + 16 * pr + 8 + 4 * h) * 2);
                            va[0] += dskip * bflo(xa.x); va[1] += dskip * bfhi(xa.x); va[2] += dskip * bflo(xa.y); va[3] += dskip * bfhi(xa.y);
                            vb[0] += dskip * bflo(xb.x); vb[1] += dskip * bfhi(xb.x); vb[2] += dskip * bflo(xb.y); vb[3] += dskip * bfhi(xb.y);
                        }
                        const unsigned a0 = cvtpk(va[0], va[1]), a1 = cvtpk(va[2], va[3]), b0 = cvtpk(vb[0], vb[1]), b1 = cvtpk(vb[2], vb[3]);
                        const auto t0 = __builtin_amdgcn_permlane32_swap(a0, b0, false, false), t1 = __builtin_amdgcn_permlane32_swap(a1, b1, false, false);
                        *(v4u*)((unsigned char*)Y + yoff[it] + 32 * pr) = (v4u){t0[0], t1[0], t0[1], t1[1]}; }
#if BG_SSD == 3
                const BgConv::Tok tok = bg.pre();
#endif
                { const float cd = __expf(tot);
#pragma unroll
                  for (int nb = 0; nb < 4; ++nb)
#pragma unroll
                      for (int q = 0; q < 16; ++q) st[nb][q] *= cd; }
#pragma unroll
                for (int s = 0; s < 4; ++s) {
                    LAS unsigned char* xp = XRh + (16 * s + 8 * h + q4) * 144 + (32 * pt + 16 * blk + 4 * p4) * 2;
                    const s16x4 xl = tr16(xp), xh = tr16(xp + 4 * 144);
                    const f32x4 w0 = *(LAS f32x4*)(PW + 192 + 16 * s + 8 * h), w1 = *(LAS f32x4*)(PW + 192 + 16 * s + 8 * h + 4);
                    v4u xd; xd.x = cvtpk(bf2f((unsigned short)xl[0]) * w0[0], bf2f((unsigned short)xl[1]) * w0[1]); xd.y = cvtpk(bf2f((unsigned short)xl[2]) * w0[2], bf2f((unsigned short)xl[3]) * w0[3]);
                    xd.z = cvtpk(bf2f((unsigned short)xh[0]) * w1[0], bf2f((unsigned short)xh[1]) * w1[1]); xd.w = cvtpk(bf2f((unsigned short)xh[2]) * w1[2], bf2f((unsigned short)xh[3]) * w1[3]);
#pragma unroll
                    for (int nb = 0; nb < 4; ++nb) { LAS unsigned char* bp = L + S2_BM + (16 * s + 8 * h + q4) * 272 + (32 * nb + 16 * blk + 4 * p4) * 2;
                        st[nb] = mfma32(cat8(tr16(bp), tr16(bp + 4 * 272)), __builtin_bit_cast(bf16x8, xd), st[nb]); }
                }
#if BG_SSD
                bg.post(tok);
#endif
            }
#undef S2_LOAD
            asm volatile("s_waitcnt vmcnt(0)" ::: "memory");
        }
    }
    if (T5_STATIC) __builtin_amdgcn_s_setprio(0);
    bg.drain();
    __syncthreads();
}

#ifndef HG_SKEW
#define HG_SKEW 1
#endif
constexpr int H2_QT = 0, H2_KT = 17408, H2_VM = 34816, H2_AM = 52224, H2_EG = 61440, H2_TEAM = 61952;
DI void hgrn_scan2_phase(const Frame& F, const _Float16* LG, const bf16* V, const bf16* Q, bf16* O, BgConv& bg) {
    const int lane0 = lane_id(), wid = F.wave, team = wid >> 2, wq = wid & 3;
    LAS unsigned char* L = F.lds + team * H2_TEAM;
    const _Float16* LGd = LG + (size_t)team * TT * D;
    for (int un = blockIdx.x; un < NB * 16; un += F.G) {
        const int b = un >> 4, hd = un & 15;
        f32x16 st[4];
#pragma unroll
        for (int dt = 0; dt < 4; ++dt)
#pragma unroll
            for (int i = 0; i < 16; ++i) st[dt][i] = 0.f;
        v4u plg[4], pq[4], pv[4];
#define H2_LOAD(stp, ln) do { const size_t rb_ = scan_rowbase(team, (stp), b); const int col_ = hd * 128 + 8 * (4 * wq + ((ln) & 3)); \
            _Pragma("unroll") for (int r_ = 0; r_ < 4; ++r_) { const int i_ = 4 * ((ln) >> 2) + r_, ti_ = team ? 63 - i_ : i_; const size_t o_ = (rb_ + ti_) * D + col_; \
                plg[r_] = *(const v4u*)(LGd + o_); pq[r_] = *(const v4u*)(Q + o_); pv[r_] = *(const v4u*)(V + o_); } } while (0)
        H2_LOAD(0, lane0);
        if (HG_SKEW && team) WGBAR();
        for (int step = 0; step < 36; ++step) {
            int lane = lane0; asm volatile("" : "+v"(lane));
            const int r32 = lane & 31, h = lane >> 5, q4 = (lane & 15) >> 2, p4 = lane & 3, blk = (lane >> 4) & 1;
            const size_t rowbase = scan_rowbase(team, step, b);
            WGBAR();
            const BgConv::Tok tok = bg.pre();
            {
                const int part = lane >> 2, dcol = 8 * (4 * wq + (lane & 3));
                float P[4][8], kk[4][8];
#pragma unroll
                for (int r = 0; r < 4; ++r)
#pragma unroll
                    for (int e = 0; e < 4; ++e) { const unsigned w = plg[r][e]; kk[r][2 * e] = (float)__builtin_bit_cast(_Float16, (unsigned short)(w & 0xffffu)); kk[r][2 * e + 1] = (float)__builtin_bit_cast(_Float16, (unsigned short)(w >> 16)); }
                float tot[8];
#pragma unroll
                for (int e = 0; e < 8; ++e) { float run = 1.f;
#pragma unroll
                    for (int r = 0; r < 4; ++r) { run *= 1.f - kk[r][e]; P[r][e] = run; }
                    tot[e] = run; }
#pragma unroll
                for (int e = 0; e < 8; ++e) { float inc = tot[e];
#pragma unroll
                    for (int off = 4; off < 64; off <<= 1) { const float t = __shfl_up(inc, off); if (lane >= off) inc *= t; }
                    float pre = __shfl_up(inc, 4); if (lane < 4) pre = 1.f;
                    tot[e] = __shfl(inc, 60 + (lane & 3));
#pragma unroll
                    for (int r = 0; r < 4; ++r) P[r][e] *= pre; }
                if (part == 0) {
#pragma unroll
                    for (int e = 0; e < 8; e += 4) *(LAS f32x4*)(L + H2_EG + (dcol + e) * 4) = (f32x4){tot[e], tot[e + 1], tot[e + 2], tot[e + 3]}; }
#pragma unroll
                for (int r = 0; r < 4; ++r) { const int i = 4 * part + r; v4u qo, ko;
#pragma unroll
                    for (int e = 0; e < 4; ++e) { const unsigned qw = pq[r][e];
                        const float p0 = P[r][2 * e], p1 = P[r][2 * e + 1];
                        qo[e] = cvtpk(bflo(qw) * p0, bfhi(qw) * p1); ko[e] = cvtpk(kk[r][2 * e] * __builtin_amdgcn_rcpf(p0), kk[r][2 * e + 1] * __builtin_amdgcn_rcpf(p1)); }
                    *(LAS v4u*)(L + H2_QT + i * 272 + dcol * 2) = qo; *(LAS v4u*)(L + H2_KT + i * 272 + dcol * 2) = ko; *(LAS v4u*)(L + H2_VM + i * 272 + dcol * 2) = pv[r]; }
            }
            if (step + 1 < 36) H2_LOAD(step + 1, lane);
            WGBAR();
            if (wq < 3) {
                const int jt = wq >> 1, it = wq == 0 ? 0 : 1, i = 32 * it + r32;
                f32x16 g;
#pragma unroll
                for (int q = 0; q < 16; ++q) g[q] = 0.f;
#pragma unroll
                for (int ks = 0; ks < 8; ++ks) g = mfma32(lds_frag(L + H2_KT + (32 * jt + r32) * 272 + 32 * ks + 16 * h), lds_frag(L + H2_QT + i * 272 + 32 * ks + 16 * h), g);
#pragma unroll
                for (int q = 0; q < 16; ++q) { const int j = 32 * jt + crow(q, h); if (j > i) g[q] = 0.f; }
#pragma unroll
                for (int g4 = 0; g4 < 4; ++g4) { u32x2 w; w.x = cvtpk(g[4 * g4], g[4 * g4 + 1]); w.y = cvtpk(g[4 * g4 + 2], g[4 * g4 + 3]);
                    *(LAS u32x2*)(L + H2_AM + i * 144 + (32 * jt + 8 * g4 + 4 * h) * 2) = w; }
            }
            f32x16 oacc[2];
#pragma unroll
            for (int it = 0; it < 2; ++it)
#pragma unroll
                for (int q = 0; q < 16; ++q) oacc[it][q] = 0.f;
#pragma unroll
            for (int dt = 0; dt < 4; ++dt)
#pragma unroll
                for (int s = 0; s < 2; ++s) { const bf16x8 afr = pack8(st[dt], s);
#pragma unroll
                    for (int it = 0; it < 2; ++it) { LAS unsigned char* qp = L + H2_QT + (32 * it + r32) * 272 + (32 * dt + 16 * s + 4 * h) * 2;
                        oacc[it] = mfma32(afr, cat8(*(LAS s16x4*)qp, *(LAS s16x4*)(qp + 16)), oacc[it]); } }
            WGBAR();
            bf16x8 vfr[4];
#pragma unroll
            for (int s = 0; s < 4; ++s) { LAS unsigned char* vp = L + H2_VM + (16 * s + 8 * h + q4) * 272 + (32 * wq + 16 * blk + 4 * p4) * 2; vfr[s] = cat8(tr16(vp), tr16(vp + 4 * 272)); }
#pragma unroll
            for (int it = 0; it < 2; ++it)
#pragma unroll
                for (int s = 0; s < 4; ++s) { if (s >= 2 * (it + 1)) continue;
                    oacc[it] = mfma32(vfr[s], lds_frag(L + H2_AM + (32 * it + r32) * 144 + 32 * s + 16 * h), oacc[it]); }
#pragma unroll
            for (int it = 0; it < 2; ++it) { const int i = 32 * it + r32, ti = team ? 63 - i : i;
                bf16* op = O + (size_t)team * TT * D + (rowbase + ti) * D + hd * 128 + 32 * wq + 8 * h;
#pragma unroll
                for (int pr = 0; pr < 2; ++pr) {
                    const unsigned a0 = cvtpk(oacc[it][8 * pr], oacc[it][8 * pr + 1]), a1 = cvtpk(oacc[it][8 * pr + 2], oacc[it][8 * pr + 3]);
                    const unsigned b0 = cvtpk(oacc[it][8 * pr + 4], oacc[it][8 * pr + 5]), b1 = cvtpk(oacc[it][8 * pr + 6], oacc[it][8 * pr + 7]);
                    const auto t0 = __builtin_amdgcn_permlane32_swap(a0, b0, false, false), t1 = __builtin_amdgcn_permlane32_swap(a1, b1, false, false);
                    *(v4u*)(op + 16 * pr) = (v4u){t0[0], t1[0], t0[1], t1[1]}; } }
#pragma unroll
            for (int s = 0; s < 4; ++s)
#pragma unroll
                for (int dt = 0; dt < 4; ++dt) { LAS unsigned char* kp = L + H2_KT + (16 * s + 8 * h + q4) * 272 + (32 * dt + 16 * blk + 4 * p4) * 2;
                    st[dt] = mfma32(cat8(tr16(kp), tr16(kp + 4 * 272)), vfr[s], st[dt]); }
#pragma unroll
            for (int dt = 0; dt < 4; ++dt)
#pragma unroll
                for (int g4 = 0; g4 < 4; ++g4) { const f32x4 eg = *(LAS f32x4*)(L + H2_EG + (32 * dt + 8 * g4 + 4 * h) * 4);
#pragma unroll
                    for (int e = 0; e < 4; ++e) st[dt][4 * g4 + e] *= eg[e]; }
            bg.post(tok);
        }
        if (HG_SKEW && !team) WGBAR();
#undef H2_LOAD
    }
    bg.drain();
    __syncthreads();
}

#ifndef EN_MODP
#define EN_MODP 1
#endif
#ifndef EN_PRO
#define EN_PRO 1
#endif
#ifndef EN_NORM
#define EN_NORM 1
#endif
#ifndef EN_G1
#define EN_G1 1
#endif
#ifndef EN_ATT
#define EN_ATT 1
#endif
#ifndef EN_CONV
#define EN_CONV 1
#endif
#ifndef EN_HSCAN
#define EN_HSCAN 1
#endif
#ifndef EN_SSCAN
#define EN_SSCAN 1
#endif
#ifndef EN_FIN
#define EN_FIN 1
#endif
#ifndef EN_G2
#define EN_G2 1
#endif
#ifndef EN_G3
#define EN_G3 1
#endif
#ifndef EN_G4
#define EN_G4 1
#endif
#ifndef EN_G1A
#define EN_G1A 1
#endif
#ifndef EN_G1S
#define EN_G1S 1
#endif
#ifndef EN_G1H
#define EN_G1H 1
#endif
#ifndef REP_G1
#define REP_G1 1
#endif
#ifndef REP_G2
#define REP_G2 1
#endif
#ifndef REP_G3
#define REP_G3 1
#endif
#ifndef REP_G4
#define REP_G4 1
#endif
#ifndef REP_ATT
#define REP_ATT 1
#endif
#ifndef REP_SSCAN
#define REP_SSCAN 1
#endif
#ifndef REP_HSCAN
#define REP_HSCAN 1
#endif
#ifndef REP_PRO
#define REP_PRO 1
#endif
#ifndef MK_ONE_LAUNCH
#define MK_ONE_LAUNCH 1
#endif
#ifndef BG_G2
#define BG_G2 1
#endif
#ifndef BG_G3
#define BG_G3 1
#endif
#ifndef BG_G4
#define BG_G4 1
#endif
#ifndef MK_LAYERS
#define MK_LAYERS 4
#endif
constexpr int PH_MODP = 0, PH_PRO = 1, PH_N0 = 2, PH_L0 = 3, PH_PER = 9, PH_END = PH_L0 + PH_PER * DEPTH;
struct Args { const float* in[24]; float* out; unsigned char* ws; int lo, hi; };
static_assert(sizeof(Args) == 26 * 8 + 8, "no padding");

__global__ void __launch_bounds__(NWAVES * 64, 2) trunk_fwd(Args args) {
    extern __shared__ __attribute__((aligned(16))) unsigned char lds_raw[];
    Frame F;
    F.lds = (LAS unsigned char*)lds_raw;
    F.MISC = (volatile LAS unsigned*)(F.lds + MISC_OFF);
    F.wave = __builtin_amdgcn_readfirstlane((int)threadIdx.x >> 6);
    F.G = gridDim.x; F.gw = blockIdx.x * NWAVES + F.wave; F.NGW = F.G * NWAVES;
    unsigned char* ws = args.ws;
    F.ctl = (gu32*)(ws + WS_CTL);
    for (int u = threadIdx.x; u < (LDS_BYTES - LDSCTL_OFF) / 4; u += NWAVES * 64) ((LAS unsigned*)(F.lds + LDSCTL_OFF))[u] = 0u;
    __syncthreads();
    XcdBarrier bar = xcd_barrier_post((unsigned*)(F.ctl + CW_BAR), F.MISC + 8);
    const int lo = args.lo, hi = args.hi;
#define IN(k) (lo <= (k) && (k) < hi)
#define SEAM(k) do { if ((k) + 1 < hi) xcd_barrier(bar); } while (0)
    float* out = args.out;
    bf16* xbl = (bf16*)out;
    bf16* xbc = (bf16*)(ws + WS_H);
    bf16* xbl3 = (bf16*)(ws + WS_U2 + 144 * MiB);
    float* mod = (float*)(ws + WS_MOD);
        bf16* U = (bf16*)(ws + WS_U2);
    const float* rope = (const float*)(ws + WS_TAB);
    const float* lbv = (const float*)(ws + WS_TAB + 16384);

    if (EN_MODP && IN(PH_MODP)) { mod_partial_phase(F, INP(1), INP(3), INP(4), (float*)(ws + WS_MODP)); SEAM(PH_MODP); }
    if (EN_PRO && IN(PH_PRO)) { for (int rep = 0; rep < REP_PRO; ++rep) prologue_phase(F, ws); SEAM(PH_PRO); }
#ifdef IDLE_TICKS
    { const unsigned long long t0 = __builtin_amdgcn_s_memrealtime(); while (__builtin_amdgcn_s_memrealtime() - t0 < IDLE_TICKS) __builtin_amdgcn_s_sleep(32); }
#endif
    if (EN_NORM && IN(PH_N0)) {
        norm_phase<0>(F, TT, nullptr, nullptr, INP(0), INP(2), xbl, xbc, xbl, nullptr, nullptr, 0, nullptr, mod, 0, INP(6), U);
        SEAM(PH_N0);
    }
    for (int l = 0; l < MK_LAYERS; ++l) {
        const int base = PH_L0 + PH_PER * l, kind = l % 3, j = l / 3;
        const float* modl = mod + (size_t)l * 17 * NMODC;
        const int M2 = l < DEPTH - 1 ? TT : TLAT;
        BgConv bg; bg.init((kind == 0 && !BG_ATT) ? DEPTH : l + 1);
        pg8::NoSide noside;
        if (EN_G1 && IN(base + 0)) { for (int rep = 0; rep < REP_G1; ++rep) {
            pg8::StaticOrder S;
            if (kind == 0) { if (EN_G1A) {
                pg8::Gemm g{U, (const bf16*)(ws + WS_WATT + (size_t)j * (W_ATT_IN + W_ATT_OUT)), TT, ATT_IN, D}; S.init(TT, ATT_IN, F.G, (int)blockIdx.x);
                EpiAttn E{(bf16*)(ws + A_KB), (bf16*)(ws + A_QB), (bf16*)(ws + A_VTL), (bf16*)(ws + A_VTC), rope};
                pg8::gemm_phase<EpiAttn, pg8::StaticOrder, true, true>(F.lds, g, S, E, F.wave, noside); }
            } else if (kind == 1) { if (EN_G1S) {
                pg8::Gemm g{U, (const bf16*)(ws + WS_WSSD), TT, SSD_INP, D}; S.init(TT, SSD_INP, F.G, (int)blockIdx.x);
                EpiSsd E{(bf16*)(ws + S_XBC), (bf16*)(ws + S_Z), (float*)(ws + S_DT), INP(15), (bf16*)(ws + WS_MODP)};
                pg8::gemm_phase<EpiSsd, pg8::StaticOrder, true, true>(F.lds, g, S, E, F.wave, noside); }
            } else if (EN_G1H) {
                pg8::Gemm g{U, (const bf16*)(ws + WS_WHG), TT, HG_IN, D}; S.init(TT, HG_IN, F.G, (int)blockIdx.x);
                EpiHgrn E{(_Float16*)(ws + H_LG), (bf16*)(ws + H_V), lbv};
                pg8::gemm_phase<EpiHgrn, pg8::StaticOrder, true, true>(F.lds, g, S, E, F.wave, noside);
            } }
            SEAM(base + 0);
        }
        if (IN(base + 1)) {
            if (kind == 0) { if (EN_ATT) for (int rep = 0; rep < REP_ATT; ++rep) attn_phase(F, (const bf16*)(ws + A_KB), (const bf16*)(ws + A_QB), (const bf16*)(ws + A_VTL), (const bf16*)(ws + A_VTC), INP(11) + j * 32, (bf16*)(ws + A_O), l < DEPTH - 1, bg); }
            else if (kind == 1) { if (EN_CONV) ssd_conv_phase(F, (bf16*)(ws + S_XBC), (const bf16*)(ws + WS_MODP), INP(13), INP(14)); }
            else if (EN_HSCAN) for (int rep = 0; rep < REP_HSCAN; ++rep) hgrn_scan2_phase(F, (const _Float16*)(ws + H_LG), (const bf16*)(ws + H_V), (const bf16*)(ws + H_Q), (bf16*)(ws + WS_U2), bg);
            SEAM(base + 1);
        }
        if (kind != 0 && IN(base + 2)) {
            if (kind == 1) { if (EN_SSCAN) for (int rep = 0; rep < REP_SSCAN; ++rep) ssd_scan2_phase(F, (const bf16*)(ws + S_XBC), (const float*)(ws + S_DT), INP(16), INP(17), (bf16*)(ws + WS_U2), bg); }
            else if (EN_FIN) hgrn_fin_phase(F, (const bf16*)(ws + WS_U2), (const bf16*)(ws + H_OG), INP(22), (bf16*)(ws + H_LG));
            SEAM(base + 2);
        }
        if (kind == 1 && IN(base + 3)) {
            if (EN_FIN) ssd_fin_phase(F, (bf16*)(ws + WS_U2), (const bf16*)(ws + S_Z), INP(18));
            SEAM(base + 3);
        }
        bf16* ymix = (bf16*)(ws + (kind == 0 ? A_Y : (kind == 1 ? S_XBC : H_V)));
        bf16* Un2 = ((NT_N2 & 2) && kind == 1) ? (bf16*)(ws + S_Z) : U;
        if (EN_G2 && IN(base + 4)) {
            const bf16* A2 = (const bf16*)(ws + (kind == 0 ? A_O : (kind == 1 ? WS_U2 : H_LG)));
            const bf16* W2 = (const bf16*)(ws + (kind == 0 ? WS_WATT + (size_t)j * (W_ATT_IN + W_ATT_OUT) + W_ATT_IN : (kind == 1 ? WS_WSSD + W_SSD_IN : WS_WHG + W_HG_IN)));
            pg8::Gemm g{A2, W2, M2, D, kind == 1 ? SSD_DI : D}; pg8::StaticOrder S; S.init(M2, D, F.G, (int)blockIdx.x);
            EpiBf16Y E{ymix};
            if (NT_ON && l < DEPTH - 1 && (((NT_N2 & 1) && kind != 1) || ((NT_N2 & 2) && kind == 1))) {
                CountOrder SC; SC.init(M2, D, F.G, (int)blockIdx.x); SC.cnt = (unsigned*)F.ctl + CW_PCNT + (l * 2 + 0) * 4096; SC.xcc = (int)bar.x;
                EpiBf16YWT EW{ymix}; NormTail<0> nt{l, (NT_TAIL && SC.idle_last()) ? 1 : 0, (int)blockIdx.x - SC.nwg % SC.G, &SC};
                pg8::gemm_phase<EpiBf16YWT, CountOrder, true, true, NormTail<0>>(F.lds, g, SC, EW, F.wave, nt);
            } else
            for (int rep = 0; rep < REP_G2; ++rep) { if (BG_G2) pg8::gemm_phase<EpiBf16Y, pg8::StaticOrder, true, true>(F.lds, g, S, E, F.wave, noside); else pg8::gemm_phase<EpiBf16Y, pg8::StaticOrder, true, true>(F.lds, g, S, E, F.wave, noside); }
            SEAM(base + 4);
        }
        if (EN_NORM && IN(base + 5)) {
            if (NT_ON && l < DEPTH - 1 && (((NT_N2 & 1) && kind != 1) || ((NT_N2 & 2) && kind == 1))) norm_rest_phase(F, l, 0, ymix, xbl, xbc, modl, 2, INP(6) + (l * 4 + 1) * D, modl, 3, INP(6) + (l * 4 + 2) * D, Un2);
            else norm_phase<1>(F, M2, ymix, nullptr, nullptr, nullptr, xbl, xbc, l == DEPTH - 1 ? xbl3 : xbl, nullptr, modl, 2, INP(6) + (l * 4 + 1) * D, modl, 3, INP(6) + (l * 4 + 2) * D, Un2);
            SEAM(base + 5);
        }
        const unsigned char* wffn = ws + WS_WFFN + (size_t)l * (W_FFN_IN + W_FFN_OUT);
        if (EN_G3 && IN(base + 6)) {
            pg8::Gemm g{Un2, (const bf16*)wffn, M2, 2 * FFN, D}; pg8::StaticOrder S; S.init(M2, 2 * FFN, F.G, (int)blockIdx.x);
            EpiSwiglu E{(bf16*)(ws + F_H)};
            for (int rep = 0; rep < REP_G3; ++rep) { if (BG_G3) pg8::gemm_phase<EpiSwiglu, pg8::StaticOrder, true, true>(F.lds, g, S, E, F.wave, noside); else pg8::gemm_phase<EpiSwiglu, pg8::StaticOrder, true, true>(F.lds, g, S, E, F.wave, noside); }
            SEAM(base + 6);
        }
        if (EN_G4 && IN(base + 7)) {
            pg8::Gemm g{(const bf16*)(ws + F_H), (const bf16*)(wffn + W_FFN_IN), M2, D, FFN}; pg8::StaticOrder S; S.init(M2, D, F.G, (int)blockIdx.x);
            EpiBf16Y E{(bf16*)(ws + F_Y)};
            if (NT_ON && l < DEPTH - 1) {
                CountOrder SC; SC.init(M2, D, F.G, (int)blockIdx.x); SC.cnt = (unsigned*)F.ctl + CW_PCNT + (l * 2 + 1) * 4096; SC.xcc = (int)bar.x;
                EpiBf16YWT EW{(bf16*)(ws + F_Y)}; NormTail<1> nt{l, (NT_TAIL && SC.idle_last()) ? 1 : 0, (int)blockIdx.x - SC.nwg % SC.G, &SC};
                pg8::gemm_phase<EpiBf16YWT, CountOrder, true, true, NormTail<1>>(F.lds, g, SC, EW, F.wave, nt);
            } else
            for (int rep = 0; rep < REP_G4; ++rep) { if (BG_G4) pg8::gemm_phase<EpiBf16Y, pg8::StaticOrder, true, true>(F.lds, g, S, E, F.wave, noside); else pg8::gemm_phase<EpiBf16Y, pg8::StaticOrder, true, true>(F.lds, g, S, E, F.wave, noside); }
            SEAM(base + 7);
        }
        if (EN_NORM && IN(base + 8)) {
            if (l < DEPTH - 1) { if (NT_ON) norm_rest_phase(F, l, 1, (const bf16*)(ws + F_Y), xbl, xbc, modl, 5, INP(6) + (l * 4 + 3) * D, modl + 17 * NMODC, 0, INP(6) + ((l + 1) * 4 + 0) * D, U);
                else norm_phase<1>(F, M2, (const bf16*)(ws + F_Y), nullptr, nullptr, nullptr, xbl, xbc, xbl, nullptr, modl, 5, INP(6) + (l * 4 + 3) * D, modl + 17 * NMODC, 0, INP(6) + ((l + 1) * 4 + 0) * D, U); }
            else norm_phase<2>(F, M2, (const bf16*)(ws + F_Y), nullptr, nullptr, nullptr, xbl3, xbc, xbl3, out, modl, 5, INP(6) + (l * 4 + 3) * D, nullptr, 0, nullptr, nullptr);
            SEAM(base + 8);
        }
    }
#undef IN
#undef SEAM
}

extern "C" void kernel_launch(void* const* d_in, const int* in_sizes, int n_in, void* d_out, int out_size, void* d_ws, size_t ws_size, hipStream_t stream) {
    static int grid = 0;
    if (grid == 0) {
        if (n_in != 24 || in_sizes[0] != TLAT * D || out_size != TLAT * D || ws_size < WS_END) {
            fprintf(stderr, "kernel_launch: unexpected shapes: n_in %d in0 %d out %d ws %zu (need %zu)\n", n_in, n_in > 0 ? in_sizes[0] : -1, out_size, ws_size, (size_t)WS_END); grid = -1; return; }
        int dev = 0, cus = 0, per_cu = 0;
        if (hipGetDevice(&dev) != hipSuccess || hipDeviceGetAttribute(&cus, hipDeviceAttributeMultiprocessorCount, dev) != hipSuccess) { grid = -1; return; }
        if (hipFuncSetAttribute((const void*)trunk_fwd, hipFuncAttributeMaxDynamicSharedMemorySize, LDS_BYTES) != hipSuccess) { fprintf(stderr, "kernel_launch: hipFuncSetAttribute failed\n"); grid = -1; return; }
        if (hipOccupancyMaxActiveBlocksPerMultiprocessor(&per_cu, (const void*)trunk_fwd, NWAVES * 64, LDS_BYTES) != hipSuccess || per_cu < 1)
            fprintf(stderr, "kernel_launch: occupancy query reports %d\n", per_cu);
        (void)hipGetLastError();
        grid = cus;
    }
    if (grid < 0) return;
    if (hipMemsetAsync((char*)d_ws + WS_CTL, 0, CTL_ZERO_BYTES, stream) != hipSuccess) return;
    Args a{};
    for (int i = 0; i < 24; ++i) a.in[i] = (const float*)d_in[i];
    a.out = (float*)d_out; a.ws = (unsigned char*)d_ws;
#if MK_ONE_LAUNCH
    a.lo = 0; a.hi = PH_L0 + PH_PER * MK_LAYERS;
    hipLaunchKernelGGL(trunk_fwd, dim3(grid), dim3(NWAVES * 64), LDS_BYTES, stream, a);
#else
    for (int id = 0; id < PH_L0 + PH_PER * MK_LAYERS; ++id) {
        if (id >= PH_L0) { const int loc = (id - PH_L0) % PH_PER, kind = ((id - PH_L0) / PH_PER) % 3; if ((loc == 2 && kind == 0) || (loc == 3 && kind != 1)) continue; }
        a.lo = id; a.hi = id + 1;
        hipLaunchKernelGGL(trunk_fwd, dim3(grid), dim3(NWAVES * 64), LDS_BYTES, stream, a);
    }
#endif
}
```

```cpp
#include <hip/hip_runtime.h>
#include <cstdio>
#include <cstdint>
#include <cmath>
namespace pg8 {
#define PG8_LAS __attribute__((address_space(3)))
typedef unsigned short bf16_t;
typedef short bf16x8 __attribute__((ext_vector_type(8)));
typedef float f32x4 __attribute__((ext_vector_type(4)));
typedef unsigned u32x4 __attribute__((ext_vector_type(4)));
constexpr int BM = 256, BK = 64, HALF = 128, HTB = HALF * BK * 2  , STAGE_BYTES = 8 * HTB, NXCD = 8, WGM = 4;

__host__ __device__ __forceinline__ int lds_byte(int r, int c) { const int st = (r >> 4) * 2 + (c >> 5), rr = r & 15, cc = c & 31, ob = rr * 64 + cc * 2; return st * 1024 + (ob ^ (((ob >> 9) & 1) << 5)); }
__host__ __device__ __forceinline__ void stage_rc(int b, int& R, int& C) { const int st = b / 1024, sb = b % 1024, swz = sb ^ (((sb >> 9) & 1) << 5); R = (st >> 1) * 16 + swz / 64; C = (st & 1) * 32 + (swz % 64) / 2; }
__host__ __device__ __forceinline__ int perm32(int rho) { const int n = rho >> 4, i = rho & 15; return 8 * (i >> 2) + 4 * n + (i & 3); }

struct Unit { int pm, pn; int koff = 0; int nt = 0; };
struct Gemm { const bf16_t* A; const bf16_t* Bt; int M, N, K; int ldk = 0; };

struct StaticOrder {
    int nM, nN, nwg, G, c; int rev = 0;
    __host__ __device__ void init(int M, int N, int G_, int c_) { nM = M / BM; nN = N / BM; nwg = nM * nN; G = G_; c = c_; }
    __host__ __device__ bool next(int i, Unit& u) const {
        const long L = (long)i * G + c; if (L >= nwg) return false;
        int wgid = (int)L; { const int q = nwg / NXCD, r = nwg % NXCD, xcd = wgid % NXCD, cnt = q + (xcd < r ? 1 : 0); int off = wgid / NXCD; if (rev) off = cnt - 1 - off; wgid = (xcd < r ? xcd * (q + 1) : r * (q + 1) + (xcd - r) * q) + off; }
        const int nig = WGM * nN, gid = wgid / nig, fm = gid * WGM, gsz = (nM - fm) < WGM ? (nM - fm) : WGM;
        u.pm = fm + ((wgid % nig) % gsz); u.pn = (wgid % nig) / gsz; return true;
    }
    __host__ __device__ bool idle_last() const { const int r = nwg % G; return r != 0 && c >= r; }
    __device__ __forceinline__ void a_ready(const Unit&) const {}
    __device__ __forceinline__ void done(const Unit&) const {}
};

__device__ __forceinline__ unsigned cvt_pk_bf16(float lo, float hi) { unsigned r; asm volatile("v_cvt_pk_bf16_f32 %0, %1, %2" : "=v"(r) : "v"(lo), "v"(hi)); return r; }
typedef float f32x2 __attribute__((ext_vector_type(2)));
struct NoSide { struct Tok {}; __device__ __forceinline__ Tok pre() { return Tok{}; } __device__ __forceinline__ void post(const Tok&) {} __device__ __forceinline__ void tail() {} };
template <class Epi, class Sched, bool ALIGN_EPI = false, bool SP2 = false, class Side = NoSide>
__device__ __forceinline__ void gemm_phase(PG8_LAS unsigned char* lds, const Gemm g, const Sched& S, const Epi& E, const int wave_id, Side& side) {
    int lane_; asm volatile("v_mbcnt_lo_u32_b32 %0, -1, 0\n\tv_mbcnt_hi_u32_b32 %0, -1, %0" : "=v"(lane_));
    const int tid_ = wave_id * 64 + lane_;
    const int tid = tid_, wid = __builtin_amdgcn_readfirstlane(tid >> 6), lane = tid & 63, wr = wid >> 2, wc = wid & 3, fr = lane & 15, fq = lane >> 4;
    const int K = g.ldk ? g.ldk : g.K, nt = g.K / BK;
    unsigned voffA[2], voffB[2];
#pragma unroll
    for (int i = 0; i < 2; ++i) { int R, C; stage_rc(tid * 16 + i * 8192, R, C); const int Rb = Epi::PERM ? ((R & ~31) + perm32(R & 31)) : R;
        voffA[i] = (unsigned)(R * K + C) * 2u; voffB[i] = (unsigned)(Rb * K + C) * 2u; }
    const size_t kstep = (size_t)(BK * 2);
    const size_t hstep = (size_t)HALF * K * 2;
    const size_t tstep = 2 * hstep;
    const unsigned ldsw = (unsigned)wid * 1024u;
    const int aoff = lds_byte(wr * 64 + fr, fq * 8), boff = lds_byte(wc * 32 + fr, fq * 8);
#define PG8_SA(b, h) (((b) * 2 + (h)) * HTB)
#define PG8_SB(b, h) ((4 + (b) * 2 + (h)) * HTB)
#define PG8_STAGE(bufoff, gbase, voff) do { _Pragma("unroll") for (int _i = 0; _i < 2; ++_i) \
        __builtin_amdgcn_global_load_lds((const unsigned*)((const char*)(gbase) + (voff)[_i]), (PG8_LAS unsigned*)(lds + (bufoff) + ldsw + _i * 8192), 16, 0, 0); } while (0)
#define PG8_LDA(dst, b, h) do { _Pragma("unroll") for (int m = 0; m < 4; ++m) _Pragma("unroll") for (int k = 0; k < 2; ++k) dst[m][k] = *(const PG8_LAS bf16x8*)(lds + PG8_SA(b, h) + aoff + m * 2048 + k * 1024); } while (0)
#define PG8_LDB(dst, b, h) do { _Pragma("unroll") for (int n = 0; n < 2; ++n) _Pragma("unroll") for (int k = 0; k < 2; ++k) dst[n][k] = *(const PG8_LAS bf16x8*)(lds + PG8_SB(b, h) + boff + n * 2048 + k * 1024); } while (0)
#define PG8_MMA(ai, bj, At, Bt) do { __builtin_amdgcn_s_setprio(1); _Pragma("unroll") for (int m = 0; m < 4; ++m) _Pragma("unroll") for (int n = 0; n < 2; ++n) _Pragma("unroll") for (int k = 0; k < 2; ++k) \
        acc[ai][bj][m][n] = __builtin_amdgcn_mfma_f32_16x16x32_bf16(Bt[n][k], At[m][k], acc[ai][bj][m][n], 0, 0, 0); __builtin_amdgcn_s_setprio(0); } while (0)
#define PG8_WAIT_V(n) asm volatile("s_waitcnt vmcnt(" #n ")" ::: "memory")
#define PG8_WAIT_L(n) asm volatile("s_waitcnt lgkmcnt(" #n ")" ::: "memory")
#define PG8_BAR __builtin_amdgcn_s_barrier()
#define PG8_SCHED __builtin_amdgcn_sched_barrier(0)
    Unit cur, nxt; int ui = 0;
    if (!S.next(0, cur)) return;
    f32x4 acc[2][2][4][2];
#pragma unroll
    for (int a = 0; a < 2; ++a)
#pragma unroll
        for (int b = 0; b < 2; ++b)
#pragma unroll
            for (int m = 0; m < 4; ++m)
#pragma unroll
                for (int n = 0; n < 2; ++n) acc[a][b][m][n] = (f32x4){0.f, 0.f, 0.f, 0.f};
    bf16x8 At[4][2], B0[2][2], B1[2][2];
    const char* cA = (const char*)g.A + (size_t)cur.pm * tstep + (size_t)cur.koff * 2; const char* cB = (const char*)g.Bt + (size_t)cur.pn * tstep + (size_t)cur.koff * 2;
    S.a_ready(cur);
    if constexpr (SP2) {
        PG8_STAGE(PG8_SB(0, 0), cB, voffB); PG8_STAGE(PG8_SB(0, 1), cB + hstep, voffB); PG8_STAGE(PG8_SA(0, 0), cA, voffA); PG8_STAGE(PG8_SA(0, 1), cA + hstep, voffA);
        if (wr == 1) PG8_BAR;
        PG8_WAIT_V(2); PG8_BAR;
        PG8_STAGE(PG8_SB(1, 0), cB + kstep, voffB); PG8_STAGE(PG8_SA(1, 0), cA + kstep, voffA); PG8_STAGE(PG8_SB(1, 1), cB + hstep + kstep, voffB);
        PG8_WAIT_V(6); PG8_BAR;
    } else {
        PG8_STAGE(PG8_SB(0, 0), cB, voffB); PG8_STAGE(PG8_SA(0, 0), cA, voffA); PG8_STAGE(PG8_SB(0, 1), cB + hstep, voffB); PG8_STAGE(PG8_SA(0, 1), cA + hstep, voffA);
        if (wr == 1) PG8_BAR;
        PG8_WAIT_V(4); PG8_BAR;
        PG8_STAGE(PG8_SB(1, 0), cB + kstep, voffB); PG8_STAGE(PG8_SA(1, 0), cA + kstep, voffA); PG8_STAGE(PG8_SB(1, 1), cB + hstep + kstep, voffB);
        PG8_WAIT_V(6); PG8_BAR;
    }
    for (;;) {
        const bool has_next = S.next(ui + 1, nxt);
        const char* nA = has_next ? (const char*)g.A + (size_t)nxt.pm * tstep + (size_t)nxt.koff * 2 : cA; const char* nB = has_next ? (const char*)g.Bt + (size_t)nxt.pn * tstep + (size_t)nxt.koff * 2 : cB;
        for (int t = 0; t < nt; t += 2) {
            const bool last = (t == nt - 2);
            const char* a1 = cA + (size_t)(t + 1) * kstep;
            const char* a2 = last ? nA : cA + (size_t)(t + 2) * kstep; const char* b2 = last ? nB : cB + (size_t)(t + 2) * kstep;
            const char* a3 = a2 + kstep; const char* b3 = b2 + kstep;
            if (last && has_next) S.a_ready(nxt);
            if constexpr (SP2) {
            PG8_LDB(B0, 0, 0); PG8_LDB(B1, 0, 1); PG8_SCHED; PG8_LDA(At, 0, 0); PG8_STAGE(PG8_SA(1, 1), a1 + hstep, voffA);
            PG8_WAIT_V(8); PG8_WAIT_L(0); PG8_BAR; PG8_MMA(0, 0, At, B0); PG8_MMA(0, 1, At, B1); PG8_BAR; PG8_SCHED;
            PG8_LDA(At, 0, 1); PG8_STAGE(PG8_SB(0, 0), b2, voffB); PG8_STAGE(PG8_SB(0, 1), b2 + hstep, voffB); PG8_STAGE(PG8_SA(0, 0), a2, voffA);
            PG8_WAIT_V(8); PG8_WAIT_L(0); PG8_BAR; PG8_MMA(1, 0, At, B0); PG8_MMA(1, 1, At, B1); PG8_BAR; PG8_SCHED;
            PG8_LDB(B0, 1, 0); PG8_LDB(B1, 1, 1); PG8_SCHED; PG8_LDA(At, 1, 0); PG8_STAGE(PG8_SA(0, 1), a2 + hstep, voffA);
            PG8_WAIT_V(8); PG8_WAIT_L(0); PG8_BAR; PG8_MMA(0, 0, At, B0); PG8_MMA(0, 1, At, B1); PG8_BAR; PG8_SCHED;
            PG8_LDA(At, 1, 1); PG8_STAGE(PG8_SB(1, 0), b3, voffB); PG8_STAGE(PG8_SB(1, 1), b3 + hstep, voffB); PG8_STAGE(PG8_SA(1, 0), a3, voffA);
            PG8_WAIT_V(8); PG8_WAIT_L(0); PG8_BAR; PG8_MMA(1, 0, At, B0); PG8_MMA(1, 1, At, B1); PG8_BAR; PG8_SCHED;
            } else {
            PG8_LDB(B0, 0, 0); PG8_SCHED; PG8_LDA(At, 0, 0); PG8_STAGE(PG8_SA(1, 1), a1 + hstep, voffA);
            PG8_WAIT_L(8); PG8_BAR; PG8_WAIT_L(0); PG8_MMA(0, 0, At, B0); PG8_BAR; PG8_SCHED;
            PG8_LDB(B1, 0, 1); PG8_STAGE(PG8_SB(0, 0), b2, voffB);
            PG8_BAR; PG8_WAIT_L(0); PG8_MMA(0, 1, At, B1); PG8_BAR;
            PG8_LDA(At, 0, 1); PG8_STAGE(PG8_SA(0, 0), a2, voffA);
            PG8_BAR; PG8_WAIT_L(0); PG8_MMA(1, 0, At, B0); PG8_BAR; PG8_SCHED;
            PG8_STAGE(PG8_SB(0, 1), b2 + hstep, voffB);
            PG8_WAIT_V(6); PG8_BAR; PG8_MMA(1, 1, At, B1); PG8_BAR;
            PG8_LDB(B0, 1, 0); PG8_SCHED; PG8_LDA(At, 1, 0); PG8_STAGE(PG8_SA(0, 1), a2 + hstep, voffA);
            PG8_WAIT_L(8); PG8_BAR; PG8_WAIT_L(0); PG8_MMA(0, 0, At, B0); PG8_BAR; PG8_SCHED;
            PG8_LDB(B1, 1, 1); PG8_STAGE(PG8_SB(1, 0), b3, voffB);
            PG8_BAR; PG8_WAIT_L(0); PG8_MMA(0, 1, At, B1); PG8_BAR;
            PG8_LDA(At, 1, 1); PG8_STAGE(PG8_SA(1, 0), a3, voffA);
            PG8_BAR; PG8_WAIT_L(0); PG8_MMA(1, 0, At, B0); PG8_BAR; PG8_SCHED;
            PG8_STAGE(PG8_SB(1, 1), b3 + hstep, voffB);
            PG8_WAIT_V(6); PG8_BAR; PG8_MMA(1, 1, At, B1); PG8_BAR;
            }
        }
        if constexpr (ALIGN_EPI) { if (wr == 0) PG8_BAR; }
        const typename Side::Tok tok = side.pre();
        if constexpr (!Epi::AFTER_DRAIN) { E(acc, cur, wr, wc, fr, fq); S.done(cur); }
        side.post(tok);
        if (!has_next) break;
#pragma unroll
        for (int a = 0; a < 2; ++a)
#pragma unroll
            for (int b = 0; b < 2; ++b)
#pragma unroll
                for (int m = 0; m < 4; ++m)
#pragma unroll
                    for (int n = 0; n < 2; ++n) acc[a][b][m][n] = (f32x4){0.f, 0.f, 0.f, 0.f};
        cur = nxt; cA = nA; cB = nB; ++ui;
        if constexpr (ALIGN_EPI) { if (wr == 1) PG8_BAR; }
    }
    PG8_WAIT_V(0);
    if constexpr (!ALIGN_EPI) { if (wr == 0) PG8_BAR; }
    PG8_BAR;
    if constexpr (Epi::AFTER_DRAIN) { E.fused(acc, cur, wr, wc, fr, fq, lds, wid, lane); S.done(cur); }
    side.tail();
#undef PG8_SA
#undef PG8_SB
#undef PG8_STAGE
#undef PG8_LDA
#undef PG8_LDB
#undef PG8_MMA
#undef PG8_WAIT_V
#undef PG8_WAIT_L
#undef PG8_BAR
#undef PG8_SCHED
}
}
#define GAS __attribute__((address_space(1)))
#define LAS __attribute__((address_space(3)))
typedef unsigned short bf16;
typedef unsigned v4u __attribute__((ext_vector_type(4)));
typedef float f32x4 __attribute__((ext_vector_type(4)));
typedef short bf16x8 __attribute__((ext_vector_type(8)));
typedef GAS unsigned gu32;
typedef GAS unsigned long long gu64;
#define RLX_AGENT __ATOMIC_RELAXED, __HIP_MEMORY_SCOPE_AGENT
#define LDS_WAIT() asm volatile("s_waitcnt lgkmcnt(0)" ::: "memory")
#define VM_WAIT() asm volatile("s_waitcnt vmcnt(0)" ::: "memory")
__device__ __forceinline__ unsigned long long rt() { return __builtin_amdgcn_s_memrealtime(); }
__device__ __forceinline__ unsigned f2bf(float f) { unsigned u = __builtin_bit_cast(unsigned, f); return (u + 0x7fffu + ((u >> 16) & 1u)) >> 16; }
__device__ __forceinline__ unsigned pk2(float lo, float hi) { return f2bf(lo) | (f2bf(hi) << 16); }

#define XB_TMO      128
#define XB_XCNT(j)  (256  + 64 * (j))
#define XB_XSUB(j)  (1280 + 64 * (j))
#define XB_XGEN(j)  (2304 + 64 * (j))
#define XB_TOP      3328
#define XB_TOPGEN   3392
#define XCD_BAR_WORDS 3456
#define XB_SPIN_CAP (1u << 18)

__device__ __forceinline__ unsigned xb_ld(unsigned* p)              { return __hip_atomic_load(p, __ATOMIC_RELAXED, __HIP_MEMORY_SCOPE_AGENT); }
__device__ __forceinline__ unsigned xb_add(unsigned* p, unsigned v) { return __hip_atomic_fetch_add(p, v, __ATOMIC_RELAXED, __HIP_MEMORY_SCOPE_AGENT); }
__device__ __forceinline__ unsigned xb_xcc_id() { return (unsigned)__builtin_amdgcn_s_getreg((3 << 11) | 20) & 0xFu; }
#define XB_SPIN(cond, bar) do { unsigned _sp = 0; while (cond) { __builtin_amdgcn_s_sleep(1); \
    if ((++_sp & 255u) == 0u) { if (xb_ld(&(bar)[XB_TMO])) break; if (_sp > XB_SPIN_CAP) { atomicAdd(&(bar)[XB_TMO], 1u); break; } } } } while (0)

struct XcdBarrier {
    unsigned* bar; unsigned x;
    volatile LAS unsigned* st;
};

__device__ __forceinline__ XcdBarrier xcd_barrier_post(unsigned* bar, volatile LAS unsigned* st) {
    XcdBarrier b; b.bar = bar; b.x = xb_xcc_id(); b.st = st;
    if (threadIdx.x == 0) (void)xb_add(&bar[XB_XCNT(b.x)], 1u);
    return b;
}
__device__ __forceinline__ void xcd_barrier_complete(unsigned* bar, unsigned x, unsigned& nloc, unsigned& nx) {
    const unsigned G = gridDim.x * gridDim.y * gridDim.z;
    unsigned sum, cnt, mine, sp = 0u;
    for (;;) {
        sum = 0u; cnt = 0u; mine = 0u;
#pragma unroll
        for (unsigned j = 0; j < 16; ++j) { const unsigned c = xb_ld(&bar[XB_XCNT(j)]); sum += c; cnt += (c > 0u) ? 1u : 0u; mine = (j == x) ? c : mine; }
        if (sum == G) break;
        __builtin_amdgcn_s_sleep(1);
        if ((++sp & 255u) == 0u) { if (xb_ld(&bar[XB_TMO])) break; if (sp > XB_SPIN_CAP) { atomicAdd(&bar[XB_TMO], 1u); break; } }
    }
    nloc = mine > 0u ? mine : 1u; nx = cnt > 0u ? cnt : 1u;
}

__device__ __forceinline__ void xcd_barrier(const XcdBarrier& b) {
    asm volatile("s_waitcnt vmcnt(0)" ::: "memory");
    __syncthreads();
    if (threadIdx.x == 0) {
        unsigned* bar = b.bar;
        __builtin_amdgcn_s_waitcnt(0);
        unsigned nloc = b.st[0], nx = b.st[1];
        if (nloc == 0u) { xcd_barrier_complete(bar, b.x, nloc, nx); b.st[0] = nloc; b.st[1] = nx; }
        const unsigned old = xb_add(&bar[XB_XSUB(b.x)], 1u);
        const unsigned gen = old / nloc;
        if (old + 1u == (gen + 1u) * nloc) {
            __builtin_amdgcn_fence(__ATOMIC_RELEASE, "agent");
            asm volatile("s_waitcnt vmcnt(0)" ::: "memory");
            const unsigned og = xb_add(&bar[XB_TOP], 1u);
            const unsigned tg = og / nx;
            if (og + 1u == (tg + 1u) * nx) xb_add(&bar[XB_TOPGEN], 1u);
            else XB_SPIN(xb_ld(&bar[XB_TOPGEN]) == tg, bar);
            __builtin_amdgcn_fence(__ATOMIC_ACQUIRE, "agent");
            xb_add(&bar[XB_XGEN(b.x)], 1u);
            asm volatile("s_waitcnt vmcnt(0)" ::: "memory");
        } else {
            XB_SPIN(xb_ld(&bar[XB_XGEN(b.x)]) == gen, bar);
            __builtin_amdgcn_fence(__ATOMIC_ACQUIRE, "agent");
            asm volatile("s_waitcnt vmcnt(0)" ::: "memory");
        }
    }
    __syncthreads();
}

#define DI __device__ __forceinline__
constexpr int NWAVES = 8;
constexpr int D = 2048, NB = 16, SEQ = 2048, CTXL = 256, DEPTH = 4;
constexpr int TLAT = NB * SEQ, TCTX = NB * CTXL, TT = TLAT + TCTX;
constexpr int FFN = 5632, NMODC = 6 * D;
constexpr int ATT_IN = 2560;
constexpr int SSD_DI = 4096, SSD_CONV = 6144, SSD_INP = 10496  , SSD_INS = 10368;
constexpr int HG_IN = 10240;
constexpr float RMS_EPS = 1e-6f, LOG2E = 1.4426950408889634f;
constexpr float QSCALE = 0.125f * LOG2E;
typedef float f32x16 __attribute__((ext_vector_type(16)));
typedef float f32x2v __attribute__((ext_vector_type(2)));
typedef unsigned u32x2 __attribute__((ext_vector_type(2)));
typedef short s16x4 __attribute__((ext_vector_type(4)));

constexpr size_t MiB = 1u << 20;
constexpr size_t WS_CTL = 0, CTL_ZERO_BYTES = 1 * MiB;
constexpr size_t WS_MODP = 1 * MiB;
constexpr size_t WS_MOD = 28 * MiB;
constexpr size_t WS_TAB = 32 * MiB;
constexpr size_t WS_H = 33 * MiB;
constexpr size_t WS_W = 65 * MiB;
constexpr size_t W_FFN_IN = (size_t)2 * FFN * D * 2, W_FFN_OUT = (size_t)D * FFN * 2;
constexpr size_t WS_WFFN = WS_W;
constexpr size_t W_ATT_IN = (size_t)ATT_IN * D * 2, W_ATT_OUT = (size_t)D * D * 2;
constexpr size_t WS_WATT = WS_WFFN + 4 * (W_FFN_IN + W_FFN_OUT);
constexpr size_t W_SSD_IN = (size_t)SSD_INP * D * 2, W_SSD_OUT = (size_t)D * SSD_DI * 2;
constexpr size_t WS_WSSD = WS_WATT + 2 * (W_ATT_IN + W_ATT_OUT);
constexpr size_t W_HG_IN = (size_t)HG_IN * D * 2, W_HG_OUT = (size_t)D * D * 2;
constexpr size_t WS_WHG = WS_WSSD + W_SSD_IN + W_SSD_OUT;
constexpr size_t WS_WEND = WS_WHG + W_HG_IN + W_HG_OUT;
constexpr size_t WS_U2 = 470 * MiB;
constexpr size_t WS_BIG = 758 * MiB;
constexpr size_t WS_END = 1496 * MiB;
static_assert(WS_WEND <= WS_U2, "weights fit");
constexpr size_t A_KB = WS_BIG;
constexpr size_t A_QB = A_KB + (size_t)TT * 256 * 2;
constexpr size_t A_VTL = A_QB + (size_t)TT * D * 2;
constexpr size_t A_VTC = A_VTL + (size_t)NB * 4 * 64 * SEQ * 2;
constexpr size_t A_O = A_VTC + (size_t)NB * 4 * 64 * CTXL * 2;
constexpr size_t A_Y = A_O + (size_t)TT * D * 2;
static_assert(A_Y + (size_t)TT * D * 4 <= WS_END, "attn map");
constexpr size_t S_XBC = WS_BIG;
constexpr size_t S_Z = S_XBC + (size_t)TT * SSD_CONV * 2;
constexpr size_t S_DT = S_Z + (size_t)TT * SSD_DI * 2;
static_assert(S_DT + (size_t)TT * 128 * 4 <= WS_END, "ssd map");
constexpr size_t H_LG = WS_BIG;
constexpr size_t H_V = H_LG + (size_t)2 * TT * D * 2;
constexpr size_t H_Q = H_V + (size_t)TT * D * 2;
constexpr size_t H_OG = H_Q + (size_t)TT * D * 2;
static_assert(H_OG + (size_t)TT * D * 2 <= WS_END, "hgrn map");
constexpr size_t F_H = WS_BIG;
constexpr size_t F_Y = F_H + (size_t)TT * FFN * 2;
static_assert(F_Y + (size_t)TT * D * 4 <= WS_END, "ffn map");
constexpr int CW_PCNT = 140032, CW_PDONE = 170000;
constexpr int CW_BAR = 4096;

constexpr int RING_BYTES = 131072;
constexpr int LDSCTL_OFF = RING_BYTES, MISC_OFF = LDSCTL_OFF + 320;
constexpr int LDS_BYTES = 163840;
constexpr int CONV_SCR_OFF = 135168, CONV_SCR_WAVE = 3584;

typedef __bf16 bf16x2_t __attribute__((ext_vector_type(2)));
DI unsigned cvtpk(float lo, float hi) { f32x2v v = {lo, hi}; bf16x2_t b = __builtin_convertvector(v, bf16x2_t); return __builtin_bit_cast(unsigned, b); }
DI int lane_id() { int l; asm volatile("v_mbcnt_lo_u32_b32 %0, -1, 0\n\tv_mbcnt_hi_u32_b32 %0, -1, %0" : "=v"(l)); return l; }
DI float bf2f(unsigned short b) { return __uint_as_float((unsigned)b << 16); }
DI float bflo(unsigned w) { return __uint_as_float(w << 16); }
DI float bfhi(unsigned w) { return __uint_as_float(w & 0xffff0000u); }
DI unsigned short f2bf16(float f) { return (unsigned short)(cvtpk(f, 0.f) & 0xffffu); }
DI unsigned pkh(float lo, float hi) { return (unsigned)__builtin_bit_cast(unsigned short, (_Float16)lo) | ((unsigned)__builtin_bit_cast(unsigned short, (_Float16)hi) << 16); }
DI float silu_f(float x) { return x * __builtin_amdgcn_rcpf(1.f + __builtin_amdgcn_exp2f(-x * LOG2E)); }
DI float wave_sum(float v) {
#pragma unroll
    for (int o = 1; o < 64; o <<= 1) v += __shfl_xor(v, o);
    return v;
}
DI int crow(int r, int h) { return (r & 3) + 8 * (r >> 2) + 4 * h; }
DI f32x16 mfma32(bf16x8 a, bf16x8 b, f32x16 c) { return __builtin_amdgcn_mfma_f32_32x32x16_bf16(a, b, c, 0, 0, 0); }
#define SCHED_FENCE() __builtin_amdgcn_sched_barrier(0)
DI bf16x8 lds_frag(LAS unsigned char* p) { return *(LAS bf16x8*)p; }
DI float swap_max(float m) { auto rr = __builtin_amdgcn_permlane32_swap(__float_as_uint(m), __float_as_uint(m), false, false); return fmaxf(__uint_as_float(rr[0]), __uint_as_float(rr[1])); }
DI float swap_sum(float m) { auto rr = __builtin_amdgcn_permlane32_swap(__float_as_uint(m), __float_as_uint(m), false, false); return __uint_as_float(rr[0]) + __uint_as_float(rr[1]); }
DI bf16x8 pack8(const f32x16& x, int s) {
    v4u p; p.x = cvtpk(x[8 * s], x[8 * s + 1]); p.y = cvtpk(x[8 * s + 2], x[8 * s + 3]);
    p.z = cvtpk(x[8 * s + 4], x[8 * s + 5]); p.w = cvtpk(x[8 * s + 6], x[8 * s + 7]);
    return __builtin_bit_cast(bf16x8, p);
}

typedef short v4i16_t __attribute__((ext_vector_type(4)));
DI s16x4 tr16(LAS unsigned char* p) { return __builtin_bit_cast(s16x4, __builtin_amdgcn_ds_read_tr16_b64_v4i16((LAS v4i16_t*)p)); }
DI bf16x8 cat8(s16x4 lo, s16x4 hi) { return (bf16x8){lo[0], lo[1], lo[2], lo[3], hi[0], hi[1], hi[2], hi[3]}; }

using pg8::Unit; using pg8::HALF; using pg8::BM;
struct EpiF32 {
    static constexpr bool PERM = false, AFTER_DRAIN = false;
    float* C; int ldc;
    DI void operator()(const f32x4 (&acc)[2][2][4][2], const Unit& u, int wr, int wc, int fr, int fq) const {
        const int row0 = u.pm * BM + wr * 64 + fr, col0 = u.pn * BM + wc * 32 + 4 * fq;
#pragma unroll
        for (int ai = 0; ai < 2; ++ai)
#pragma unroll
            for (int m = 0; m < 4; ++m) { float* rowp = C + (size_t)(row0 + ai * HALF + m * 16) * ldc + col0;
#pragma unroll
                for (int bj = 0; bj < 2; ++bj)
#pragma unroll
                    for (int n = 0; n < 2; ++n) *(f32x4*)(rowp + bj * HALF + n * 16) = acc[ai][bj][m][n]; }
    }
};
struct EpiBf16Y {
    static constexpr bool PERM = true, AFTER_DRAIN = false;
    bf16* C;
    DI void operator()(const f32x4 (&acc)[2][2][4][2], const Unit& u, int wr, int wc, int fr, int fq) const {
        const int row0 = u.pm * BM + wr * 64 + fr, col0 = u.pn * BM + wc * 32 + 8 * fq;
#pragma unroll
        for (int ai = 0; ai < 2; ++ai)
#pragma unroll
            for (int m = 0; m < 4; ++m) { bf16* rowp = C + (size_t)(row0 + ai * HALF + m * 16) * D + col0;
#pragma unroll
                for (int bj = 0; bj < 2; ++bj) { const f32x4 v0 = acc[ai][bj][m][0], v1 = acc[ai][bj][m][1]; v4u w;
                    w.x = cvtpk(v0[0], v0[1]); w.y = cvtpk(v0[2], v0[3]); w.z = cvtpk(v1[0], v1[1]); w.w = cvtpk(v1[2], v1[3]);
                    *(v4u*)(rowp + bj * HALF) = w; }
                asm volatile("" ::: "memory"); }
    }
};
#ifndef NT_DEFER
#define NT_DEFER 0
#endif
#ifndef NT_WT
#define NT_WT 0
#endif
struct EpiBf16YWT {
    static constexpr bool PERM = true, AFTER_DRAIN = false;
    bf16* C;
    DI void operator()(const f32x4 (&acc)[2][2][4][2], const Unit& u, int wr, int wc, int fr, int fq) const {
        const int row0 = u.pm * BM + wr * 64 + fr, col0 = u.pn * BM + wc * 32 + 8 * fq;
#pragma unroll
        for (int ai = 0; ai < 2; ++ai)
#pragma unroll
            for (int m = 0; m < 4; ++m) { bf16* rowp = C + (size_t)(row0 + ai * HALF + m * 16) * D + col0;
#pragma unroll
                for (int bj = 0; bj < 2; ++bj) { const f32x4 v0 = acc[ai][bj][m][0], v1 = acc[ai][bj][m][1];
                    const unsigned long long lo = (unsigned long long)cvtpk(v0[0], v0[1]) | ((unsigned long long)cvtpk(v0[2], v0[3]) << 32), hi = (unsigned long long)cvtpk(v1[0], v1[1]) | ((unsigned long long)cvtpk(v1[2], v1[3]) << 32);
                    unsigned long long* q = (unsigned long long*)(rowp + bj * HALF);
                    if (NT_WT) { __hip_atomic_store(q, lo, __ATOMIC_RELAXED, __HIP_MEMORY_SCOPE_AGENT); __hip_atomic_store(q + 1, hi, __ATOMIC_RELAXED, __HIP_MEMORY_SCOPE_AGENT); }
                    else *(v4u*)q = (v4u){(unsigned)lo, (unsigned)(lo >> 32), (unsigned)hi, (unsigned)(hi >> 32)}; }
                asm volatile("" ::: "memory"); }
    }
};
struct CountOrder : pg8::StaticOrder {
    unsigned* cnt; mutable int prev = -1;
    DI bool next(int i, Unit& u) const {
        if (!pg8::StaticOrder::next(i, u)) return false;
        const int fm = u.pm & ~3, idx = (u.pm & 3) + 4 * u.pn;
        u.pm = fm + 2 * (idx >> 4) + (idx & 1); u.pn = (idx & 15) >> 1; return true;
    }
    int xcc;
    DI void publish(int pm) const { if (pm >= 0 && (threadIdx.x & 63) == 0) __hip_atomic_fetch_add(cnt + pm * 16 + xcc, 1u, __ATOMIC_RELAXED, __HIP_MEMORY_SCOPE_AGENT); }
    DI void done(const Unit& u) const { if (NT_DEFER) { publish(prev); prev = u.pm; } else { asm volatile("s_waitcnt vmcnt(0)" ::: "memory"); publish(u.pm); } }
    DI void flush() const { asm volatile("s_waitcnt vmcnt(0)" ::: "memory"); publish(prev); prev = -1; }
};
struct SplitTailOrder {
    int G, c, khalf, call;
    DI void init(int K, int G_, int c_, int call_) { G = G_; c = c_; khalf = K / 2; call = call_; }
    DI bool next(int i, Unit& u) const {
        constexpr int nN = D / BM, nwg = (TLAT / BM) * nN;
        const int L = i * G + c;
        if (call == 0) { if (L >= nwg) return false; const int q = nwg / 8, xcd = L % 8, off = L / 8, wgid = xcd * q + off, nig = 8 * nN;
            u.pm = (wgid / nig) * 8 + (wgid % nig) % 8; u.pn = (wgid % nig) / 8; u.koff = 0; return true; }
        if (L >= 256) return false;
        const int t = L >> 1; u.pm = TLAT / BM + (t >> 3); u.pn = t & 7; u.koff = (L & 1) * khalf; return true;
    }
    DI void a_ready(const Unit&) const {}
    DI void done(const Unit&) const {}
};
struct EpiYSplit {
    static constexpr bool PERM = true, AFTER_DRAIN = false;
    bf16* C; float* P; int split;
    DI void operator()(const f32x4 (&acc)[2][2][4][2], const Unit& u, int wr, int wc, int fr, int fq) const {
        const int row0 = u.pm * BM + wr * 64 + fr, col0 = u.pn * BM + wc * 32 + 8 * fq;
        if (!split) {
#pragma unroll
            for (int ai = 0; ai < 2; ++ai)
#pragma unroll
                for (int m = 0; m < 4; ++m) { bf16* rowp = C + (size_t)(row0 + ai * HALF + m * 16) * D + col0;
#pragma unroll
                    for (int bj = 0; bj < 2; ++bj) { const f32x4 v0 = acc[ai][bj][m][0], v1 = acc[ai][bj][m][1]; v4u w;
                        w.x = cvtpk(v0[0], v0[1]); w.y = cvtpk(v0[2], v0[3]); w.z = cvtpk(v1[0], v1[1]); w.w = cvtpk(v1[2], v1[3]);
                        *(v4u*)(rowp + bj * HALF) = w; }
                    asm volatile("" ::: "memory"); }
        } else {
            float* Pb = P + (u.koff ? (size_t)TCTX * D : 0);
#pragma unroll
            for (int ai = 0; ai < 2; ++ai)
#pragma unroll
                for (int m = 0; m < 4; ++m) { float* rowp = Pb + (size_t)(row0 - TLAT + ai * HALF + m * 16) * D + col0;
#pragma unroll
                    for (int bj = 0; bj < 2; ++bj) { *(f32x4*)(rowp + bj * HALF) = acc[ai][bj][m][0]; *(f32x4*)(rowp + bj * HALF + 4) = acc[ai][bj][m][1]; }
                    asm volatile("" ::: "memory"); }
        }
    }
};
struct EpiSwiglu {
    static constexpr bool PERM = true, AFTER_DRAIN = false;
    bf16* H;
    DI void operator()(const f32x4 (&acc)[2][2][4][2], const Unit& u, int wr, int wc, int fr, int fq) const {
        const int row0 = u.pm * BM + wr * 64 + fr, col0 = u.pn * 128 + wc * 32 + 8 * fq;
#pragma unroll
        for (int ai = 0; ai < 2; ++ai)
#pragma unroll
            for (int m = 0; m < 4; ++m) {
                float o[8];
#pragma unroll
                for (int n = 0; n < 2; ++n)
#pragma unroll
                    for (int j = 0; j < 4; ++j) o[4 * n + j] = silu_f(acc[ai][0][m][n][j]) * acc[ai][1][m][n][j];
                v4u w; w.x = cvtpk(o[0], o[1]); w.y = cvtpk(o[2], o[3]); w.z = cvtpk(o[4], o[5]); w.w = cvtpk(o[6], o[7]);
                *(v4u*)(H + (size_t)(row0 + ai * HALF + m * 16) * FFN + col0) = w; }
    }
};
struct EpiAttn {
    static constexpr bool PERM = false, AFTER_DRAIN = false;
    bf16* Kb; bf16* Qb; bf16* VtL; bf16* VtC; const float* rope;
    DI void operator()(const f32x4 (&acc)[2][2][4][2], const Unit& u, int wr, int wc, int fr, int fq) const {
        const int pn = u.pn;
#pragma unroll
        for (int ai = 0; ai < 2; ++ai)
#pragma unroll
            for (int m = 0; m < 4; ++m) {
                const int row = u.pm * BM + ai * HALF + wr * 64 + m * 16 + fr;
                const bool lat = u.pm < TLAT / BM; const int s = row & 2047;
                if (pn == 1) {
                    bf16* base; size_t pitch;
                    if (lat) { base = VtL + (size_t)(row >> 11) * (4 * 64 * SEQ) + s; pitch = SEQ; }
                    else { const int rc = row - TLAT; base = VtC + (size_t)(rc >> 8) * (4 * 64 * CTXL) + (rc & 255); pitch = CTXL; }
#pragma unroll
                    for (int bj = 0; bj < 2; ++bj)
#pragma unroll
                        for (int n = 0; n < 2; ++n)
#pragma unroll
                            for (int j = 0; j < 4; ++j) { const int col = 128 * bj + 32 * wc + 16 * n + 4 * fq + j; base[(size_t)col * pitch] = f2bf16(acc[ai][bj][m][n][j]); }
                } else {
                    const int pos = (wc & 1) ? (s & 63) : (s >> 6);
                    const f32x4* rp = (const f32x4*)(rope + (pos * 16 + 4 * fq) * 2);
                    const f32x4 c01 = rp[0], c23 = rp[1];
                    const float cs[4] = {c01[0], c01[2], c23[0], c23[2]}, sn[4] = {c01[1], c01[3], c23[1], c23[3]};
#pragma unroll
                    for (int bj = 0; bj < 2; ++bj) {
                        const f32x4 t1 = acc[ai][bj][m][0], t2 = acc[ai][bj][m][1]; float o1[4], o2[4];
#pragma unroll
                        for (int j = 0; j < 4; ++j) { o1[j] = lat ? t1[j] * cs[j] - t2[j] * sn[j] : t1[j]; o2[j] = lat ? t2[j] * cs[j] + t1[j] * sn[j] : t2[j]; }
                        bf16* dst; float sc;
                        if (pn == 0) { dst = Kb + (size_t)row * 256 + 128 * bj + 32 * wc + 4 * fq; sc = 1.f; }
                        else { dst = Qb + (size_t)row * D + (pn - 2) * 256 + 128 * bj + 32 * wc + 4 * fq; sc = QSCALE; }
                        u32x2 w1, w2; w1.x = cvtpk(o1[0] * sc, o1[1] * sc); w1.y = cvtpk(o1[2] * sc, o1[3] * sc);
                        w2.x = cvtpk(o2[0] * sc, o2[1] * sc); w2.y = cvtpk(o2[2] * sc, o2[3] * sc);
                        *(u32x2*)dst = w1; *(u32x2*)(dst + 16) = w2;
                    }
                }
                asm volatile("" ::: "memory");
            }
    }
};
struct EpiSsd {
    static constexpr bool PERM = true, AFTER_DRAIN = false;
    bf16* XBC; bf16* Z; float* DT; const float* dt_bias; bf16* HB;
    DI void operator()(const f32x4 (&acc)[2][2][4][2], const Unit& u, int wr, int wc, int fr, int fq) const {
        const int pn = u.pn, row0 = u.pm * BM + wr * 64 + fr, cl = wc * 32 + 8 * fq;
        if (pn < 40) {
            bf16* base; int ldc;
            if (pn < 24) { base = XBC + pn * 256; ldc = SSD_CONV; } else { base = Z + (pn - 24) * 256; ldc = SSD_DI; }
#pragma unroll
            for (int ai = 0; ai < 2; ++ai)
#pragma unroll
                for (int m = 0; m < 4; ++m) { bf16* rowp = base + (size_t)(row0 + ai * HALF + m * 16) * ldc + cl;
#pragma unroll
                    for (int bj = 0; bj < 2; ++bj) { const f32x4 v0 = acc[ai][bj][m][0], v1 = acc[ai][bj][m][1]; v4u w;
                        w.x = cvtpk(v0[0], v0[1]); w.y = cvtpk(v0[2], v0[3]); w.z = cvtpk(v1[0], v1[1]); w.w = cvtpk(v1[2], v1[3]);
                        *(v4u*)(rowp + bj * HALF) = w;
                        const int rr = (row0 + ai * HALF + m * 16) & 255;
                        if (pn < 24 && (rr == 0 || rr == 255)) *(v4u*)(HB + (size_t)(2 * u.pm + (rr & 1)) * SSD_CONV + pn * 256 + cl + bj * HALF) = w; }
                    asm volatile("" ::: "memory"); }
        } else {
            const f32x4 b0 = *(const f32x4*)(dt_bias + cl), b1 = *(const f32x4*)(dt_bias + cl + 4);
#pragma unroll
            for (int ai = 0; ai < 2; ++ai)
#pragma unroll
                for (int m = 0; m < 4; ++m) { float* rowp = DT + (size_t)(row0 + ai * HALF + m * 16) * 128 + cl;
#pragma unroll
                    for (int n = 0; n < 2; ++n) { f32x4 v = acc[ai][0][m][n] + (n ? b1 : b0), o;
#pragma unroll
                        for (int j = 0; j < 4; ++j) { const float x = v[j]; o[j] = fmaxf(x, 0.f) + log1pf(__expf(-fabsf(x))); }
                        *(f32x4*)(rowp + 4 * n) = o; }
                    asm volatile("" ::: "memory"); }
        }
    }
};
struct EpiHgrn {
    static constexpr bool PERM = true, AFTER_DRAIN = false;
    _Float16* LG; bf16* VQG; const float* lbv;
    DI void operator()(const f32x4 (&acc)[2][2][4][2], const Unit& u, int wr, int wc, int fr, int fq) const {
        const int pn = u.pn, row0 = u.pm * BM + wr * 64 + fr, cl = wc * 32 + 8 * fq;
        if (pn < 16) {
            const int dir = pn >> 3, cb = (pn & 7) * 256;
#pragma unroll
            for (int bj = 0; bj < 2; ++bj) {
                const f32x4 l0 = *(const f32x4*)(lbv + dir * D + cb + bj * HALF + cl), l1 = *(const f32x4*)(lbv + dir * D + cb + bj * HALF + cl + 4);
#pragma unroll
                for (int ai = 0; ai < 2; ++ai)
#pragma unroll
                    for (int m = 0; m < 4; ++m) { float o[8];
#pragma unroll
                        for (int n = 0; n < 2; ++n)
#pragma unroll
                            for (int j = 0; j < 4; ++j) { const float f = acc[ai][bj][m][n][j], lb = n ? l1[j] : l0[j];
                                const float e = __builtin_amdgcn_exp2f(-f * LOG2E);
                                o[4 * n + j] = (1.f - lb) * e * __builtin_amdgcn_rcpf(1.f + e); }
                        v4u w; w.x = pkh(o[0], o[1]); w.y = pkh(o[2], o[3]); w.z = pkh(o[4], o[5]); w.w = pkh(o[6], o[7]);
                        *(v4u*)(LG + ((size_t)dir * TT + row0 + ai * HALF + m * 16) * D + cb + bj * HALF + cl) = w;
                        asm volatile("" ::: "memory"); }
            }
        } else {
            const int t = (pn - 16) >> 3, cb = (pn & 7) * 256; bf16* base = VQG + (size_t)t * TT * D + cb;
#pragma unroll
            for (int ai = 0; ai < 2; ++ai)
#pragma unroll
                for (int m = 0; m < 4; ++m) { bf16* rowp = base + (size_t)(row0 + ai * HALF + m * 16) * D + cl;
#pragma unroll
                    for (int bj = 0; bj < 2; ++bj) { f32x4 v0 = acc[ai][bj][m][0], v1 = acc[ai][bj][m][1];
                        if (t == 1) {
#pragma unroll
                            for (int j = 0; j < 4; ++j) { v0[j] = silu_f(v0[j]); v1[j] = silu_f(v1[j]); } }
                        v4u w; w.x = cvtpk(v0[0], v0[1]); w.y = cvtpk(v0[2], v0[3]); w.z = cvtpk(v1[0], v1[1]); w.w = cvtpk(v1[2], v1[3]);
                        *(v4u*)(rowp + bj * HALF) = w; }
                    asm volatile("" ::: "memory"); }
        }
    }
};

struct Frame {
    LAS unsigned char* lds;
    volatile LAS unsigned* MISC;
    gu32* ctl;
    int wave, G, gw, NGW;
};

DI void mod_partial_phase(const Frame& F, const float* c, const float* cctx, const float* ada_w, float* modp) {
    const int lane = lane_id();
    for (int it = F.gw; it < 4 * 48 * 8; it += F.NGW) {
        const int cb = it % 48, ks = (it / 48) & 7, l = it / (8 * 48);
        f32x4 acc[17];
#pragma unroll
        for (int b = 0; b < 17; ++b) acc[b] = (f32x4){0.f, 0.f, 0.f, 0.f};
        const float* W = ada_w + (size_t)l * D * NMODC + cb * 256 + lane * 4;
        for (int kb = 0; kb < 4; ++kb) {
            const int k0 = ks * 256 + kb * 64;
            float sv[17];
#pragma unroll
            for (int b = 0; b < 16; ++b) { const float x = c[b * D + k0 + lane]; sv[b] = x / (1.f + __expf(-x)); }
            { const float x = cctx[k0 + lane]; sv[16] = x / (1.f + __expf(-x)); }
            for (int jj = 0; jj < 64; jj += 8) {
                f32x4 w[8];
#pragma unroll
                for (int q = 0; q < 8; ++q) w[q] = *(const f32x4*)(W + (size_t)(k0 + jj + q) * NMODC);
#pragma unroll
                for (int q = 0; q < 8; ++q)
#pragma unroll
                    for (int b = 0; b < 17; ++b) { const float s = __int_as_float(__builtin_amdgcn_readlane(__float_as_int(sv[b]), jj + q)); acc[b] += w[q] * s; }
            }
        }
#pragma unroll
        for (int b = 0; b < 17; ++b) *(f32x4*)(modp + (((size_t)ks * 4 + l) * 17 + b) * NMODC + cb * 256 + lane * 4) = acc[b];
    }
}

DI int srcmap(int kind, int n) {
    if (kind == 0) return n;
    if (kind == 1) { const int t = n >> 8, w = n & 255; return w < 128 ? 128 * t + w : FFN + 128 * t + (w - 128); }
    if (n < SSD_CONV) return n;
    if (n < SSD_CONV + SSD_DI) return n + 128;
    if (n < SSD_INS) return n - SSD_DI;
    return -1;
}
struct ConvItem { const float* src; bf16* dst; int Nsrc, K; };
DI ConvItem conv_decode(const float* W, int K, int Nsrc, int Ndst, bf16* WT, int kind, int item) {
    const int nblk = Ndst / 32, kb = item / nblk, nb = item % nblk, k0 = 64 * kb, n0 = 32 * nb, s0 = srcmap(kind, n0);
    return ConvItem{s0 >= 0 ? W + (size_t)k0 * Nsrc + s0 : nullptr, WT + (size_t)n0 * K + k0, Nsrc, K};
}
DI void conv_load(const ConvItem& c, f32x4 (&v)[8], int lane) {
    const float* src = c.src + (size_t)(lane >> 3) * c.Nsrc + 4 * (lane & 7);
#pragma unroll
    for (int i = 0; i < 8; ++i) v[i] = c.src ? *(const f32x4*)(src + (size_t)(8 * i) * c.Nsrc) : (f32x4){0.f, 0.f, 0.f, 0.f};
}
DI void conv_finish(const ConvItem& c, const f32x4 (&v)[8], LAS unsigned char* scr, int lane) {
    const int r32 = lane & 31, h = lane >> 5, q4 = (lane & 15) >> 2, p4 = lane & 3, blk = (lane >> 4) & 1;
    bf16* dst = c.dst + (size_t)r32 * c.K + 8 * h;
#pragma unroll
    for (int half = 0; half < 2; ++half) {
#pragma unroll
        for (int i = 0; i < 4; ++i) *(LAS u32x2*)(scr + (8 * i + (lane >> 3)) * 80 + 8 * (lane & 7)) = (u32x2){cvtpk(v[4 * half + i][0], v[4 * half + i][1]), cvtpk(v[4 * half + i][2], v[4 * half + i][3])};
        LDS_WAIT(); asm volatile("" ::: "memory");
#pragma unroll
        for (int cc = 0; cc < 2; ++cc) { LAS unsigned char* p = scr + (16 * cc + 8 * h + q4) * 80 + (16 * blk + 4 * p4) * 2;
            const bf16x8 o = cat8(tr16(p), tr16(p + 4 * 80)); *(GAS bf16x8*)(dst + 16 * (2 * half + cc)) = o; }
        LDS_WAIT(); asm volatile("" ::: "memory");
    }
}
DI ConvItem conv16_decode(const float* W, int K, int Nsrc, int Ndst, bf16* WT, int kind, int item) {
    const int nblk = Ndst / 16, kb = item / nblk, nb = item % nblk, k0 = 64 * kb, n0 = 16 * nb, s0 = srcmap(kind, n0);
    return ConvItem{s0 >= 0 ? W + (size_t)k0 * Nsrc + s0 : nullptr, WT + (size_t)n0 * K + k0, Nsrc, K};
}
DI void conv16_load(const ConvItem& c, f32x4 (&v)[4], int lane) {
    const float* src = c.src + (size_t)(lane >> 2) * c.Nsrc + 4 * (lane & 3);
#pragma unroll
    for (int i = 0; i < 4; ++i) v[i] = c.src ? *(const f32x4*)(src + (size_t)(16 * i) * c.Nsrc) : (f32x4){0.f, 0.f, 0.f, 0.f};
}
DI void conv16_finish(bf16* dst0, int K, const f32x4 (&v)[4], LAS unsigned char* scr, int lane) {
#pragma unroll
    for (int i = 0; i < 4; ++i) *(LAS u32x2*)(scr + (16 * i + (lane >> 2)) * 40 + 8 * (lane & 3)) = (u32x2){cvtpk(v[i][0], v[i][1]), cvtpk(v[i][2], v[i][3])};
    LDS_WAIT(); asm volatile("" ::: "memory");
    const int n = lane & 15, kq = lane >> 4, q4 = (lane & 15) >> 2, p4 = lane & 3;
    bf16* dst = dst0 + (size_t)n * K + 8 * kq;
#pragma unroll
    for (int cc = 0; cc < 2; ++cc) { LAS unsigned char* p = scr + (32 * cc + 8 * kq + q4) * 40 + 8 * p4;
        const bf16x8 o = cat8(tr16(p), tr16(p + 4 * 40)); *(GAS bf16x8*)(dst + 32 * cc) = o; }
    LDS_WAIT(); asm volatile("" ::: "memory");
}
template <int OFF> DI const float* inp_load() { const GAS float* p; asm volatile("s_load_dwordx2 %0, %1, %2\n\ts_waitcnt lgkmcnt(0)" : "=s"(p) : "s"(__builtin_amdgcn_kernarg_segment_ptr()), "n"(OFF)); return (const float*)p; }
#define INP(k) inp_load<(k) * 8>()

constexpr int I_FI = (D / 64) * (2 * FFN / 32), I_FO = (FFN / 64) * (D / 32), I_AI = (D / 64) * (ATT_IN / 32), I_AO = (D / 64) * (D / 32);
constexpr int I_SI = (D / 64) * (SSD_INP / 32), I_SO = (SSD_DI / 64) * (D / 32), I_HI = (D / 64) * (HG_IN / 32), I_HO = I_AO;
template <bool N16> DI int conv_group_items(int l) { if (N16) return 2 * conv_group_items<false>(l); const int k = l % 3; return I_FI + I_FO + (k == 0 ? I_AI + I_AO : (k == 1 ? I_SI + I_SO : I_HI + I_HO)); }
template <bool N16> DI ConvItem conv_group_decode(unsigned char* ws, int l, int r) {
    constexpr int S = N16 ? 2 : 1;
#define CDEC(...) (N16 ? conv16_decode(__VA_ARGS__) : conv_decode(__VA_ARGS__))
    bf16* wf = (bf16*)(ws + WS_WFFN + (size_t)l * (W_FFN_IN + W_FFN_OUT));
    if (r < S * I_FI) return CDEC(INP(7) + (size_t)l * D * 2 * FFN, D, 2 * FFN, 2 * FFN, wf, 1, r);
    r -= S * I_FI;
    if (r < S * I_FO) return CDEC(INP(8) + (size_t)l * FFN * D, FFN, D, D, (bf16*)((unsigned char*)wf + W_FFN_IN), 0, r);
    r -= S * I_FO;
    const int k = l % 3, j = l / 3;
    if (k == 0) { bf16* wb = (bf16*)(ws + WS_WATT + (size_t)j * (W_ATT_IN + W_ATT_OUT));
        if (r < S * I_AI) return CDEC(INP(9) + (size_t)j * D * ATT_IN, D, ATT_IN, ATT_IN, wb, 0, r);
        return CDEC(INP(10) + (size_t)j * D * D, D, D, D, (bf16*)((unsigned char*)wb + W_ATT_IN), 0, r - S * I_AI); }
    if (k == 1) {
        if (r < S * I_SI) return CDEC(INP(12), D, SSD_INS, SSD_INP, (bf16*)(ws + WS_WSSD), 2, r);
        return CDEC(INP(19), SSD_DI, D, D, (bf16*)(ws + WS_WSSD + W_SSD_IN), 0, r - S * I_SI); }
    if (r < S * I_HI) return CDEC(INP(20), D, HG_IN, HG_IN, (bf16*)(ws + WS_WHG), 0, r);
    return CDEC(INP(23), D, D, D, (bf16*)(ws + WS_WHG + W_HG_IN), 0, r - S * I_HI);
#undef CDEC
}
#ifndef BG_CONV
#define BG_CONV 1
#endif
#ifndef BG_SSD
#define BG_SSD 4
#endif
#ifndef BG_HG
#define BG_HG 1
#endif
#ifndef BG_ATT
#define BG_ATT 1
#endif
struct BgConv {
    int l, it;
    DI static unsigned char* wsp() { return (unsigned char*)inp_load<200>(); }
    DI static int wave() { return __builtin_amdgcn_readfirstlane((int)threadIdx.x >> 6); }
    DI static LAS unsigned char* scrp() { extern __shared__ __attribute__((aligned(16))) unsigned char lds_raw[]; return (LAS unsigned char*)lds_raw + CONV_SCR_OFF + wave() * CONV_SCR_WAVE; }
    DI int end() const { return (BG_CONV && l < DEPTH) ? conv_group_items<true>(l) : 0; }
    DI void init(int layer) { l = layer; it = (int)blockIdx.x * NWAVES + wave(); }
    DI void tail() {}
    struct Tok { f32x4 v[4]; };
    DI Tok pre() { Tok t; if (it < end()) { const ConvItem c = conv_group_decode<true>(wsp(), l, it); conv16_load(c, t.v, lane_id()); } return t; }
    DI void post(const Tok& t) { if (it < end()) { const ConvItem c = conv_group_decode<true>(wsp(), l, it); conv16_finish(c.dst, c.K, t.v, scrp(), lane_id()); it += (int)gridDim.x * NWAVES; } }
    DI void drain() {
        unsigned char* ws = wsp(); LAS unsigned char* scr = scrp(); const int step = (int)gridDim.x * NWAVES, e = end();
        while (it < e) {
            const int lane = lane_id();
            const ConvItem c0 = conv_group_decode<true>(ws, l, it); f32x4 v0[4]; conv16_load(c0, v0, lane);
            const int it1 = it + step;
            if (it1 < e) { const ConvItem c1 = conv_group_decode<true>(ws, l, it1); f32x4 v1[4]; conv16_load(c1, v1, lane);
                conv16_finish(c0.dst, c0.K, v0, scr, lane); conv16_finish(c1.dst, c1.K, v1, scr, lane); }
            else conv16_finish(c0.dst, c0.K, v0, scr, lane);
            it += 2 * step;
        }
    }
};
DI void prologue_phase(const Frame& F, unsigned char* ws) {
    LAS unsigned char* scr = F.lds + CONV_SCR_OFF + F.wave * CONV_SCR_WAVE;
    const int lane = lane_id(); const int gt = F.gw * 64 + lane, NGT = F.NGW * 64;
    { const float* modp = (const float*)(ws + WS_MODP); float* mod = (float*)(ws + WS_MOD); const float* ada_b = INP(5);
      for (int i = gt; i < 4 * 17 * NMODC / 4; i += NGT) {
          const int e = i * 4, l = e / (17 * NMODC), n = e % NMODC;
          f32x4 s = *(const f32x4*)(ada_b + l * NMODC + n);
#pragma unroll
          for (int ks = 0; ks < 8; ++ks) s += *(const f32x4*)(modp + (size_t)ks * 4 * 17 * NMODC + e);
          *(f32x4*)(mod + e) = s; } }
    { float* tab = (float*)(ws + WS_TAB);
      if (gt < 1024) { const int pos = gt >> 4, p = gt & 15; const float invf = powf(10000.f, -(float)p / 16.f); const float ang = (float)pos * invf; tab[2 * gt] = cosf(ang); tab[2 * gt + 1] = sinf(ang); }
      float* lbv = (float*)(ws + WS_TAB + 16384); const float* lbr = INP(21);
      if (gt < 2 * D) { const int dir = gt >> 11, d = gt & 2047; float v[4], mx = -1e30f;
#pragma unroll
          for (int l = 0; l < 4; ++l) { v[l] = lbr[(dir * 4 + l) * D + d]; mx = fmaxf(mx, v[l]); }
          float e[4], sum = 0.f;
#pragma unroll
          for (int l = 0; l < 4; ++l) { e[l] = expf(v[l] - mx); sum += e[l]; }
          lbv[gt] = (e[1] + e[2]) / sum; } }
    for (int l = 0; l < (BG_CONV ? (BG_ATT ? 1 : 2) : DEPTH); ++l) {
        const int NIT = conv_group_items<false>(l);
        if (F.gw < NIT) {
            ConvItem cur = conv_group_decode<false>(ws, l, F.gw); f32x4 v[8]; conv_load(cur, v, lane);
            for (int it = F.gw; it < NIT; it += F.NGW) {
                const int nit = it + F.NGW; ConvItem nxt = cur; f32x4 vn[8];
                if (nit < NIT) { nxt = conv_group_decode<false>(ws, l, nit); conv_load(nxt, vn, lane); }
                conv_finish(cur, v, scr, lane);
                cur = nxt;
#pragma unroll
                for (int i = 0; i < 8; ++i) v[i] = vn[i];
            }
        }
    }
}

template <int MODE, bool YSC1 = false>
DI void norm_range(int wbeg, int wend, int nrows, const bf16* y, const float* ysplit, const float* xin_lat, const float* xin_ctx, bf16* xb_lat, bf16* xb_ctx, bf16* xd_lat, float* out_f32,
                   const float* mod_a, int gate_idx, const float* gpost, const float* mod_b, int shift_idx, const float* gpre, bf16* u) {
    constexpr bool HAS_Y = MODE != 0, HAS_U = MODE != 2;
    const int lane = lane_id();
    unsigned vo2 = (unsigned)lane * 16u, vo4 = (unsigned)lane * 32u;
#define NP_B16(p, m) (*(const v4u*)((const unsigned char*)(p) + vo2 + 1024 * (m)))
#define NP_Y16(p, m) (YSC1 ? ({ const unsigned long long* q_ = (const unsigned long long*)((const unsigned char*)(p) + vo2 + 1024 * (m)); const unsigned long long a_ = __hip_atomic_load(q_, __ATOMIC_RELAXED, __HIP_MEMORY_SCOPE_AGENT), b_ = __hip_atomic_load(q_ + 1, __ATOMIC_RELAXED, __HIP_MEMORY_SCOPE_AGENT); (v4u){(unsigned)a_, (unsigned)(a_ >> 32), (unsigned)b_, (unsigned)(b_ >> 32)}; }) : NP_B16(p, m))
#define NP_B(p, k) (*(const u32x2*)((const unsigned char*)(p) + vo2 + 1024 * ((k) >> 1) + 8 * ((k) & 1)))
#define NP_F(p, k) (*(const f32x4*)((const unsigned char*)(p) + vo4 + 2048 * ((k) >> 1) + 16 * ((k) & 1)))
    for (int r0 = wbeg; r0 < wend;) {
        const int mb = r0 < TLAT ? (r0 >> 11) : 16; const bool lat = r0 < TLAT;
        const int bend = lat ? ((r0 >> 11) + 1) << 11 : nrows, rend = wend < bend ? wend : bend, nr = rend - r0;
        asm volatile("" : "+v"(vo2), "+v"(vo4));
        f32x4 GG[8], AA[8], SH[8];
        { const float* ga = HAS_Y ? mod_a + (size_t)mb * NMODC + gate_idx * D : nullptr; const float* sc = HAS_U ? mod_b + (size_t)mb * NMODC + (shift_idx + 1) * D : nullptr;
          const float* sh = HAS_U ? mod_b + (size_t)mb * NMODC + shift_idx * D : nullptr;
#pragma unroll
          for (int k = 0; k < 8; ++k) {
              if (HAS_Y) GG[k] = NP_F(ga, k) * NP_F(gpost, k);
              if (HAS_U) { AA[k] = NP_F(gpre, k) * (NP_F(sc, k) + 1.f); SH[k] = NP_F(sh, k); } } }
        const size_t rl = lat ? (size_t)r0 : (size_t)(r0 - TLAT);
        bf16* xb = (lat ? xb_lat : xb_ctx) + rl * D;
        bf16* xw = (lat ? xd_lat : xb_ctx) + rl * D;
        const float* xin = MODE == 0 ? (lat ? xin_lat : xin_ctx) + rl * D : nullptr;
        const bf16* yp = HAS_Y ? y + (size_t)r0 * D : nullptr;
        f32x4 xf[8]; u32x2 xr[8], yr[8];
        const float* ysp = (HAS_Y && ysplit && !lat) ? ysplit + rl * D : nullptr;
#define NP_Y(rowoff, k) (ysp ? ({ const f32x4 s_ = NP_F(ysp + (size_t)(rowoff) * D, k) + NP_F(ysp + (size_t)TCTX * D + (size_t)(rowoff) * D, k); (u32x2){cvtpk(s_[0], s_[1]), cvtpk(s_[2], s_[3])}; }) : NP_B(yp + (size_t)(rowoff) * D, k))
#pragma unroll
        for (int k = 0; k < 8; ++k) { if (MODE == 0) xf[k] = NP_F(xin, k); if (HAS_Y && ysp) yr[k] = NP_Y(0, k); }
#pragma unroll
        for (int m = 0; m < 4; ++m) { if (MODE != 0) { const v4u t = NP_B16(xb, m); xr[2 * m] = (u32x2){t.x, t.y}; xr[2 * m + 1] = (u32x2){t.z, t.w}; }
            if (HAS_Y && !ysp) { const v4u t = NP_Y16(yp, m); yr[2 * m] = (u32x2){t.x, t.y}; yr[2 * m + 1] = (u32x2){t.z, t.w}; } }
        for (int rr = 0; rr < nr; ++rr) {
            asm volatile("" : "+v"(vo2), "+v"(vo4));
            f32x4 x[8]; u32x2 yc[8];
#pragma unroll
            for (int k = 0; k < 8; ++k) { x[k] = MODE == 0 ? xf[k] : (f32x4){bflo(xr[k].x), bfhi(xr[k].x), bflo(xr[k].y), bfhi(xr[k].y)};
                if (HAS_Y) yc[k] = yr[k]; }
            if (rr + 1 < nr) {
#pragma unroll
                for (int k = 0; k < 8; ++k) { if (MODE == 0) xf[k] = NP_F(xin + (size_t)(rr + 1) * D, k); if (HAS_Y && ysp) yr[k] = NP_Y(rr + 1, k); }
#pragma unroll
                for (int m = 0; m < 4; ++m) { if (MODE != 0) { const v4u t = NP_B16(xb + (size_t)(rr + 1) * D, m); xr[2 * m] = (u32x2){t.x, t.y}; xr[2 * m + 1] = (u32x2){t.z, t.w}; }
                    if (HAS_Y && !ysp) { const v4u t = NP_Y16(yp + (size_t)(rr + 1) * D, m); yr[2 * m] = (u32x2){t.x, t.y}; yr[2 * m + 1] = (u32x2){t.z, t.w}; } } }
            if (HAS_Y) {
                float ss = 0.f;
#pragma unroll
                for (int k = 0; k < 8; ++k) { const float a0 = bflo(yc[k].x), a1 = bfhi(yc[k].x), a2 = bflo(yc[k].y), a3 = bfhi(yc[k].y); ss += (a0 * a0 + a1 * a1) + (a2 * a2 + a3 * a3); }
                const float rs = 1.f / sqrtf(wave_sum(ss) * (1.f / D) + RMS_EPS);
#pragma unroll
                for (int k = 0; k < 8; ++k) x[k] += GG[k] * (f32x4){bflo(yc[k].x), bfhi(yc[k].x), bflo(yc[k].y), bfhi(yc[k].y)} * rs;
            }
            if (MODE == 2) { float* od = out_f32 + (size_t)(r0 + rr) * D;
#pragma unroll
                for (int k = 0; k < 8; ++k) *(f32x4*)((unsigned char*)od + vo4 + 2048 * (k >> 1) + 16 * (k & 1)) = x[k];
            } else {
#pragma unroll
                for (int m = 0; m < 4; ++m) { const f32x4 xa = x[2 * m], xc = x[2 * m + 1]; *(v4u*)((unsigned char*)(xw + (size_t)rr * D) + vo2 + 1024 * m) = (v4u){cvtpk(xa[0], xa[1]), cvtpk(xa[2], xa[3]), cvtpk(xc[0], xc[1]), cvtpk(xc[2], xc[3])}; }
            }
            if (HAS_U) {
                float ss = 0.f;
#pragma unroll
                for (int k = 0; k < 8; ++k) ss += (x[k][0] * x[k][0] + x[k][1] * x[k][1]) + (x[k][2] * x[k][2] + x[k][3] * x[k][3]);
                const float rs = 1.f / sqrtf(wave_sum(ss) * (1.f / D) + RMS_EPS);
                bf16* up = u + (size_t)(r0 + rr) * D;
#pragma unroll
                for (int m = 0; m < 4; ++m) { const f32x4 oa = x[2 * m] * rs * AA[2 * m] + SH[2 * m], oc = x[2 * m + 1] * rs * AA[2 * m + 1] + SH[2 * m + 1];
                    *(v4u*)((unsigned char*)up + vo2 + 1024 * m) = (v4u){cvtpk(oa[0], oa[1]), cvtpk(oa[2], oa[3]), cvtpk(oc[0], oc[1]), cvtpk(oc[2], oc[3])}; }
            }
        }
        r0 = rend;
    }
#undef NP_B
#undef NP_B16
#undef NP_F
#undef NP_Y
#undef NP_Y16
}
template <int MODE>
DI void norm_phase(const Frame& F, int nrows, const bf16* y, const float* ysplit, const float* xin_lat, const float* xin_ctx, bf16* xb_lat, bf16* xb_ctx, bf16* xd_lat, float* out_f32,
                   const float* mod_a, int gate_idx, const float* gpost, const float* mod_b, int shift_idx, const float* gpre, bf16* u) {
    const int per = (nrows + F.NGW - 1) / F.NGW, wbeg = F.gw * per < nrows ? F.gw * per : nrows, wend = wbeg + per < nrows ? wbeg + per : nrows;
    norm_range<MODE>(wbeg, wend, nrows, y, ysplit, xin_lat, xin_ctx, xb_lat, xb_ctx, xd_lat, out_f32, mod_a, gate_idx, gpost, mod_b, shift_idx, gpre, u);
}

#ifndef NT_ON
#define NT_ON 1
#endif
#ifndef NT_TAIL
#define NT_TAIL 1
#endif
#ifndef NT_N2_WHOLE
#define NT_N2_WHOLE 1
#endif
#ifndef NT_N2
#define NT_N2 3
#endif
static_assert(D / 256 == 8 && pg8::WGM == 4 && ((TT / 256) * (D / 256)) % (16 * pg8::NXCD) == 0, "CountOrder's 16-tile runs");
constexpr int NT_NWG = (TT / 256) * (D / 256), NT_Q = NT_NWG / pg8::NXCD, NT_LAST = (NT_NWG % 256) / pg8::NXCD, NT_SPIN = 800;
DI bool panel_late(int pm) {
    const int g = pm / pg8::WGM; bool late = false;
#pragma unroll
    for (int x = 0; x < pg8::NXCD; ++x) { const int lo = (x * NT_Q + NT_Q - NT_LAST) / (pg8::WGM * (D / 256)), hi = (x * NT_Q + NT_Q - 1) / (pg8::WGM * (D / 256)); late |= (NT_LAST > 0) && g >= lo && g <= hi; }
    return late;
}
template <int WHICH>
struct NormTail {
    int l, idle, k;
    const CountOrder* sc;
    struct Tok {}; DI Tok pre() { return Tok{}; } DI void post(const Tok&) {}
    DI void tail() {
        if (NT_DEFER) sc->flush();
        if (!idle) return;
        const int xa = (int)blockIdx.x % pg8::NXCD, j = k / pg8::NXCD;
        const int pm = 2 * (xa * NT_Q / 16) + j;
        if (j >= 2 * ((NT_Q - NT_LAST) / 16) || pm >= TT / 256) return;
        unsigned char* ws = BgConv::wsp(); unsigned* ctl = (unsigned*)(ws + WS_CTL);
        extern __shared__ __attribute__((aligned(16))) unsigned char lds_raw[];
        volatile LAS unsigned* flag = (volatile LAS unsigned*)((LAS unsigned char*)lds_raw + MISC_OFF) + 16;
        if (threadIdx.x == 0) { unsigned ok = 0u; unsigned* slot = ctl + CW_PCNT + (l * 2 + WHICH) * 4096 + pm * 16;
            for (int sp = 0; sp < NT_SPIN; ++sp) {
                if (__hip_atomic_load(slot + sc->xcc, __ATOMIC_RELAXED, __HIP_MEMORY_SCOPE_AGENT) >= 64u) { ok = 1u; break; }
                if ((sp & 15) == 15) { unsigned tot = 0u; for (int q = 0; q < 16; ++q) tot += __hip_atomic_load(slot + q, __ATOMIC_RELAXED, __HIP_MEMORY_SCOPE_AGENT); if (tot >= 64u && __hip_atomic_load(slot + sc->xcc, __ATOMIC_RELAXED, __HIP_MEMORY_SCOPE_AGENT) < 64u) break; }
                __builtin_amdgcn_s_sleep(8); }
            __builtin_amdgcn_fence(__ATOMIC_ACQUIRE, "agent"); asm volatile("s_waitcnt vmcnt(0)" ::: "memory");
            *flag = ok; }
        __syncthreads();
        const unsigned ok = *flag;
        if (!ok) return;
        const int w = __builtin_amdgcn_readfirstlane((int)threadIdx.x >> 6), kind = l % 3;
        const float* mod = (const float*)(ws + WS_MOD); const float* modl = mod + (size_t)l * 17 * NMODC;
        bf16* xbl = (bf16*)inp_load<192>();
        for (int hf = 0; hf < ((WHICH || kind == 1 || NT_N2_WHOLE) ? 2 : 1); ++hf) {
            const int r0 = pm * 256 + 128 * hf + 16 * w;
            if (WHICH) norm_range<1, NT_WT != 0>(r0, r0 + 16, TT, (const bf16*)(ws + F_Y), nullptr, nullptr, nullptr, xbl, (bf16*)(ws + WS_H), xbl, nullptr,
                                                 modl, 5, INP(6) + (l * 4 + 3) * D, modl + 17 * NMODC, 0, INP(6) + ((l + 1) * 4 + 0) * D, (bf16*)(ws + WS_U2));
            else norm_range<1, NT_WT != 0>(r0, r0 + 16, TT, (const bf16*)(ws + (kind == 0 ? A_Y : (kind == 1 ? S_XBC : H_V))), nullptr, nullptr, nullptr, xbl, (bf16*)(ws + WS_H), xbl, nullptr,
                                           modl, 2, INP(6) + (l * 4 + 1) * D, modl, 3, INP(6) + (l * 4 + 2) * D, (bf16*)(ws + (kind == 1 ? S_Z : WS_U2)));
            __syncthreads();
            if (threadIdx.x == 0) ctl[CW_PDONE + (l * 2 + WHICH) * 512 + 2 * pm + hf] = 1u;
        }
    }
};
DI void norm_rest_phase(const Frame& F, int l, int which, const bf16* y, bf16* xb_lat, bf16* xb_ctx, const float* mod_a, int gate_idx, const float* gpost, const float* mod_b, int shift_idx, const float* gpre, bf16* u) {
    const unsigned* done = (const unsigned*)F.ctl + CW_PDONE + (l * 2 + which) * 512;
    LAS unsigned* list = (LAS unsigned*)F.lds;
    const int lane = lane_id();
    constexpr int NHP = 2 * (TT / 256);
    if (F.wave == 0) { int base = 0;
#pragma unroll
        for (int j = 0; j < (NHP + 63) / 64; ++j) { const int p = lane + 64 * j; const bool nd = p < NHP && done[p < NHP ? p : 0] == 0u; const unsigned long long m = __ballot(nd);
            if (nd) list[base + __popcll(m & ((1ull << lane) - 1ull))] = (unsigned)p; base += __popcll(m); }
        if (lane == 0) list[320] = (unsigned)base; }
    __syncthreads();
    const int P = __builtin_amdgcn_readfirstlane((int)list[320]), R = P * 128;
    const int per = (R + F.NGW - 1) / F.NGW; int cr = F.gw * per < R ? F.gw * per : R; const int cend = cr + per < R ? cr + per : R;
    while (cr < cend) {
        const int o = cr & 127, hp = __builtin_amdgcn_readfirstlane((int)list[cr >> 7]), n = (cend - cr) < (128 - o) ? (cend - cr) : (128 - o), r0 = hp * 128 + o;
        norm_range<1>(r0, r0 + n, TT, y, nullptr, nullptr, nullptr, xb_lat, xb_ctx, xb_lat, nullptr, mod_a, gate_idx, gpost, mod_b, shift_idx, gpre, u);
        cr += n;
    }
    __syncthreads();
}

#ifndef AT_THR
#define AT_THR 8.f
#endif
constexpr int AT_KP = 144, AT_VP = 648, AT_LV = 320 * AT_KP;
#define AT_BAR() do { asm volatile("s_waitcnt lgkmcnt(0)" ::: "memory"); __builtin_amdgcn_s_barrier(); asm volatile("" ::: "memory"); } while (0)
DI void attn_phase(const Frame& F, const bf16* Kb, const bf16* Qb, const bf16* VtL, const bf16* VtC, const float* sink, bf16* O, bool need_ctx, BgConv& bg) {
    const int lane0 = lane_id(), wid = F.wave;
    LAS unsigned char* ldsK = F.lds; LAS unsigned char* ldsV = F.lds + AT_LV;
    const int nunits = need_ctx ? 2304 : 2048;
    v4u pk[5], pvv[5];
#define AT_LOAD(un_, pass_, tid_) do { const int u_ = (un_); int b_, q0_, kvh_; \
        if (u_ < 2048) { kvh_ = u_ & 3; q0_ = ((u_ >> 2) & 31) * 64; b_ = u_ >> 7; } else { const int v_ = u_ - 2048; kvh_ = v_ & 3; q0_ = ((v_ >> 2) & 3) * 64; b_ = v_ >> 4; } \
        if ((pass_) == 0) { \
            _Pragma("unroll") for (int i_ = 0; i_ < 5; ++i_) { const int idx_ = (tid_) + 512 * i_, row_ = idx_ >> 3, part_ = idx_ & 7, s_ = q0_ - 128 + row_; \
                pk[i_] = (s_ >= 0 && s_ < SEQ) ? *(const v4u*)(Kb + (size_t)(b_ * SEQ + s_) * 256 + kvh_ * 64 + part_ * 8) : (v4u){0u, 0u, 0u, 0u}; \
                const int d_ = idx_ / 40, pv_ = idx_ % 40, s0_ = q0_ - 128 + pv_ * 8; \
                pvv[i_] = (s0_ >= 0 && s0_ < SEQ) ? *(const v4u*)(VtL + ((size_t)((b_ * 4 + kvh_) * 64 + d_)) * SEQ + s0_) : (v4u){0u, 0u, 0u, 0u}; } \
        } else { \
            _Pragma("unroll") for (int i_ = 0; i_ < 4; ++i_) { const int idx_ = (tid_) + 512 * i_; \
                pk[i_] = *(const v4u*)(Kb + (size_t)(TLAT + b_ * CTXL + (idx_ >> 3)) * 256 + kvh_ * 64 + (idx_ & 7) * 8); \
                pvv[i_] = *(const v4u*)(VtC + ((size_t)((b_ * 4 + kvh_) * 64 + (idx_ >> 5))) * CTXL + (idx_ & 31) * 8); } \
        } } while (0)
    int un = blockIdx.x, pass = un >= 2048 ? 1 : 0;
    if (un < nunits) AT_LOAD(un, pass, wid * 64 + lane0);
    bf16x8 qf[2][4]; float m_[2], l_[2]; f32x16 o[2][2];
    while (un < nunits) {
        int lane = lane0; asm volatile("" : "+v"(lane));
        const int tid = wid * 64 + lane, r32 = lane & 31, h = lane >> 5;
        const bool cq = un >= 2048; int b, qblk, kvh;
        if (!cq) { kvh = un & 3; qblk = (un >> 2) & 31; b = un >> 7; } else { const int v = un - 2048; kvh = v & 3; qblk = (v >> 2) & 3; b = v >> 4; }
        const int q0 = qblk * 64, hq = kvh * 8 + wid;
        const size_t qrow0 = cq ? (size_t)(TLAT + b * CTXL + q0) : (size_t)(b * SEQ + q0);
        if (pass == (cq ? 1 : 0)) {
#pragma unroll
            for (int rb = 0; rb < 2; ++rb)
#pragma unroll
                for (int d0 = 0; d0 < 4; ++d0) qf[rb][d0] = *(const bf16x8*)(Qb + (qrow0 + 32 * rb + r32) * D + hq * 64 + 16 * d0 + 8 * h);
            const float sk = sink[hq] * LOG2E;
#pragma unroll
            for (int rb = 0; rb < 2; ++rb) { m_[rb] = sk; l_[rb] = h == 0 ? 1.f : 0.f;
#pragma unroll
                for (int db = 0; db < 2; ++db)
#pragma unroll
                    for (int i = 0; i < 16; ++i) o[rb][db][i] = 0.f; }
        }
        AT_BAR();
        if (pass == 0) {
#pragma unroll
            for (int i = 0; i < 5; ++i) { const int idx = tid + 512 * i; *(LAS v4u*)(ldsK + (idx >> 3) * AT_KP + (idx & 7) * 16) = pk[i];
                const int d = idx / 40, part = idx % 40; *(LAS u32x2*)(ldsV + d * AT_VP + part * 16) = (u32x2){pvv[i].x, pvv[i].y}; *(LAS u32x2*)(ldsV + d * AT_VP + part * 16 + 8) = (u32x2){pvv[i].z, pvv[i].w}; }
        } else {
#pragma unroll
            for (int i = 0; i < 4; ++i) { const int idx = tid + 512 * i; *(LAS v4u*)(ldsK + (idx >> 3) * AT_KP + (idx & 7) * 16) = pk[i];
                const int d = idx >> 5, part = idx & 31; *(LAS u32x2*)(ldsV + d * AT_VP + part * 16) = (u32x2){pvv[i].x, pvv[i].y}; *(LAS u32x2*)(ldsV + d * AT_VP + part * 16 + 8) = (u32x2){pvv[i].z, pvv[i].w}; }
        }
        int nun = un, npass = pass + 1;
        if (npass > 1) { nun = un + F.G; npass = nun >= 2048 ? 1 : 0; }
        if (nun < nunits) AT_LOAD(nun, npass, tid);
        AT_BAR();
        const int nkt = pass == 0 ? 10 : 8;
#pragma unroll 2
        for (int kt = 0; kt < nkt; ++kt) {
#if BG_ATT
            const BgConv::Tok tok = bg.pre();
#endif
            bf16x8 kf[4], vf[2][2];
#pragma unroll
            for (int d0 = 0; d0 < 4; ++d0) kf[d0] = lds_frag(ldsK + (32 * kt + r32) * AT_KP + 32 * d0 + 16 * h);
#pragma unroll
            for (int db = 0; db < 2; ++db)
#pragma unroll
                for (int s = 0; s < 2; ++s) { LAS unsigned char* vp = ldsV + (32 * db + r32) * AT_VP + (32 * kt + 16 * s + 4 * h) * 2;
                    const s16x4 vlo = *(LAS s16x4*)vp, vhi = *(LAS s16x4*)(vp + 16);
                    vf[db][s] = (bf16x8){vlo[0], vlo[1], vlo[2], vlo[3], vhi[0], vhi[1], vhi[2], vhi[3]}; }
#pragma unroll
            for (int rb = 0; rb < 2; ++rb) {
                if (pass == 0 && (kt < rb || kt > 8 + rb)) continue;
                const int t = pass == 0 ? kt - rb : kt;
                const int r = 32 * rb + r32;
                const int lo = max(r, 128 - q0), hi = min(r + 256, 2047 + 128 - q0);
                f32x16 p;
                { const float nm = -m_[rb];
#pragma unroll
                  for (int i = 0; i < 16; ++i) p[i] = nm; }
#pragma unroll
                for (int d0 = 0; d0 < 4; ++d0) p = mfma32(kf[d0], qf[rb][d0], p);
                if (pass == 0 && (t == 0 || t == 8 || q0 < 128 || q0 >= SEQ - 192)) {
#pragma unroll
                    for (int i = 0; i < 16; ++i) { const int c = 32 * kt + crow(i, h); if (c < lo || c > hi) p[i] = -INFINITY; }
                }
                float tm = p[0];
#pragma unroll
                for (int i = 1; i < 16; ++i) tm = fmaxf(tm, p[i]);
                tm = swap_max(tm);
                float alpha = 1.f;
                if (__any(tm > AT_THR)) {
                    const float d = fmaxf(tm, 0.f); alpha = __builtin_amdgcn_exp2f(-d); m_[rb] += d;
#pragma unroll
                    for (int i = 0; i < 16; ++i) p[i] -= d;
#pragma unroll
                    for (int db = 0; db < 2; ++db)
#pragma unroll
                        for (int i = 0; i < 16; ++i) o[rb][db][i] *= alpha; }
                float ls = 0.f;
#pragma unroll
                for (int i = 0; i < 16; ++i) { p[i] = __builtin_amdgcn_exp2f(p[i]); ls += p[i]; }
                l_[rb] = l_[rb] * alpha + ls;
                const bf16x8 pf0 = pack8(p, 0), pf1 = pack8(p, 1);
#pragma unroll
                for (int db = 0; db < 2; ++db)
#pragma unroll
                    for (int s = 0; s < 2; ++s) o[rb][db] = mfma32(vf[db][s], s == 0 ? pf0 : pf1, o[rb][db]);
            }
#if BG_ATT
            bg.post(tok);
#endif
        }
        if (pass == 1) {
#pragma unroll
            for (int rb = 0; rb < 2; ++rb) {
                const float inv = 1.f / swap_sum(l_[rb]);
                bf16* orow = O + (qrow0 + 32 * rb + r32) * D + hq * 64;
#pragma unroll
                for (int db = 0; db < 2; ++db)
#pragma unroll
                    for (int g4 = 0; g4 < 4; ++g4) { u32x2 w; w.x = cvtpk(o[rb][db][4 * g4] * inv, o[rb][db][4 * g4 + 1] * inv); w.y = cvtpk(o[rb][db][4 * g4 + 2] * inv, o[rb][db][4 * g4 + 3] * inv);
                        *(u32x2*)(orow + 32 * db + 8 * g4 + 4 * h) = w; }
            }
        }
        un = nun; pass = npass;
    }
#undef AT_LOAD
    bg.drain();
    __syncthreads();
}

DI void ssd_conv_phase(const Frame& F, bf16* XBC, const bf16* HB, const float* cw, const float* cb) {
    const int lane = lane_id();
    for (int it = F.gw; it < (TT / 256) * 24; it += F.NGW) {
        const int seg = it / 24, col = (it % 24) * 256 + lane * 4;
        const bool first = seg >= TLAT / 256 || (seg & 7) == 0, last = seg >= TLAT / 256 || (seg & 7) == 7;
        const f32x4 w0 = *(const f32x4*)(cw + col), w1 = *(const f32x4*)(cw + SSD_CONV + col), w2 = *(const f32x4*)(cw + 2 * SSD_CONV + col), bb = *(const f32x4*)(cb + col);
        u32x2* base = (u32x2*)(XBC + (size_t)seg * 256 * SSD_CONV + col);
        u32x2 prev = first ? (u32x2){0u, 0u} : *(const u32x2*)(HB + (size_t)(2 * (seg - 1) + 1) * SSD_CONV + col);
        const u32x2 nxt = last ? (u32x2){0u, 0u} : *(const u32x2*)(HB + (size_t)(2 * (seg + 1)) * SSD_CONV + col);
        for (int t0 = 0; t0 < 256; t0 += 32) {
            u32x2 raw[33];
#pragma unroll
            for (int i = 0; i < 32; ++i) raw[i] = base[(size_t)(t0 + i) * (SSD_CONV / 4)];
            raw[32] = (t0 + 32 < 256) ? base[(size_t)(t0 + 32) * (SSD_CONV / 4)] : nxt;
#pragma unroll
            for (int i = 0; i < 32; ++i) {
                const u32x2 a = i == 0 ? prev : raw[i - 1], b = raw[i], c2 = raw[i + 1];
                const float o0 = bb[0] + w0[0] * bflo(a.x) + w1[0] * bflo(b.x) + w2[0] * bflo(c2.x), o1 = bb[1] + w0[1] * bfhi(a.x) + w1[1] * bfhi(b.x) + w2[1] * bfhi(c2.x);
                const float o2 = bb[2] + w0[2] * bflo(a.y) + w1[2] * bflo(b.y) + w2[2] * bflo(c2.y), o3 = bb[3] + w0[3] * bfhi(a.y) + w1[3] * bfhi(b.y) + w2[3] * bfhi(c2.y);
                base[(size_t)(t0 + i) * (SSD_CONV / 4)] = (u32x2){cvtpk(silu_f(o0), silu_f(o1)), cvtpk(silu_f(o2), silu_f(o3))};
            }
            prev = raw[31];
        }
    }
}

DI void ssd_fin_phase(const Frame& F, bf16* Y, const bf16* Z, const float* nw) {
    const int lane = lane_id();
    for (int row = F.gw; row < TT; row += F.NGW) {
#pragma unroll 2
        for (int k = 0; k < 8; ++k) {
            const int col = 512 * k + 8 * lane;
            const v4u yv = *(const v4u*)(Y + (size_t)row * SSD_DI + col), zv = *(const v4u*)(Z + (size_t)row * SSD_DI + col);
            float t[8]; float ss = 0.f;
#pragma unroll
            for (int e = 0; e < 4; ++e) { const unsigned yw = yv[e], zw = zv[e];
                t[2 * e] = bflo(yw) * silu_f(bflo(zw)); t[2 * e + 1] = bfhi(yw) * silu_f(bfhi(zw));
                ss += t[2 * e] * t[2 * e] + t[2 * e + 1] * t[2 * e + 1]; }
            const float rs = 1.f / sqrtf(wave_sum(ss) * (1.f / 512.f) + RMS_EPS);
            const f32x4 n0 = *(const f32x4*)(nw + col), n1 = *(const f32x4*)(nw + col + 4);
            v4u o; o.x = cvtpk(t[0] * rs * n0[0], t[1] * rs * n0[1]); o.y = cvtpk(t[2] * rs * n0[2], t[3] * rs * n0[3]);
            o.z = cvtpk(t[4] * rs * n1[0], t[5] * rs * n1[1]); o.w = cvtpk(t[6] * rs * n1[2], t[7] * rs * n1[3]);
            *(v4u*)(Y + (size_t)row * SSD_DI + col) = o;
        }
    }
}

DI void hgrn_fin_phase(const Frame& F, const bf16* O, const bf16* OG, const float* nw, bf16* Gp) {
    const int lane = lane_id();
    for (int row = F.gw; row < TT; row += F.NGW) {
#pragma unroll
        for (int k = 0; k < 4; ++k) {
            const int col = 512 * k + 8 * lane;
            const v4u of = *(const v4u*)(O + (size_t)row * D + col), ob = *(const v4u*)(O + (size_t)TT * D + (size_t)row * D + col), gv = *(const v4u*)(OG + (size_t)row * D + col);
            const f32x4 n0 = *(const f32x4*)(nw + col), n1 = *(const f32x4*)(nw + col + 4);
            float o[8]; float ss = 0.f;
#pragma unroll
            for (int e = 0; e < 4; ++e) { o[2 * e] = bflo(of[e]) + bflo(ob[e]); o[2 * e + 1] = bfhi(of[e]) + bfhi(ob[e]); ss += o[2 * e] * o[2 * e] + o[2 * e + 1] * o[2 * e + 1]; }
#pragma unroll
            for (int sft = 1; sft < 16; sft <<= 1) ss += __shfl_xor(ss, sft);
            const float rs = 1.f / sqrtf(ss * (1.f / 128.f) + RMS_EPS);
            v4u w;
#pragma unroll
            for (int e = 0; e < 4; ++e) { const float na = e < 2 ? n0[2 * e] : n1[2 * e - 4], nb = e < 2 ? n0[2 * e + 1] : n1[2 * e - 3];
                w[e] = cvtpk(o[2 * e] * rs * na * silu_f(bflo(gv[e])), o[2 * e + 1] * rs * nb * silu_f(bfhi(gv[e]))); }
            *(v4u*)(Gp + (size_t)row * D + col) = w;
        }
    }
}

#define WGBAR() do { asm volatile("s_waitcnt lgkmcnt(0)" ::: "memory"); __builtin_amdgcn_s_barrier(); asm volatile("" ::: "memory"); } while (0)
constexpr int S2_BM = 0, S2_CM = 17408, S2_GT = 34816, S2_XR = 52224, S2_PW = 89088;
DI size_t scan_rowbase(int dir, int step, int b) {
    if (dir == 0) return step < 4 ? (size_t)(TLAT + b * CTXL + 64 * step) : (size_t)(b * SEQ + 64 * (step - 4));
    return step < 4 ? (size_t)(TLAT + b * CTXL + 64 * (3 - step)) : (size_t)(b * SEQ + 64 * (35 - step));
}
DI void ssd_scan2_phase(const Frame& F, const bf16* XBC, const float* DT, const float* a_log, const float* dsk, bf16* Y, BgConv& bg) {
    const int lane0 = lane_id(), wid = F.wave;
    LAS unsigned char* L = F.lds;
    for (int un = blockIdx.x; un < NB * 16; un += F.G) {
        const int b = un >> 4, hg = un & 15, grp = hg >> 1, hd = hg * 4 + (wid >> 1), pt = wid & 1;
        LAS unsigned char* XRh = L + S2_XR + (wid >> 1) * 9216;
        LAS float* PW = (LAS float*)(L + S2_PW + wid * 1024);
        for (int dir = 0; dir < 2; ++dir) {
            const float a = -__expf(a_log[dir * 64 + hd]), dskip = dsk[hd];
            f32x16 st[4];
#pragma unroll
            for (int nb = 0; nb < 4; ++nb)
#pragma unroll
                for (int i = 0; i < 16; ++i) st[nb][i] = 0.f;
            v4u pb[2], pc[2], px[4]; float pdt;
#define S2_LOAD(stp, ln) do { const size_t rb_ = scan_rowbase(dir, (stp), b); const int tid_ = wid * 64 + (ln); \
                _Pragma("unroll") for (int q_ = 0; q_ < 2; ++q_) { const int idx_ = tid_ + 512 * q_, j_ = idx_ >> 4, part_ = idx_ & 15, tj_ = dir ? 63 - j_ : j_; \
                    const bf16* src_ = XBC + (rb_ + tj_) * SSD_CONV + SSD_DI + grp * 128 + part_ * 8; pb[q_] = *(const v4u*)src_; pc[q_] = *(const v4u*)(src_ + 1024); } \
                _Pragma("unroll") for (int q_ = 0; q_ < 4; ++q_) { const int j_ = 32 * (wid & 1) + 8 * q_ + ((ln) >> 3), tj_ = dir ? 63 - j_ : j_; \
                    px[q_] = *(const v4u*)(XBC + (rb_ + tj_) * SSD_CONV + hd * 64 + ((ln) & 7) * 8); } \
                pdt = DT[(rb_ + (dir ? 63 - (ln) : (ln))) * 128 + dir * 64 + hd]; } while (0)
            S2_LOAD(0, lane0);
            for (int step = 0; step < 36; ++step) {
                int lane = lane0; asm volatile("" : "+v"(lane));
                const int tid = wid * 64 + lane, r32 = lane & 31, h = lane >> 5, q4 = (lane & 15) >> 2, p4 = lane & 3, blk = (lane >> 4) & 1;
                const size_t rowbase = scan_rowbase(dir, step, b);
                WGBAR();
#pragma unroll
                for (int q = 0; q < 2; ++q) { const int idx = tid + 512 * q, j = idx >> 4, part = idx & 15;
                    *(LAS v4u*)(L + S2_BM + j * 272 + part * 16) = pb[q]; *(LAS v4u*)(L + S2_CM + j * 272 + part * 16) = pc[q]; }
#pragma unroll
                for (int q = 0; q < 4; ++q) { const int j = 32 * (wid & 1) + 8 * q + (lane >> 3); *(LAS v4u*)(XRh + j * 144 + (lane & 7) * 16) = px[q]; }
                const float dtv = pdt; float ac = dtv * a;
#pragma unroll
                for (int off = 1; off < 64; off <<= 1) { const float t = __shfl_up(ac, off); if (lane >= off) ac += t; }
                const float tot = __int_as_float(__builtin_amdgcn_readlane(__float_as_int(ac), 63));
                { const float la = ac * LOG2E; PW[lane] = la; PW[64 + lane] = __builtin_amdgcn_exp2f(la); PW[128 + lane] = la - __builtin_amdgcn_logf(dtv); PW[192 + lane] = dtv * __expf(tot - ac); }
                if (step + 1 < 36) S2_LOAD(step + 1, lane);
                WGBAR();
#if BG_SSD == 1
                const BgConv::Tok tok = bg.pre();
#endif
                v4u yold[2][2];
                unsigned yoff[2];
#pragma unroll
                for (int it = 0; it < 2; ++it) { const int i = 32 * it + r32, ti = dir ? 63 - i : i; yoff[it] = (unsigned)(((rowbase + ti) * SSD_DI + hd * 64 + 32 * pt + 8 * h) * 2); }
                if (dir) {
#pragma unroll
                    for (int it = 0; it < 2; ++it)
#pragma unroll
                        for (int pr = 0; pr < 2; ++pr) yold[it][pr] = *(const v4u*)((const unsigned char*)Y + yoff[it] + 32 * pr);
                }
                if (wid < 3) {
                    const int jt = wid >> 1, it = wid == 0 ? 0 : 1, i = 32 * it + r32;
                    f32x16 g;
#pragma unroll
                    for (int q = 0; q < 16; ++q) g[q] = 0.f;
#pragma unroll
                    for (int ks = 0; ks < 8; ++ks) g = mfma32(lds_frag(L + S2_BM + (32 * jt + r32) * 272 + 32 * ks + 16 * h), lds_frag(L + S2_CM + i * 272 + 32 * ks + 16 * h), g);
#pragma unroll
                    for (int g4 = 0; g4 < 4; ++g4) *(LAS f32x4*)(L + S2_GT + i * 272 + (32 * jt + 8 * g4 + 4 * h) * 4) = (f32x4){g[4 * g4], g[4 * g4 + 1], g[4 * g4 + 2], g[4 * g4 + 3]};
                }
                f32x16 yacc[2];
#pragma unroll
                for (int it = 0; it < 2; ++it)
#pragma unroll
                    for (int q = 0; q < 16; ++q) yacc[it][q] = 0.f;
#pragma unroll
                for (int nb = 0; nb < 4; ++nb) {
                    bf16x8 cf[2][2];
#pragma unroll
                    for (int s = 0; s < 2; ++s)
#pragma unroll
                        for (int it = 0; it < 2; ++it) { LAS unsigned char* cp = L + S2_CM + (32 * it + r32) * 272 + (32 * nb + 16 * s + 4 * h) * 2; cf[s][it] = cat8(*(LAS s16x4*)cp, *(LAS s16x4*)(cp + 16)); }
                    SCHED_FENCE();
#pragma unroll
                    for (int s = 0; s < 2; ++s) { const bf16x8 bfr = pack8(st[nb], s);
#pragma unroll
                        for (int it = 0; it < 2; ++it) yacc[it] = mfma32(bfr, cf[s][it], yacc[it]); }
                    SCHED_FENCE(); }
#pragma unroll
                for (int it = 0; it < 2; ++it) { const float ea = PW[64 + 32 * it + r32];
#pragma unroll
                    for (int q = 0; q < 16; ++q) yacc[it][q] *= ea; }
                WGBAR();
#if BG_SSD == 2
                const BgConv::Tok tok = bg.pre();
#endif
#pragma unroll
                for (int it = 0; it < 2; ++it) { const int i = 32 * it + r32; const float aci = PW[i];
#pragma unroll
                    for (int s = 0; s < 4; ++s) { if (s >= 2 * (it + 1)) continue;
                        const int j0 = 16 * s + 8 * h;
                        const f32x4 g0 = *(LAS f32x4*)(L + S2_GT + i * 272 + j0 * 4), g1 = *(LAS f32x4*)(L + S2_GT + i * 272 + j0 * 4 + 16);
                        const f32x4 a0 = *(LAS f32x4*)(PW + 128 + j0), a1 = *(LAS f32x4*)(PW + 128 + j0 + 4);
                        float m[8];
#pragma unroll
                        for (int e = 0; e < 4; ++e) { m[e] = (j0 + e <= i) ? g0[e] * __builtin_amdgcn_exp2f(aci - a0[e]) : 0.f; m[4 + e] = (j0 + 4 + e <= i) ? g1[e] * __builtin_amdgcn_exp2f(aci - a1[e]) : 0.f; }
                        v4u mp; mp.x = cvtpk(m[0], m[1]); mp.y = cvtpk(m[2], m[3]); mp.z = cvtpk(m[4], m[5]); mp.w = cvtpk(m[6], m[7]);
                        LAS unsigned char* xp = XRh + (16 * s + 8 * h + q4) * 144 + (32 * pt + 16 * blk + 4 * p4) * 2;
                        yacc[it] = mfma32(cat8(tr16(xp), tr16(xp + 4 * 144)), __builtin_bit_cast(bf16x8, mp), yacc[it]); } }
#if BG_SSD == 4
                const BgConv::Tok tok = bg.pre();
#endif
#pragma unroll
                for (int it = 0; it < 2; ++it)
#pragma unroll
                    for (int pr = 0; pr < 2; ++pr) {
                        float va[4], vb[4];
#pragma unroll
                        for (int e2 = 0; e2 < 4; ++e2) { va[e2] = yacc[it][8 * pr + e2]; vb[e2] = yacc[it][8 * pr + 4 + e2]; }
                        if (dir) {
                            const auto s0 = __builtin_amdgcn_permlane32_swap(yold[it][pr].x, yold[it][pr].z, false, false), s1 = __builtin_amdgcn_permlane32_swap(yold[it][pr].y, yold[it][pr].w, false, false);
                            va[0] += bflo(s0[0]); va[1] += bfhi(s0[0]); va[2] += bflo(s1[0]); va[3] += bfhi(s1[0]);
                            vb[0] += bflo(s0[1]); vb[1] += bfhi(s0[1]); vb[2] += bflo(s1[1]); vb[3] += bfhi(s1[1]);
                        } else {
                            const u32x2 xa = *(LAS u32x2*)(XRh + (32 * it + r32) * 144 + (32 * pt + 16 * pr + 4 * h) * 2), xb = *(LAS u32x2*)(XRh + (32 * it + r32) * 144 + (32 * pt + 16 * pr + 8 + 4 * h) * 2);
                            va[0] += dskip * bflo(xa.x); va[1] += dskip * bfhi(xa.x); va[2] += dskip * bflo(xa.y); va[3] += dskip * bfhi(xa.y);
                            vb[0] += dskip * bflo(xb.x); vb[1] += dskip * bfhi(xb.x); vb[2] += dskip * bflo(xb.y); vb[3] += dskip * bfhi(xb.y);
                        }
                        const unsigned a0 = cvtpk(va[0], va[1]), a1 = cvtpk(va[2], va[3]), b0 = cvtpk(vb[0], vb[1]), b1 = cvtpk(vb[2], vb[3]);
                        const auto t0 = __builtin_amdgcn_permlane32_swap(a0, b0, false, false), t1 = __builtin_amdgcn_permlane32_swap(a1, b1, false, false);
                        *(v4u*)((unsigned char*)Y + yoff[it] + 32 * pr) = (v4u){t0[0], t1[0], t0[1], t1[1]}; }
#if BG_SSD == 3
                const BgConv::Tok tok = bg.pre();
#endif
                { const float cd = __expf(tot);
#pragma unroll
                  for (int nb = 0; nb < 4; ++nb)
#pragma unroll
                      for (int q = 0; q < 16; ++q) st[nb][q] *= cd; }
#pragma unroll
                for (int s = 0; s < 4; ++s) {
                    LAS unsigned char* xp = XRh + (16 * s + 8 * h + q4) * 144 + (32 * pt + 16 * blk + 4 * p4) * 2;
                    const s16x4 xl = tr16(xp), xh = tr16(xp + 4 * 144);
                    const f32x4 w0 = *(LAS f32x4*)(PW + 192 + 16 * s + 8 * h), w1 = *(LAS f32x4*)(PW + 192 + 16 * s + 8 * h + 4);
                    v4u xd; xd.x = cvtpk(bf2f((unsigned short)xl[0]) * w0[0], bf2f((unsigned short)xl[1]) * w0[1]); xd.y = cvtpk(bf2f((unsigned short)xl[2]) * w0[2], bf2f((unsigned short)xl[3]) * w0[3]);
                    xd.z = cvtpk(bf2f((unsigned short)xh[0]) * w1[0], bf2f((unsigned short)xh[1]) * w1[1]); xd.w = cvtpk(bf2f((unsigned short)xh[2]) * w1[2], bf2f((unsigned short)xh[3]) * w1[3]);
                    bf16x8 bfm[4];
#pragma unroll
                    for (int nb = 0; nb < 4; ++nb) { LAS unsigned char* bp = L + S2_BM + (16 * s + 8 * h + q4) * 272 + (32 * nb + 16 * blk + 4 * p4) * 2; bfm[nb] = cat8(tr16(bp), tr16(bp + 4 * 272)); }
                    SCHED_FENCE();
#pragma unroll
                    for (int nb = 0; nb < 4; ++nb) st[nb] = mfma32(bfm[nb], __builtin_bit_cast(bf16x8, xd), st[nb]);
                    SCHED_FENCE();
                }
#if BG_SSD
                bg.post(tok);
#endif
            }
#undef S2_LOAD
            asm volatile("s_waitcnt vmcnt(0)" ::: "memory");
        }
    }
    bg.drain();
    __syncthreads();
}

#ifndef HG_SKEW
#define HG_SKEW 1
#endif
constexpr int H2_QT = 0, H2_KT = 17408, H2_VM = 34816, H2_AM = 52224, H2_EG = 61440, H2_TEAM = 61952;
DI void hgrn_scan2_phase(const Frame& F, const _Float16* LG, const bf16* V, const bf16* Q, bf16* O, BgConv& bg) {
    const int lane0 = lane_id(), wid = F.wave, team = wid >> 2, wq = wid & 3;
    LAS unsigned char* L = F.lds + team * H2_TEAM;
    const _Float16* LGd = LG + (size_t)team * TT * D;
    for (int un = blockIdx.x; un < NB * 16; un += F.G) {
        const int b = un >> 4, hd = un & 15;
        f32x16 st[4];
#pragma unroll
        for (int dt = 0; dt < 4; ++dt)
#pragma unroll
            for (int i = 0; i < 16; ++i) st[dt][i] = 0.f;
        v4u plg[4], pq[4], pv[4];
#define H2_LOAD(stp, ln) do { const size_t rb_ = scan_rowbase(team, (stp), b); const int col_ = hd * 128 + 8 * (4 * wq + ((ln) & 3)); \
            _Pragma("unroll") for (int r_ = 0; r_ < 4; ++r_) { const int i_ = 4 * ((ln) >> 2) + r_, ti_ = team ? 63 - i_ : i_; const size_t o_ = (rb_ + ti_) * D + col_; \
                plg[r_] = *(const v4u*)(LGd + o_); pq[r_] = *(const v4u*)(Q + o_); pv[r_] = *(const v4u*)(V + o_); } } while (0)
        H2_LOAD(0, lane0);
        if (HG_SKEW && team) WGBAR();
        for (int step = 0; step < 36; ++step) {
            int lane = lane0; asm volatile("" : "+v"(lane));
            const int r32 = lane & 31, h = lane >> 5, q4 = (lane & 15) >> 2, p4 = lane & 3, blk = (lane >> 4) & 1;
            const size_t rowbase = scan_rowbase(team, step, b);
            WGBAR();
            const BgConv::Tok tok = bg.pre();
            {
                const int part = lane >> 2, dcol = 8 * (4 * wq + (lane & 3));
                float P[4][8], kk[4][8];
#pragma unroll
                for (int r = 0; r < 4; ++r)
#pragma unroll
                    for (int e = 0; e < 4; ++e) { const unsigned w = plg[r][e]; kk[r][2 * e] = (float)__builtin_bit_cast(_Float16, (unsigned short)(w & 0xffffu)); kk[r][2 * e + 1] = (float)__builtin_bit_cast(_Float16, (unsigned short)(w >> 16)); }
                float tot[8];
#pragma unroll
                for (int e = 0; e < 8; ++e) { float run = 1.f;
#pragma unroll
                    for (int r = 0; r < 4; ++r) { run *= 1.f - kk[r][e]; P[r][e] = run; }
                    tot[e] = run; }
#pragma unroll
                for (int e = 0; e < 8; ++e) { float inc = tot[e];
#pragma unroll
                    for (int off = 4; off < 64; off <<= 1) { const float t = __shfl_up(inc, off); if (lane >= off) inc *= t; }
                    float pre = __shfl_up(inc, 4); if (lane < 4) pre = 1.f;
                    tot[e] = __shfl(inc, 60 + (lane & 3));
#pragma unroll
                    for (int r = 0; r < 4; ++r) P[r][e] *= pre; }
                if (part == 0) {
#pragma unroll
                    for (int e = 0; e < 8; e += 4) *(LAS f32x4*)(L + H2_EG + (dcol + e) * 4) = (f32x4){tot[e], tot[e + 1], tot[e + 2], tot[e + 3]}; }
#pragma unroll
                for (int r = 0; r < 4; ++r) { const int i = 4 * part + r; v4u qo, ko;
#pragma unroll
                    for (int e = 0; e < 4; ++e) { const unsigned qw = pq[r][e];
                        const float p0 = P[r][2 * e], p1 = P[r][2 * e + 1];
                        qo[e] = cvtpk(bflo(qw) * p0, bfhi(qw) * p1); ko[e] = cvtpk(kk[r][2 * e] * __builtin_amdgcn_rcpf(p0), kk[r][2 * e + 1] * __builtin_amdgcn_rcpf(p1)); }
                    *(LAS v4u*)(L + H2_QT + i * 272 + dcol * 2) = qo; *(LAS v4u*)(L + H2_KT + i * 272 + dcol * 2) = ko; *(LAS v4u*)(L + H2_VM + i * 272 + dcol * 2) = pv[r]; }
            }
            if (step + 1 < 36) H2_LOAD(step + 1, lane);
            WGBAR();
            if (wq < 3) {
                const int jt = wq >> 1, it = wq == 0 ? 0 : 1, i = 32 * it + r32;
                f32x16 g;
#pragma unroll
                for (int q = 0; q < 16; ++q) g[q] = 0.f;
#pragma unroll
                for (int ks = 0; ks < 8; ++ks) g = mfma32(lds_frag(L + H2_KT + (32 * jt + r32) * 272 + 32 * ks + 16 * h), lds_frag(L + H2_QT + i * 272 + 32 * ks + 16 * h), g);
#pragma unroll
                for (int q = 0; q < 16; ++q) { const int j = 32 * jt + crow(q, h); if (j > i) g[q] = 0.f; }
#pragma unroll
                for (int g4 = 0; g4 < 4; ++g4) { u32x2 w; w.x = cvtpk(g[4 * g4], g[4 * g4 + 1]); w.y = cvtpk(g[4 * g4 + 2], g[4 * g4 + 3]);
                    *(LAS u32x2*)(L + H2_AM + i * 144 + (32 * jt + 8 * g4 + 4 * h) * 2) = w; }
            }
            f32x16 oacc[2];
#pragma unroll
            for (int it = 0; it < 2; ++it)
#pragma unroll
                for (int q = 0; q < 16; ++q) oacc[it][q] = 0.f;
#pragma unroll
            for (int dt = 0; dt < 4; ++dt)
#pragma unroll
                for (int s = 0; s < 2; ++s) { const bf16x8 afr = pack8(st[dt], s);
#pragma unroll
                    for (int it = 0; it < 2; ++it) { LAS unsigned char* qp = L + H2_QT + (32 * it + r32) * 272 + (32 * dt + 16 * s + 4 * h) * 2;
                        oacc[it] = mfma32(afr, cat8(*(LAS s16x4*)qp, *(LAS s16x4*)(qp + 16)), oacc[it]); } }
            WGBAR();
            bf16x8 vfr[4];
#pragma unroll
            for (int s = 0; s < 4; ++s) { LAS unsigned char* vp = L + H2_VM + (16 * s + 8 * h + q4) * 272 + (32 * wq + 16 * blk + 4 * p4) * 2; vfr[s] = cat8(tr16(vp), tr16(vp + 4 * 272)); }
#pragma unroll
            for (int it = 0; it < 2; ++it)
#pragma unroll
                for (int s = 0; s < 4; ++s) { if (s >= 2 * (it + 1)) continue;
                    oacc[it] = mfma32(vfr[s], lds_frag(L + H2_AM + (32 * it + r32) * 144 + 32 * s + 16 * h), oacc[it]); }
#pragma unroll
            for (int it = 0; it < 2; ++it) { const int i = 32 * it + r32, ti = team ? 63 - i : i;
                bf16* op = O + (size_t)team * TT * D + (rowbase + ti) * D + hd * 128 + 32 * wq + 8 * h;
#pragma unroll
                for (int pr = 0; pr < 2; ++pr) {
                    const unsigned a0 = cvtpk(oacc[it][8 * pr], oacc[it][8 * pr + 1]), a1 = cvtpk(oacc[it][8 * pr + 2], oacc[it][8 * pr + 3]);
                    const unsigned b0 = cvtpk(oacc[it][8 * pr + 4], oacc[it][8 * pr + 5]), b1 = cvtpk(oacc[it][8 * pr + 6], oacc[it][8 * pr + 7]);
                    const auto t0 = __builtin_amdgcn_permlane32_swap(a0, b0, false, false), t1 = __builtin_amdgcn_permlane32_swap(a1, b1, false, false);
                    *(v4u*)(op + 16 * pr) = (v4u){t0[0], t1[0], t0[1], t1[1]}; } }
#pragma unroll
            for (int s = 0; s < 4; ++s)
#pragma unroll
                for (int dt = 0; dt < 4; ++dt) { LAS unsigned char* kp = L + H2_KT + (16 * s + 8 * h + q4) * 272 + (32 * dt + 16 * blk + 4 * p4) * 2;
                    st[dt] = mfma32(cat8(tr16(kp), tr16(kp + 4 * 272)), vfr[s], st[dt]); }
#pragma unroll
            for (int dt = 0; dt < 4; ++dt)
#pragma unroll
                for (int g4 = 0; g4 < 4; ++g4) { const f32x4 eg = *(LAS f32x4*)(L + H2_EG + (32 * dt + 8 * g4 + 4 * h) * 4);
#pragma unroll
                    for (int e = 0; e < 4; ++e) st[dt][4 * g4 + e] *= eg[e]; }
            bg.post(tok);
        }
        if (HG_SKEW && !team) WGBAR();
#undef H2_LOAD
    }
    bg.drain();
    __syncthreads();
}

#ifndef EN_MODP
#define EN_MODP 1
#endif
#ifndef EN_PRO
#define EN_PRO 1
#endif
#ifndef EN_NORM
#define EN_NORM 1
#endif
#ifndef EN_G1
#define EN_G1 1
#endif
#ifndef EN_ATT
#define EN_ATT 1
#endif
#ifndef EN_CONV
#define EN_CONV 1
#endif
#ifndef EN_HSCAN
#define EN_HSCAN 1
#endif
#ifndef EN_SSCAN
#define EN_SSCAN 1
#endif
#ifndef EN_FIN
#define EN_FIN 1
#endif
#ifndef EN_G2
#define EN_G2 1
#endif
#ifndef EN_G3
#define EN_G3 1
#endif
#ifndef EN_G4
#define EN_G4 1
#endif
#ifndef EN_G1A
#define EN_G1A 1
#endif
#ifndef EN_G1S
#define EN_G1S 1
#endif
#ifndef EN_G1H
#define EN_G1H 1
#endif
#ifndef REP_G1
#define REP_G1 1
#endif
#ifndef REP_G2
#define REP_G2 1
#endif
#ifndef REP_G3
#define REP_G3 1
#endif
#ifndef REP_G4
#define REP_G4 1
#endif
#ifndef REP_ATT
#define REP_ATT 1
#endif
#ifndef REP_SSCAN
#define REP_SSCAN 1
#endif
#ifndef REP_HSCAN
#define REP_HSCAN 1
#endif
#ifndef REP_PRO
#define REP_PRO 1
#endif
#ifndef MK_ONE_LAUNCH
#define MK_ONE_LAUNCH 1
#endif
#ifndef BG_G2
#define BG_G2 1
#endif
#ifndef BG_G3
#define BG_G3 1
#endif
#ifndef BG_G4
#define BG_G4 1
#endif
#ifndef MK_LAYERS
#define MK_LAYERS 4
#endif
constexpr int PH_MODP = 0, PH_PRO = 1, PH_N0 = 2, PH_L0 = 3, PH_PER = 9, PH_END = PH_L0 + PH_PER * DEPTH;
struct Args { const float* in[24]; float* out; unsigned char* ws; int lo, hi; };
static_assert(sizeof(Args) == 26 * 8 + 8, "no padding");

__global__ void __launch_bounds__(NWAVES * 64, 2) trunk_fwd(Args args) {
    extern __shared__ __attribute__((aligned(16))) unsigned char lds_raw[];
    Frame F;
    F.lds = (LAS unsigned char*)lds_raw;
    F.MISC = (volatile LAS unsigned*)(F.lds + MISC_OFF);
    F.wave = __builtin_amdgcn_readfirstlane((int)threadIdx.x >> 6);
    F.G = gridDim.x; F.gw = blockIdx.x * NWAVES + F.wave; F.NGW = F.G * NWAVES;
    unsigned char* ws = args.ws;
    F.ctl = (gu32*)(ws + WS_CTL);
    for (int u = threadIdx.x; u < (LDS_BYTES - LDSCTL_OFF) / 4; u += NWAVES * 64) ((LAS unsigned*)(F.lds + LDSCTL_OFF))[u] = 0u;
    __syncthreads();
    XcdBarrier bar = xcd_barrier_post((unsigned*)(F.ctl + CW_BAR), F.MISC + 8);
    const int lo = args.lo, hi = args.hi;
#define IN(k) (lo <= (k) && (k) < hi)
#define SEAM(k) do { if ((k) + 1 < hi) xcd_barrier(bar); } while (0)
    float* out = args.out;
    bf16* xbl = (bf16*)out;
    bf16* xbc = (bf16*)(ws + WS_H);
    bf16* xbl3 = (bf16*)(ws + WS_U2 + 144 * MiB);
    float* mod = (float*)(ws + WS_MOD);
        bf16* U = (bf16*)(ws + WS_U2);
    const float* rope = (const float*)(ws + WS_TAB);
    const float* lbv = (const float*)(ws + WS_TAB + 16384);

    if (EN_MODP && IN(PH_MODP)) { mod_partial_phase(F, INP(1), INP(3), INP(4), (float*)(ws + WS_MODP)); SEAM(PH_MODP); }
    if (EN_PRO && IN(PH_PRO)) { for (int rep = 0; rep < REP_PRO; ++rep) prologue_phase(F, ws); SEAM(PH_PRO); }
#ifdef IDLE_TICKS
    { const unsigned long long t0 = __builtin_amdgcn_s_memrealtime(); while (__builtin_amdgcn_s_memrealtime() - t0 < IDLE_TICKS) __builtin_amdgcn_s_sleep(32); }
#endif
    if (EN_NORM && IN(PH_N0)) {
        norm_phase<0>(F, TT, nullptr, nullptr, INP(0), INP(2), xbl, xbc, xbl, nullptr, nullptr, 0, nullptr, mod, 0, INP(6), U);
        SEAM(PH_N0);
    }
    for (int l = 0; l < MK_LAYERS; ++l) {
        const int base = PH_L0 + PH_PER * l, kind = l % 3, j = l / 3;
        const float* modl = mod + (size_t)l * 17 * NMODC;
        const int M2 = l < DEPTH - 1 ? TT : TLAT;
        BgConv bg; bg.init((kind == 0 && !BG_ATT) ? DEPTH : l + 1);
        pg8::NoSide noside;
        if (EN_G1 && IN(base + 0)) { for (int rep = 0; rep < REP_G1; ++rep) {
            pg8::StaticOrder S;
            if (kind == 0) { if (EN_G1A) {
                pg8::Gemm g{U, (const bf16*)(ws + WS_WATT + (size_t)j * (W_ATT_IN + W_ATT_OUT)), TT, ATT_IN, D}; S.init(TT, ATT_IN, F.G, (int)blockIdx.x);
                EpiAttn E{(bf16*)(ws + A_KB), (bf16*)(ws + A_QB), (bf16*)(ws + A_VTL), (bf16*)(ws + A_VTC), rope};
                pg8::gemm_phase<EpiAttn, pg8::StaticOrder, true, true>(F.lds, g, S, E, F.wave, noside); }
            } else if (kind == 1) { if (EN_G1S) {
                pg8::Gemm g{U, (const bf16*)(ws + WS_WSSD), TT, SSD_INP, D}; S.init(TT, SSD_INP, F.G, (int)blockIdx.x);
                EpiSsd E{(bf16*)(ws + S_XBC), (bf16*)(ws + S_Z), (float*)(ws + S_DT), INP(15), (bf16*)(ws + WS_MODP)};
                pg8::gemm_phase<EpiSsd, pg8::StaticOrder, true, true>(F.lds, g, S, E, F.wave, noside); }
            } else if (EN_G1H) {
                pg8::Gemm g{U, (const bf16*)(ws + WS_WHG), TT, HG_IN, D}; S.init(TT, HG_IN, F.G, (int)blockIdx.x);
                EpiHgrn E{(_Float16*)(ws + H_LG), (bf16*)(ws + H_V), lbv};
                pg8::gemm_phase<EpiHgrn, pg8::StaticOrder, true, true>(F.lds, g, S, E, F.wave, noside);
            } }
            SEAM(base + 0);
        }
        if (IN(base + 1)) {
            if (kind == 0) { if (EN_ATT) for (int rep = 0; rep < REP_ATT; ++rep) attn_phase(F, (const bf16*)(ws + A_KB), (const bf16*)(ws + A_QB), (const bf16*)(ws + A_VTL), (const bf16*)(ws + A_VTC), INP(11) + j * 32, (bf16*)(ws + A_O), l < DEPTH - 1, bg); }
            else if (kind == 1) { if (EN_CONV) ssd_conv_phase(F, (bf16*)(ws + S_XBC), (const bf16*)(ws + WS_MODP), INP(13), INP(14)); }
            else if (EN_HSCAN) for (int rep = 0; rep < REP_HSCAN; ++rep) hgrn_scan2_phase(F, (const _Float16*)(ws + H_LG), (const bf16*)(ws + H_V), (const bf16*)(ws + H_Q), (bf16*)(ws + WS_U2), bg);
            SEAM(base + 1);
        }
        if (kind != 0 && IN(base + 2)) {
            if (kind == 1) { if (EN_SSCAN) for (int rep = 0; rep < REP_SSCAN; ++rep) ssd_scan2_phase(F, (const bf16*)(ws + S_XBC), (const float*)(ws + S_DT), INP(16), INP(17), (bf16*)(ws + WS_U2), bg); }
            else if (EN_FIN) hgrn_fin_phase(F, (const bf16*)(ws + WS_U2), (const bf16*)(ws + H_OG), INP(22), (bf16*)(ws + H_LG));
            SEAM(base + 2);
        }
        if (kind == 1 && IN(base + 3)) {
            if (EN_FIN) ssd_fin_phase(F, (bf16*)(ws + WS_U2), (const bf16*)(ws + S_Z), INP(18));
            SEAM(base + 3);
        }
        bf16* ymix = (bf16*)(ws + (kind == 0 ? A_Y : (kind == 1 ? S_XBC : H_V)));
        bf16* Un2 = ((NT_N2 & 2) && kind == 1) ? (bf16*)(ws + S_Z) : U;
        if (EN_G2 && IN(base + 4)) {
            const bf16* A2 = (const bf16*)(ws + (kind == 0 ? A_O : (kind == 1 ? WS_U2 : H_LG)));
            const bf16* W2 = (const bf16*)(ws + (kind == 0 ? WS_WATT + (size_t)j * (W_ATT_IN + W_ATT_OUT) + W_ATT_IN : (kind == 1 ? WS_WSSD + W_SSD_IN : WS_WHG + W_HG_IN)));
            pg8::Gemm g{A2, W2, M2, D, kind == 1 ? SSD_DI : D}; pg8::StaticOrder S; S.init(M2, D, F.G, (int)blockIdx.x);
            EpiBf16Y E{ymix};
            if (NT_ON && l < DEPTH - 1 && (((NT_N2 & 1) && kind != 1) || ((NT_N2 & 2) && kind == 1))) {
                CountOrder SC; SC.init(M2, D, F.G, (int)blockIdx.x); SC.cnt = (unsigned*)F.ctl + CW_PCNT + (l * 2 + 0) * 4096; SC.xcc = (int)bar.x;
                EpiBf16YWT EW{ymix}; NormTail<0> nt{l, (NT_TAIL && SC.idle_last()) ? 1 : 0, (int)blockIdx.x - SC.nwg % SC.G, &SC};
                pg8::gemm_phase<EpiBf16YWT, CountOrder, true, true, NormTail<0>>(F.lds, g, SC, EW, F.wave, nt);
            } else
            for (int rep = 0; rep < REP_G2; ++rep) { if (BG_G2) pg8::gemm_phase<EpiBf16Y, pg8::StaticOrder, true, true>(F.lds, g, S, E, F.wave, noside); else pg8::gemm_phase<EpiBf16Y, pg8::StaticOrder, true, true>(F.lds, g, S, E, F.wave, noside); }
            SEAM(base + 4);
        }
        if (EN_NORM && IN(base + 5)) {
            if (NT_ON && l < DEPTH - 1 && (((NT_N2 & 1) && kind != 1) || ((NT_N2 & 2) && kind == 1))) norm_rest_phase(F, l, 0, ymix, xbl, xbc, modl, 2, INP(6) + (l * 4 + 1) * D, modl, 3, INP(6) + (l * 4 + 2) * D, Un2);
            else norm_phase<1>(F, M2, ymix, nullptr, nullptr, nullptr, xbl, xbc, l == DEPTH - 1 ? xbl3 : xbl, nullptr, modl, 2, INP(6) + (l * 4 + 1) * D, modl, 3, INP(6) + (l * 4 + 2) * D, Un2);
            SEAM(base + 5);
        }
        const unsigned char* wffn = ws + WS_WFFN + (size_t)l * (W_FFN_IN + W_FFN_OUT);
        if (EN_G3 && IN(base + 6)) {
            pg8::Gemm g{Un2, (const bf16*)wffn, M2, 2 * FFN, D}; pg8::StaticOrder S; S.init(M2, 2 * FFN, F.G, (int)blockIdx.x);
            EpiSwiglu E{(bf16*)(ws + F_H)};
            for (int rep = 0; rep < REP_G3; ++rep) { if (BG_G3) pg8::gemm_phase<EpiSwiglu, pg8::StaticOrder, true, true>(F.lds, g, S, E, F.wave, noside); else pg8::gemm_phase<EpiSwiglu, pg8::StaticOrder, true, true>(F.lds, g, S, E, F.wave, noside); }
            SEAM(base + 6);
        }
        if (EN_G4 && IN(base + 7)) {
            pg8::Gemm g{(const bf16*)(ws + F_H), (const bf16*)(wffn + W_FFN_IN), M2, D, FFN}; pg8::StaticOrder S; S.init(M2, D, F.G, (int)blockIdx.x);
            EpiBf16Y E{(bf16*)(ws + F_Y)};
            if (NT_ON && l < DEPTH - 1) {
                CountOrder SC; SC.init(M2, D, F.G, (int)blockIdx.x); SC.cnt = (unsigned*)F.ctl + CW_PCNT + (l * 2 + 1) * 4096; SC.xcc = (int)bar.x;
                EpiBf16YWT EW{(bf16*)(ws + F_Y)}; NormTail<1> nt{l, (NT_TAIL && SC.idle_last()) ? 1 : 0, (int)blockIdx.x - SC.nwg % SC.G, &SC};
                pg8::gemm_phase<EpiBf16YWT, CountOrder, true, true, NormTail<1>>(F.lds, g, SC, EW, F.wave, nt);
            } else
            for (int rep = 0; rep < REP_G4; ++rep) { if (BG_G4) pg8::gemm_phase<EpiBf16Y, pg8::StaticOrder, true, true>(F.lds, g, S, E, F.wave, noside); else pg8::gemm_phase<EpiBf16Y, pg8::StaticOrder, true, true>(F.lds, g, S, E, F.wave, noside); }
            SEAM(base + 7);
        }
        if (EN_NORM && IN(base + 8)) {
            if (l < DEPTH - 1) { if (NT_ON) norm_rest_phase(F, l, 1, (const bf16*)(ws + F_Y), xbl, xbc, modl, 5, INP(6) + (l * 4 + 3) * D, modl + 17 * NMODC, 0, INP(6) + ((l + 1) * 4 + 0) * D, U);
                else norm_phase<1>(F, M2, (const bf16*)(ws + F_Y), nullptr, nullptr, nullptr, xbl, xbc, xbl, nullptr, modl, 5, INP(6) + (l * 4 + 3) * D, modl + 17 * NMODC, 0, INP(6) + ((l + 1) * 4 + 0) * D, U); }
            else norm_phase<2>(F, M2, (const bf16*)(ws + F_Y), nullptr, nullptr, nullptr, xbl3, xbc, xbl3, out, modl, 5, INP(6) + (l * 4 + 3) * D, nullptr, 0, nullptr, nullptr);
            SEAM(base + 8);
        }
    }
#undef IN
#undef SEAM
}

extern "C" void kernel_launch(void* const* d_in, const int* in_sizes, int n_in, void* d_out, int out_size, void* d_ws, size_t ws_size, hipStream_t stream) {
    static int grid = 0;
    if (grid == 0) {
        if (n_in != 24 || in_sizes[0] != TLAT * D || out_size != TLAT * D || ws_size < WS_END) {
            fprintf(stderr, "kernel_launch: unexpected shapes: n_in %d in0 %d out %d ws %zu (need %zu)\n", n_in, n_in > 0 ? in_sizes[0] : -1, out_size, ws_size, (size_t)WS_END); grid = -1; return; }
        int dev = 0, cus = 0, per_cu = 0;
        if (hipGetDevice(&dev) != hipSuccess || hipDeviceGetAttribute(&cus, hipDeviceAttributeMultiprocessorCount, dev) != hipSuccess) { grid = -1; return; }
        if (hipFuncSetAttribute((const void*)trunk_fwd, hipFuncAttributeMaxDynamicSharedMemorySize, LDS_BYTES) != hipSuccess) { fprintf(stderr, "kernel_launch: hipFuncSetAttribute failed\n"); grid = -1; return; }
        if (hipOccupancyMaxActiveBlocksPerMultiprocessor(&per_cu, (const void*)trunk_fwd, NWAVES * 64, LDS_BYTES) != hipSuccess || per_cu < 1)
            fprintf(stderr, "kernel_launch: occupancy query reports %d\n", per_cu);
        (void)hipGetLastError();
        grid = cus;
    }
    if (grid < 0) return;
    if (hipMemsetAsync((char*)d_ws + WS_CTL, 0, CTL_ZERO_BYTES, stream) != hipSuccess) return;
    Args a{};
    for (int i = 0; i < 24; ++i) a.in[i] = (const float*)d_in[i];
    a.out = (float*)d_out; a.ws = (unsigned char*)d_ws;
#if MK_ONE_LAUNCH
    a.lo = 0; a.hi = PH_L0 + PH_PER * MK_LAYERS;
    hipLaunchKernelGGL(trunk_fwd, dim3(grid), dim3(NWAVES * 64), LDS_BYTES, stream, a);
#else
    for (int id = 0; id < PH_L0 + PH_PER * MK_LAYERS; ++id) {
        if (id >= PH_L0) { const int loc = (id - PH_L0) % PH_PER, kind = ((id - PH_L0) / PH_PER) % 3; if ((loc == 2 && kind == 0) || (loc == 3 && kind != 1)) continue; }
        a.lo = id; a.hi = id + 1;
        hipLaunchKernelGGL(trunk_fwd, dim3(grid), dim3(NWAVES * 64), LDS_BYTES, stream, a);
    }
#endif
}
```

```cpp
#include <hip/hip_runtime.h>
#include <cstdio>
#include <cstdint>
#include <cmath>
namespace pg8 {
#define PG8_LAS __attribute__((address_space(3)))
typedef unsigned short bf16_t;
typedef short bf16x8 __attribute__((ext_vector_type(8)));
typedef float f32x4 __attribute__((ext_vector_type(4)));
typedef unsigned u32x4 __attribute__((ext_vector_type(4)));
constexpr int BM = 256, BK = 64, HALF = 128, HTB = HALF * BK * 2  , STAGE_BYTES = 8 * HTB, NXCD = 8, WGM = 4;

__host__ __device__ __forceinline__ int lds_byte(int r, int c) { const int st = (r >> 4) * 2 + (c >> 5), rr = r & 15, cc = c & 31, ob = rr * 64 + cc * 2; return st * 1024 + (ob ^ (((ob >> 9) & 1) << 5)); }
__host__ __device__ __forceinline__ void stage_rc(int b, int& R, int& C) { const int st = b / 1024, sb = b % 1024, swz = sb ^ (((sb >> 9) & 1) << 5); R = (st >> 1) * 16 + swz / 64; C = (st & 1) * 32 + (swz % 64) / 2; }
__host__ __device__ __forceinline__ int perm32(int rho) { const int n = rho >> 4, i = rho & 15; return 8 * (i >> 2) + 4 * n + (i & 3); }

struct Unit { int pm, pn; int koff = 0; int nt = 0; };
struct Gemm { const bf16_t* A; const bf16_t* Bt; int M, N, K; int ldk = 0; };

struct StaticOrder {
    int nM, nN, nwg, G, c; int rev = 0;
    __host__ __device__ void init(int M, int N, int G_, int c_) { nM = M / BM; nN = N / BM; nwg = nM * nN; G = G_; c = c_; }
    __host__ __device__ bool next(int i, Unit& u) const {
        const long L = (long)i * G + c; if (L >= nwg) return false;
        int wgid = (int)L; { const int q = nwg / NXCD, r = nwg % NXCD, xcd = wgid % NXCD, cnt = q + (xcd < r ? 1 : 0); int off = wgid / NXCD; if (rev) off = cnt - 1 - off; wgid = (xcd < r ? xcd * (q + 1) : r * (q + 1) + (xcd - r) * q) + off; }
        const int nig = WGM * nN, gid = wgid / nig, fm = gid * WGM, gsz = (nM - fm) < WGM ? (nM - fm) : WGM;
        u.pm = fm + ((wgid % nig) % gsz); u.pn = (wgid % nig) / gsz; return true;
    }
    __host__ __device__ bool idle_last() const { const int r = nwg % G; return r != 0 && c >= r; }
    __device__ __forceinline__ void a_ready(const Unit&) const {}
    __device__ __forceinline__ void done(const Unit&) const {}
};

__device__ __forceinline__ unsigned cvt_pk_bf16(float lo, float hi) { unsigned r; asm volatile("v_cvt_pk_bf16_f32 %0, %1, %2" : "=v"(r) : "v"(lo), "v"(hi)); return r; }
typedef float f32x2 __attribute__((ext_vector_type(2)));
struct NoSide { struct Tok {}; __device__ __forceinline__ Tok pre() { return Tok{}; } __device__ __forceinline__ void post(const Tok&) {} __device__ __forceinline__ void tail() {} };
template <class Epi, class Sched, bool ALIGN_EPI = false, bool SP2 = false, class Side = NoSide>
__device__ __forceinline__ void gemm_phase(PG8_LAS unsigned char* lds, const Gemm g, const Sched& S, const Epi& E, const int wave_id, Side& side) {
    int lane_; asm volatile("v_mbcnt_lo_u32_b32 %0, -1, 0\n\tv_mbcnt_hi_u32_b32 %0, -1, %0" : "=v"(lane_));
    const int tid_ = wave_id * 64 + lane_;
    const int tid = tid_, wid = __builtin_amdgcn_readfirstlane(tid >> 6), lane = tid & 63, wr = wid >> 2, wc = wid & 3, fr = lane & 15, fq = lane >> 4;
    const int K = g.ldk ? g.ldk : g.K, nt = g.K / BK;
    unsigned voffA[2], voffB[2];
#pragma unroll
    for (int i = 0; i < 2; ++i) { int R, C; stage_rc(tid * 16 + i * 8192, R, C); const int Rb = Epi::PERM ? ((R & ~31) + perm32(R & 31)) : R;
        voffA[i] = (unsigned)(R * K + C) * 2u; voffB[i] = (unsigned)(Rb * K + C) * 2u; }
    const size_t kstep = (size_t)(BK * 2);
    const size_t hstep = (size_t)HALF * K * 2;
    const size_t tstep = 2 * hstep;
    const unsigned ldsw = (unsigned)wid * 1024u;
    const int aoff = lds_byte(wr * 64 + fr, fq * 8), boff = lds_byte(wc * 32 + fr, fq * 8);
#define PG8_SA(b, h) (((b) * 2 + (h)) * HTB)
#define PG8_SB(b, h) ((4 + (b) * 2 + (h)) * HTB)
#define PG8_STAGE(bufoff, gbase, voff) do { _Pragma("unroll") for (int _i = 0; _i < 2; ++_i) \
        __builtin_amdgcn_global_load_lds((const unsigned*)((const char*)(gbase) + (voff)[_i]), (PG8_LAS unsigned*)(lds + (bufoff) + ldsw + _i * 8192), 16, 0, 0); } while (0)
#define PG8_LDA(dst, b, h) do { _Pragma("unroll") for (int m = 0; m < 4; ++m) _Pragma("unroll") for (int k = 0; k < 2; ++k) dst[m][k] = *(const PG8_LAS bf16x8*)(lds + PG8_SA(b, h) + aoff + m * 2048 + k * 1024); } while (0)
#define PG8_LDB(dst, b, h) do { _Pragma("unroll") for (int n = 0; n < 2; ++n) _Pragma("unroll") for (int k = 0; k < 2; ++k) dst[n][k] = *(const PG8_LAS bf16x8*)(lds + PG8_SB(b, h) + boff + n * 2048 + k * 1024); } while (0)
#define PG8_MMA(ai, bj, At, Bt) do { __builtin_amdgcn_s_setprio(1); _Pragma("unroll") for (int m = 0; m < 4; ++m) _Pragma("unroll") for (int n = 0; n < 2; ++n) _Pragma("unroll") for (int k = 0; k < 2; ++k) \
        acc[ai][bj][m][n] = __builtin_amdgcn_mfma_f32_16x16x32_bf16(Bt[n][k], At[m][k], acc[ai][bj][m][n], 0, 0, 0); __builtin_amdgcn_s_setprio(0); } while (0)
#define PG8_WAIT_V(n) asm volatile("s_waitcnt vmcnt(" #n ")" ::: "memory")
#define PG8_WAIT_L(n) asm volatile("s_waitcnt lgkmcnt(" #n ")" ::: "memory")
#define PG8_BAR __builtin_amdgcn_s_barrier()
#define PG8_SCHED __builtin_amdgcn_sched_barrier(0)
    Unit cur, nxt; int ui = 0;
    if (!S.next(0, cur)) return;
    f32x4 acc[2][2][4][2];
#pragma unroll
    for (int a = 0; a < 2; ++a)
#pragma unroll
        for (int b = 0; b < 2; ++b)
#pragma unroll
            for (int m = 0; m < 4; ++m)
#pragma unroll
                for (int n = 0; n < 2; ++n) acc[a][b][m][n] = (f32x4){0.f, 0.f, 0.f, 0.f};
    bf16x8 At[4][2], B0[2][2], B1[2][2];
    const char* cA = (const char*)g.A + (size_t)cur.pm * tstep + (size_t)cur.koff * 2; const char* cB = (const char*)g.Bt + (size_t)cur.pn * tstep + (size_t)cur.koff * 2;
    S.a_ready(cur);
    if constexpr (SP2) {
        PG8_STAGE(PG8_SB(0, 0), cB, voffB); PG8_STAGE(PG8_SB(0, 1), cB + hstep, voffB); PG8_STAGE(PG8_SA(0, 0), cA, voffA); PG8_STAGE(PG8_SA(0, 1), cA + hstep, voffA);
        if (wr == 1) PG8_BAR;
        PG8_WAIT_V(2); PG8_BAR;
        PG8_STAGE(PG8_SB(1, 0), cB + kstep, voffB); PG8_STAGE(PG8_SA(1, 0), cA + kstep, voffA); PG8_STAGE(PG8_SB(1, 1), cB + hstep + kstep, voffB);
        PG8_WAIT_V(6); PG8_BAR;
    } else {
        PG8_STAGE(PG8_SB(0, 0), cB, voffB); PG8_STAGE(PG8_SA(0, 0), cA, voffA); PG8_STAGE(PG8_SB(0, 1), cB + hstep, voffB); PG8_STAGE(PG8_SA(0, 1), cA + hstep, voffA);
        if (wr == 1) PG8_BAR;
        PG8_WAIT_V(4); PG8_BAR;
        PG8_STAGE(PG8_SB(1, 0), cB + kstep, voffB); PG8_STAGE(PG8_SA(1, 0), cA + kstep, voffA); PG8_STAGE(PG8_SB(1, 1), cB + hstep + kstep, voffB);
        PG8_WAIT_V(6); PG8_BAR;
    }
    for (;;) {
        const bool has_next = S.next(ui + 1, nxt);
        const char* nA = has_next ? (const char*)g.A + (size_t)nxt.pm * tstep + (size_t)nxt.koff * 2 : cA; const char* nB = has_next ? (const char*)g.Bt + (size_t)nxt.pn * tstep + (size_t)nxt.koff * 2 : cB;
        for (int t = 0; t < nt; t += 2) {
            const bool last = (t == nt - 2);
            const char* a1 = cA + (size_t)(t + 1) * kstep;
            const char* a2 = last ? nA : cA + (size_t)(t + 2) * kstep; const char* b2 = last ? nB : cB + (size_t)(t + 2) * kstep;
            const char* a3 = a2 + kstep; const char* b3 = b2 + kstep;
            if (last && has_next) S.a_ready(nxt);
            if constexpr (SP2) {
            PG8_LDB(B0, 0, 0); PG8_LDB(B1, 0, 1); PG8_SCHED; PG8_LDA(At, 0, 0); PG8_STAGE(PG8_SA(1, 1), a1 + hstep, voffA);
            PG8_WAIT_V(8); PG8_WAIT_L(0); PG8_BAR; PG8_MMA(0, 0, At, B0); PG8_MMA(0, 1, At, B1); PG8_BAR; PG8_SCHED;
            PG8_LDA(At, 0, 1); PG8_STAGE(PG8_SB(0, 0), b2, voffB); PG8_STAGE(PG8_SB(0, 1), b2 + hstep, voffB); PG8_STAGE(PG8_SA(0, 0), a2, voffA);
            PG8_WAIT_V(8); PG8_WAIT_L(0); PG8_BAR; PG8_MMA(1, 0, At, B0); PG8_MMA(1, 1, At, B1); PG8_BAR; PG8_SCHED;
            PG8_LDB(B0, 1, 0); PG8_LDB(B1, 1, 1); PG8_SCHED; PG8_LDA(At, 1, 0); PG8_STAGE(PG8_SA(0, 1), a2 + hstep, voffA);
            PG8_WAIT_V(8); PG8_WAIT_L(0); PG8_BAR; PG8_MMA(0, 0, At, B0); PG8_MMA(0, 1, At, B1); PG8_BAR; PG8_SCHED;
            PG8_LDA(At, 1, 1); PG8_STAGE(PG8_SB(1, 0), b3, voffB); PG8_STAGE(PG8_SB(1, 1), b3 + hstep, voffB); PG8_STAGE(PG8_SA(1, 0), a3, voffA);
            PG8_WAIT_V(8); PG8_WAIT_L(0); PG8_BAR; PG8_MMA(1, 0, At, B0); PG8_MMA(1, 1, At, B1); PG8_BAR; PG8_SCHED;
            } else {
            PG8_LDB(B0, 0, 0); PG8_SCHED; PG8_LDA(At, 0, 0); PG8_STAGE(PG8_SA(1, 1), a1 + hstep, voffA);
            PG8_WAIT_L(8); PG8_BAR; PG8_WAIT_L(0); PG8_MMA(0, 0, At, B0); PG8_BAR; PG8_SCHED;
            PG8_LDB(B1, 0, 1); PG8_STAGE(PG8_SB(0, 0), b2, voffB);
            PG8_BAR; PG8_WAIT_L(0); PG8_MMA(0, 1, At, B1); PG8_BAR;
            PG8_LDA(At, 0, 1); PG8_STAGE(PG8_SA(0, 0), a2, voffA);
            PG8_BAR; PG8_WAIT_L(0); PG8_MMA(1, 0, At, B0); PG8_BAR; PG8_SCHED;
            PG8_STAGE(PG8_SB(0, 1), b2 + hstep, voffB);
            PG8_WAIT_V(6); PG8_BAR; PG8_MMA(1, 1, At, B1); PG8_BAR;
            PG8_LDB(B0, 1, 0); PG8_SCHED; PG8_LDA(At, 1, 0); PG8_STAGE(PG8_SA(0, 1), a2 + hstep, voffA);
            PG8_WAIT_L(8); PG8_BAR; PG8_WAIT_L(0); PG8_MMA(0, 0, At, B0); PG8_BAR; PG8_SCHED;
            PG8_LDB(B1, 1, 1); PG8_STAGE(PG8_SB(1, 0), b3, voffB);
            PG8_BAR; PG8_WAIT_L(0); PG8_MMA(0, 1, At, B1); PG8_BAR;
            PG8_LDA(At, 1, 1); PG8_STAGE(PG8_SA(1, 0), a3, voffA);
            PG8_BAR; PG8_WAIT_L(0); PG8_MMA(1, 0, At, B0); PG8_BAR; PG8_SCHED;
            PG8_STAGE(PG8_SB(1, 1), b3 + hstep, voffB);
            PG8_WAIT_V(6); PG8_BAR; PG8_MMA(1, 1, At, B1); PG8_BAR;
            }
        }
        if constexpr (ALIGN_EPI) { if (wr == 0) PG8_BAR; }
        const typename Side::Tok tok = side.pre();
        if constexpr (!Epi::AFTER_DRAIN) { E(acc, cur, wr, wc, fr, fq); S.done(cur); }
        side.post(tok);
        if (!has_next) break;
#pragma unroll
        for (int a = 0; a < 2; ++a)
#pragma unroll
            for (int b = 0; b < 2; ++b)
#pragma unroll
                for (int m = 0; m < 4; ++m)
#pragma unroll
                    for (int n = 0; n < 2; ++n) acc[a][b][m][n] = (f32x4){0.f, 0.f, 0.f, 0.f};
        cur = nxt; cA = nA; cB = nB; ++ui;
        if constexpr (ALIGN_EPI) { if (wr == 1) PG8_BAR; }
    }
    PG8_WAIT_V(0);
    if constexpr (!ALIGN_EPI) { if (wr == 0) PG8_BAR; }
    PG8_BAR;
    if constexpr (Epi::AFTER_DRAIN) { E.fused(acc, cur, wr, wc, fr, fq, lds, wid, lane); S.done(cur); }
    side.tail();
#undef PG8_SA
#undef PG8_SB
#undef PG8_STAGE
#undef PG8_LDA
#undef PG8_LDB
#undef PG8_MMA
#undef PG8_WAIT_V
#undef PG8_WAIT_L
#undef PG8_BAR
#undef PG8_SCHED
}
}
#define GAS __attribute__((address_space(1)))
#define LAS __attribute__((address_space(3)))
typedef unsigned short bf16;
typedef unsigned v4u __attribute__((ext_vector_type(4)));
typedef float f32x4 __attribute__((ext_vector_type(4)));
typedef short bf16x8 __attribute__((ext_vector_type(8)));
typedef GAS unsigned gu32;
typedef GAS unsigned long long gu64;
#define RLX_AGENT __ATOMIC_RELAXED, __HIP_MEMORY_SCOPE_AGENT
#define LDS_WAIT() asm volatile("s_waitcnt lgkmcnt(0)" ::: "memory")
#define VM_WAIT() asm volatile("s_waitcnt vmcnt(0)" ::: "memory")
__device__ __forceinline__ unsigned long long rt() { return __builtin_amdgcn_s_memrealtime(); }
__device__ __forceinline__ unsigned f2bf(float f) { unsigned u = __builtin_bit_cast(unsigned, f); return (u + 0x7fffu + ((u >> 16) & 1u)) >> 16; }
__device__ __forceinline__ unsigned pk2(float lo, float hi) { return f2bf(lo) | (f2bf(hi) << 16); }

#define XB_TMO      128
#define XB_XCNT(j)  (256  + 64 * (j))
#define XB_XSUB(j)  (1280 + 64 * (j))
#define XB_XGEN(j)  (2304 + 64 * (j))
#define XB_TOP      3328
#define XB_TOPGEN   3392
#define XCD_BAR_WORDS 3456
#define XB_SPIN_CAP (1u << 18)

__device__ __forceinline__ unsigned xb_ld(unsigned* p)              { return __hip_atomic_load(p, __ATOMIC_RELAXED, __HIP_MEMORY_SCOPE_AGENT); }
__device__ __forceinline__ unsigned xb_add(unsigned* p, unsigned v) { return __hip_atomic_fetch_add(p, v, __ATOMIC_RELAXED, __HIP_MEMORY_SCOPE_AGENT); }
__device__ __forceinline__ unsigned xb_xcc_id() { return (unsigned)__builtin_amdgcn_s_getreg((3 << 11) | 20) & 0xFu; }
#define XB_SPIN(cond, bar) do { unsigned _sp = 0; while (cond) { __builtin_amdgcn_s_sleep(1); \
    if ((++_sp & 255u) == 0u) { if (xb_ld(&(bar)[XB_TMO])) break; if (_sp > XB_SPIN_CAP) { atomicAdd(&(bar)[XB_TMO], 1u); break; } } } } while (0)

struct XcdBarrier {
    unsigned* bar; unsigned x;
    volatile LAS unsigned* st;
};

__device__ __forceinline__ XcdBarrier xcd_barrier_post(unsigned* bar, volatile LAS unsigned* st) {
    XcdBarrier b; b.bar = bar; b.x = xb_xcc_id(); b.st = st;
    if (threadIdx.x == 0) (void)xb_add(&bar[XB_XCNT(b.x)], 1u);
    return b;
}
__device__ __forceinline__ void xcd_barrier_complete(unsigned* bar, unsigned x, unsigned& nloc, unsigned& nx) {
    const unsigned G = gridDim.x * gridDim.y * gridDim.z;
    unsigned sum, cnt, mine, sp = 0u;
    for (;;) {
        sum = 0u; cnt = 0u; mine = 0u;
#pragma unroll
        for (unsigned j = 0; j < 16; ++j) { const unsigned c = xb_ld(&bar[XB_XCNT(j)]); sum += c; cnt += (c > 0u) ? 1u : 0u; mine = (j == x) ? c : mine; }
        if (sum == G) break;
        __builtin_amdgcn_s_sleep(1);
        if ((++sp & 255u) == 0u) { if (xb_ld(&bar[XB_TMO])) break; if (sp > XB_SPIN_CAP) { atomicAdd(&bar[XB_TMO], 1u); break; } }
    }
    nloc = mine > 0u ? mine : 1u; nx = cnt > 0u ? cnt : 1u;
}

__device__ __forceinline__ void xcd_barrier(const XcdBarrier& b) {
    asm volatile("s_waitcnt vmcnt(0)" ::: "memory");
    __syncthreads();
    if (threadIdx.x == 0) {
        unsigned* bar = b.bar;
        __builtin_amdgcn_s_waitcnt(0);
        unsigned nloc = b.st[0], nx = b.st[1];
        if (nloc == 0u) { xcd_barrier_complete(bar, b.x, nloc, nx); b.st[0] = nloc; b.st[1] = nx; }
        const unsigned old = xb_add(&bar[XB_XSUB(b.x)], 1u);
        const unsigned gen = old / nloc;
        if (old + 1u == (gen + 1u) * nloc) {
            __builtin_amdgcn_fence(__ATOMIC_RELEASE, "agent");
            asm volatile("s_waitcnt vmcnt(0)" ::: "memory");
            const unsigned og = xb_add(&bar[XB_TOP], 1u);
            const unsigned tg = og / nx;
            if (og + 1u == (tg + 1u) * nx) xb_add(&bar[XB_TOPGEN], 1u);
            else XB_SPIN(xb_ld(&bar[XB_TOPGEN]) == tg, bar);
            __builtin_amdgcn_fence(__ATOMIC_ACQUIRE, "agent");
            xb_add(&bar[XB_XGEN(b.x)], 1u);
            asm volatile("s_waitcnt vmcnt(0)" ::: "memory");
        } else {
            XB_SPIN(xb_ld(&bar[XB_XGEN(b.x)]) == gen, bar);
            __builtin_amdgcn_fence(__ATOMIC_ACQUIRE, "agent");
            asm volatile("s_waitcnt vmcnt(0)" ::: "memory");
        }
    }
    __syncthreads();
}

#define DI __device__ __forceinline__
constexpr int NWAVES = 8;
constexpr int D = 2048, NB = 16, SEQ = 2048, CTXL = 256, DEPTH = 4;
constexpr int TLAT = NB * SEQ, TCTX = NB * CTXL, TT = TLAT + TCTX;
constexpr int FFN = 5632, NMODC = 6 * D;
constexpr int ATT_IN = 2560;
constexpr int SSD_DI = 4096, SSD_CONV = 6144, SSD_INP = 10496  , SSD_INS = 10368;
constexpr int HG_IN = 10240;
constexpr float RMS_EPS = 1e-6f, LOG2E = 1.4426950408889634f;
constexpr float QSCALE = 0.125f * LOG2E;
typedef float f32x16 __attribute__((ext_vector_type(16)));
typedef float f32x2v __attribute__((ext_vector_type(2)));
typedef unsigned u32x2 __attribute__((ext_vector_type(2)));
typedef short s16x4 __attribute__((ext_vector_type(4)));

constexpr size_t MiB = 1u << 20;
constexpr size_t WS_CTL = 0, CTL_ZERO_BYTES = 1 * MiB;
constexpr size_t WS_MODP = 1 * MiB;
constexpr size_t WS_MOD = 28 * MiB;
constexpr size_t WS_TAB = 32 * MiB;
constexpr size_t WS_H = 33 * MiB;
constexpr size_t WS_W = 65 * MiB;
constexpr size_t W_FFN_IN = (size_t)2 * FFN * D * 2, W_FFN_OUT = (size_t)D * FFN * 2;
constexpr size_t WS_WFFN = WS_W;
constexpr size_t W_ATT_IN = (size_t)ATT_IN * D * 2, W_ATT_OUT = (size_t)D * D * 2;
constexpr size_t WS_WATT = WS_WFFN + 4 * (W_FFN_IN + W_FFN_OUT);
constexpr size_t W_SSD_IN = (size_t)SSD_INP * D * 2, W_SSD_OUT = (size_t)D * SSD_DI * 2;
constexpr size_t WS_WSSD = WS_WATT + 2 * (W_ATT_IN + W_ATT_OUT);
constexpr size_t W_HG_IN = (size_t)HG_IN * D * 2, W_HG_OUT = (size_t)D * D * 2;
constexpr size_t WS_WHG = WS_WSSD + W_SSD_IN + W_SSD_OUT;
constexpr size_t WS_WEND = WS_WHG + W_HG_IN + W_HG_OUT;
constexpr size_t WS_U2 = 470 * MiB;
constexpr size_t WS_BIG = 758 * MiB;
constexpr size_t WS_END = 1496 * MiB;
static_assert(WS_WEND <= WS_U2, "weights fit");
constexpr size_t A_KB = WS_BIG;
constexpr size_t A_QB = A_KB + (size_t)TT * 256 * 2;
constexpr size_t A_VTL = A_QB + (size_t)TT * D * 2;
constexpr size_t A_VTC = A_VTL + (size_t)NB * 4 * 64 * SEQ * 2;
constexpr size_t A_O = A_VTC + (size_t)NB * 4 * 64 * CTXL * 2;
constexpr size_t A_Y = A_O + (size_t)TT * D * 2;
static_assert(A_Y + (size_t)TT * D * 4 <= WS_END, "attn map");
constexpr size_t S_XBC = WS_BIG;
constexpr size_t S_Z = S_XBC + (size_t)TT * SSD_CONV * 2;
constexpr size_t S_DT = S_Z + (size_t)TT * SSD_DI * 2;
static_assert(S_DT + (size_t)TT * 128 * 4 <= WS_END, "ssd map");
constexpr size_t H_LG = WS_BIG;
constexpr size_t H_V = H_LG + (size_t)2 * TT * D * 2;
constexpr size_t H_Q = H_V + (size_t)TT * D * 2;
constexpr size_t H_OG = H_Q + (size_t)TT * D * 2;
static_assert(H_OG + (size_t)TT * D * 2 <= WS_END, "hgrn map");
constexpr size_t F_H = WS_BIG;
constexpr size_t F_Y = F_H + (size_t)TT * FFN * 2;
static_assert(F_Y + (size_t)TT * D * 4 <= WS_END, "ffn map");
constexpr int CW_PCNT = 140032, CW_PDONE = 170000;
constexpr int CW_BAR = 4096;

constexpr int RING_BYTES = 131072;
constexpr int LDSCTL_OFF = RING_BYTES, MISC_OFF = LDSCTL_OFF + 320;
constexpr int LDS_BYTES = 163840;
constexpr int CONV_SCR_OFF = 135168, CONV_SCR_WAVE = 3584;

typedef __bf16 bf16x2_t __attribute__((ext_vector_type(2)));
DI unsigned cvtpk(float lo, float hi) { f32x2v v = {lo, hi}; bf16x2_t b = __builtin_convertvector(v, bf16x2_t); return __builtin_bit_cast(unsigned, b); }
DI int lane_id() { int l; asm volatile("v_mbcnt_lo_u32_b32 %0, -1, 0\n\tv_mbcnt_hi_u32_b32 %0, -1, %0" : "=v"(l)); return l; }
DI float bf2f(unsigned short b) { return __uint_as_float((unsigned)b << 16); }
DI float bflo(unsigned w) { return __uint_as_float(w << 16); }
DI float bfhi(unsigned w) { return __uint_as_float(w & 0xffff0000u); }
DI unsigned short f2bf16(float f) { return (unsigned short)(cvtpk(f, 0.f) & 0xffffu); }
DI unsigned pkh(float lo, float hi) { return (unsigned)__builtin_bit_cast(unsigned short, (_Float16)lo) | ((unsigned)__builtin_bit_cast(unsigned short, (_Float16)hi) << 16); }
DI float silu_f(float x) { return x * __builtin_amdgcn_rcpf(1.f + __builtin_amdgcn_exp2f(-x * LOG2E)); }
DI float wave_sum(float v) {
#pragma unroll
    for (int o = 1; o < 64; o <<= 1) v += __shfl_xor(v, o);
    return v;
}
DI int crow(int r, int h) { return (r & 3) + 8 * (r >> 2) + 4 * h; }
DI f32x16 mfma32(bf16x8 a, bf16x8 b, f32x16 c) { return __builtin_amdgcn_mfma_f32_32x32x16_bf16(a, b, c, 0, 0, 0); }
DI bf16x8 lds_frag(LAS unsigned char* p) { return *(LAS bf16x8*)p; }
DI float swap_max(float m) { auto rr = __builtin_amdgcn_permlane32_swap(__float_as_uint(m), __float_as_uint(m), false, false); return fmaxf(__uint_as_float(rr[0]), __uint_as_float(rr[1])); }
DI float swap_sum(float m) { auto rr = __builtin_amdgcn_permlane32_swap(__float_as_uint(m), __float_as_uint(m), false, false); return __uint_as_float(rr[0]) + __uint_as_float(rr[1]); }
DI bf16x8 pack8(const f32x16& x, int s) {
    v4u p; p.x = cvtpk(x[8 * s], x[8 * s + 1]); p.y = cvtpk(x[8 * s + 2], x[8 * s + 3]);
    p.z = cvtpk(x[8 * s + 4], x[8 * s + 5]); p.w = cvtpk(x[8 * s + 6], x[8 * s + 7]);
    return __builtin_bit_cast(bf16x8, p);
}

typedef short v4i16_t __attribute__((ext_vector_type(4)));
DI s16x4 tr16(LAS unsigned char* p) { return __builtin_bit_cast(s16x4, __builtin_amdgcn_ds_read_tr16_b64_v4i16((LAS v4i16_t*)p)); }
DI bf16x8 cat8(s16x4 lo, s16x4 hi) { return (bf16x8){lo[0], lo[1], lo[2], lo[3], hi[0], hi[1], hi[2], hi[3]}; }

using pg8::Unit; using pg8::HALF; using pg8::BM;
struct EpiF32 {
    static constexpr bool PERM = false, AFTER_DRAIN = false;
    float* C; int ldc;
    DI void operator()(const f32x4 (&acc)[2][2][4][2], const Unit& u, int wr, int wc, int fr, int fq) const {
        const int row0 = u.pm * BM + wr * 64 + fr, col0 = u.pn * BM + wc * 32 + 4 * fq;
#pragma unroll
        for (int ai = 0; ai < 2; ++ai)
#pragma unroll
            for (int m = 0; m < 4; ++m) { float* rowp = C + (size_t)(row0 + ai * HALF + m * 16) * ldc + col0;
#pragma unroll
                for (int bj = 0; bj < 2; ++bj)
#pragma unroll
                    for (int n = 0; n < 2; ++n) *(f32x4*)(rowp + bj * HALF + n * 16) = acc[ai][bj][m][n]; }
    }
};
struct EpiBf16Y {
    static constexpr bool PERM = true, AFTER_DRAIN = false;
    bf16* C;
    DI void operator()(const f32x4 (&acc)[2][2][4][2], const Unit& u, int wr, int wc, int fr, int fq) const {
        const int row0 = u.pm * BM + wr * 64 + fr, col0 = u.pn * BM + wc * 32 + 8 * fq;
#pragma unroll
        for (int ai = 0; ai < 2; ++ai)
#pragma unroll
            for (int m = 0; m < 4; ++m) { bf16* rowp = C + (size_t)(row0 + ai * HALF + m * 16) * D + col0;
#pragma unroll
                for (int bj = 0; bj < 2; ++bj) { const f32x4 v0 = acc[ai][bj][m][0], v1 = acc[ai][bj][m][1]; v4u w;
                    w.x = cvtpk(v0[0], v0[1]); w.y = cvtpk(v0[2], v0[3]); w.z = cvtpk(v1[0], v1[1]); w.w = cvtpk(v1[2], v1[3]);
                    *(v4u*)(rowp + bj * HALF) = w; }
                asm volatile("" ::: "memory"); }
    }
};
#ifndef NT_DEFER
#define NT_DEFER 0
#endif
#ifndef NT_WT
#define NT_WT 0
#endif
struct EpiBf16YWT {
    static constexpr bool PERM = true, AFTER_DRAIN = false;
    bf16* C;
    DI void operator()(const f32x4 (&acc)[2][2][4][2], const Unit& u, int wr, int wc, int fr, int fq) const {
        const int row0 = u.pm * BM + wr * 64 + fr, col0 = u.pn * BM + wc * 32 + 8 * fq;
#pragma unroll
        for (int ai = 0; ai < 2; ++ai)
#pragma unroll
            for (int m = 0; m < 4; ++m) { bf16* rowp = C + (size_t)(row0 + ai * HALF + m * 16) * D + col0;
#pragma unroll
                for (int bj = 0; bj < 2; ++bj) { const f32x4 v0 = acc[ai][bj][m][0], v1 = acc[ai][bj][m][1];
                    const unsigned long long lo = (unsigned long long)cvtpk(v0[0], v0[1]) | ((unsigned long long)cvtpk(v0[2], v0[3]) << 32), hi = (unsigned long long)cvtpk(v1[0], v1[1]) | ((unsigned long long)cvtpk(v1[2], v1[3]) << 32);
                    unsigned long long* q = (unsigned long long*)(rowp + bj * HALF);
                    if (NT_WT) { __hip_atomic_store(q, lo, __ATOMIC_RELAXED, __HIP_MEMORY_SCOPE_AGENT); __hip_atomic_store(q + 1, hi, __ATOMIC_RELAXED, __HIP_MEMORY_SCOPE_AGENT); }
                    else *(v4u*)q = (v4u){(unsigned)lo, (unsigned)(lo >> 32), (unsigned)hi, (unsigned)(hi >> 32)}; }
                asm volatile("" ::: "memory"); }
    }
};
struct CountOrder : pg8::StaticOrder {
    unsigned* cnt; mutable int prev = -1;
    DI bool next(int i, Unit& u) const {
        if (!pg8::StaticOrder::next(i, u)) return false;
        const int fm = u.pm & ~3, idx = (u.pm & 3) + 4 * u.pn;
        u.pm = fm + 2 * (idx >> 4) + (idx & 1); u.pn = (idx & 15) >> 1; return true;
    }
    int xcc;
    DI void publish(int pm) const { if (pm >= 0 && (threadIdx.x & 63) == 0) __hip_atomic_fetch_add(cnt + pm * 16 + xcc, 1u, __ATOMIC_RELAXED, __HIP_MEMORY_SCOPE_AGENT); }
    DI void done(const Unit& u) const { if (NT_DEFER) { publish(prev); prev = u.pm; } else { asm volatile("s_waitcnt vmcnt(0)" ::: "memory"); publish(u.pm); } }
    DI void flush() const { asm volatile("s_waitcnt vmcnt(0)" ::: "memory"); publish(prev); prev = -1; }
};
struct SplitTailOrder {
    int G, c, khalf, call;
    DI void init(int K, int G_, int c_, int call_) { G = G_; c = c_; khalf = K / 2; call = call_; }
    DI bool next(int i, Unit& u) const {
        constexpr int nN = D / BM, nwg = (TLAT / BM) * nN;
        const int L = i * G + c;
        if (call == 0) { if (L >= nwg) return false; const int q = nwg / 8, xcd = L % 8, off = L / 8, wgid = xcd * q + off, nig = 8 * nN;
            u.pm = (wgid / nig) * 8 + (wgid % nig) % 8; u.pn = (wgid % nig) / 8; u.koff = 0; return true; }
        if (L >= 256) return false;
        const int t = L >> 1; u.pm = TLAT / BM + (t >> 3); u.pn = t & 7; u.koff = (L & 1) * khalf; return true;
    }
    DI void a_ready(const Unit&) const {}
    DI void done(const Unit&) const {}
};
struct EpiYSplit {
    static constexpr bool PERM = true, AFTER_DRAIN = false;
    bf16* C; float* P; int split;
    DI void operator()(const f32x4 (&acc)[2][2][4][2], const Unit& u, int wr, int wc, int fr, int fq) const {
        const int row0 = u.pm * BM + wr * 64 + fr, col0 = u.pn * BM + wc * 32 + 8 * fq;
        if (!split) {
#pragma unroll
            for (int ai = 0; ai < 2; ++ai)
#pragma unroll
                for (int m = 0; m < 4; ++m) { bf16* rowp = C + (size_t)(row0 + ai * HALF + m * 16) * D + col0;
#pragma unroll
                    for (int bj = 0; bj < 2; ++bj) { const f32x4 v0 = acc[ai][bj][m][0], v1 = acc[ai][bj][m][1]; v4u w;
                        w.x = cvtpk(v0[0], v0[1]); w.y = cvtpk(v0[2], v0[3]); w.z = cvtpk(v1[0], v1[1]); w.w = cvtpk(v1[2], v1[3]);
                        *(v4u*)(rowp + bj * HALF) = w; }
                    asm volatile("" ::: "memory"); }
        } else {
            float* Pb = P + (u.koff ? (size_t)TCTX * D : 0);
#pragma unroll
            for (int ai = 0; ai < 2; ++ai)
#pragma unroll
                for (int m = 0; m < 4; ++m) { float* rowp = Pb + (size_t)(row0 - TLAT + ai * HALF + m * 16) * D + col0;
#pragma unroll
                    for (int bj = 0; bj < 2; ++bj) { *(f32x4*)(rowp + bj * HALF) = acc[ai][bj][m][0]; *(f32x4*)(rowp + bj * HALF + 4) = acc[ai][bj][m][1]; }
                    asm volatile("" ::: "memory"); }
        }
    }
};
struct EpiSwiglu {
    static constexpr bool PERM = true, AFTER_DRAIN = false;
    bf16* H;
    DI void operator()(const f32x4 (&acc)[2][2][4][2], const Unit& u, int wr, int wc, int fr, int fq) const {
        const int row0 = u.pm * BM + wr * 64 + fr, col0 = u.pn * 128 + wc * 32 + 8 * fq;
#pragma unroll
        for (int ai = 0; ai < 2; ++ai)
#pragma unroll
            for (int m = 0; m < 4; ++m) {
                float o[8];
#pragma unroll
                for (int n = 0; n < 2; ++n)
#pragma unroll
                    for (int j = 0; j < 4; ++j) o[4 * n + j] = silu_f(acc[ai][0][m][n][j]) * acc[ai][1][m][n][j];
                v4u w; w.x = cvtpk(o[0], o[1]); w.y = cvtpk(o[2], o[3]); w.z = cvtpk(o[4], o[5]); w.w = cvtpk(o[6], o[7]);
                *(v4u*)(H + (size_t)(row0 + ai * HALF + m * 16) * FFN + col0) = w; }
    }
};
struct EpiAttn {
    static constexpr bool PERM = false, AFTER_DRAIN = false;
    bf16* Kb; bf16* Qb; bf16* VtL; bf16* VtC; const float* rope;
    DI void operator()(const f32x4 (&acc)[2][2][4][2], const Unit& u, int wr, int wc, int fr, int fq) const {
        const int pn = u.pn;
#pragma unroll
        for (int ai = 0; ai < 2; ++ai)
#pragma unroll
            for (int m = 0; m < 4; ++m) {
                const int row = u.pm * BM + ai * HALF + wr * 64 + m * 16 + fr;
                const bool lat = u.pm < TLAT / BM; const int s = row & 2047;
                if (pn == 1) {
                    bf16* base; size_t pitch;
                    if (lat) { base = VtL + (size_t)(row >> 11) * (4 * 64 * SEQ) + s; pitch = SEQ; }
                    else { const int rc = row - TLAT; base = VtC + (size_t)(rc >> 8) * (4 * 64 * CTXL) + (rc & 255); pitch = CTXL; }
#pragma unroll
                    for (int bj = 0; bj < 2; ++bj)
#pragma unroll
                        for (int n = 0; n < 2; ++n)
#pragma unroll
                            for (int j = 0; j < 4; ++j) { const int col = 128 * bj + 32 * wc + 16 * n + 4 * fq + j; base[(size_t)col * pitch] = f2bf16(acc[ai][bj][m][n][j]); }
                } else {
                    const int pos = (wc & 1) ? (s & 63) : (s >> 6);
                    const f32x4* rp = (const f32x4*)(rope + (pos * 16 + 4 * fq) * 2);
                    const f32x4 c01 = rp[0], c23 = rp[1];
                    const float cs[4] = {c01[0], c01[2], c23[0], c23[2]}, sn[4] = {c01[1], c01[3], c23[1], c23[3]};
#pragma unroll
                    for (int bj = 0; bj < 2; ++bj) {
                        const f32x4 t1 = acc[ai][bj][m][0], t2 = acc[ai][bj][m][1]; float o1[4], o2[4];
#pragma unroll
                        for (int j = 0; j < 4; ++j) { o1[j] = lat ? t1[j] * cs[j] - t2[j] * sn[j] : t1[j]; o2[j] = lat ? t2[j] * cs[j] + t1[j] * sn[j] : t2[j]; }
                        bf16* dst; float sc;
                        if (pn == 0) { dst = Kb + (size_t)row * 256 + 128 * bj + 32 * wc + 4 * fq; sc = 1.f; }
                        else { dst = Qb + (size_t)row * D + (pn - 2) * 256 + 128 * bj + 32 * wc + 4 * fq; sc = QSCALE; }
                        u32x2 w1, w2; w1.x = cvtpk(o1[0] * sc, o1[1] * sc); w1.y = cvtpk(o1[2] * sc, o1[3] * sc);
                        w2.x = cvtpk(o2[0] * sc, o2[1] * sc); w2.y = cvtpk(o2[2] * sc, o2[3] * sc);
                        *(u32x2*)dst = w1; *(u32x2*)(dst + 16) = w2;
                    }
                }
                asm volatile("" ::: "memory");
            }
    }
};
struct EpiSsd {
    static constexpr bool PERM = true, AFTER_DRAIN = false;
    bf16* XBC; bf16* Z; float* DT; const float* dt_bias; bf16* HB;
    DI void operator()(const f32x4 (&acc)[2][2][4][2], const Unit& u, int wr, int wc, int fr, int fq) const {
        const int pn = u.pn, row0 = u.pm * BM + wr * 64 + fr, cl = wc * 32 + 8 * fq;
        if (pn < 40) {
            bf16* base; int ldc;
            if (pn < 24) { base = XBC + pn * 256; ldc = SSD_CONV; } else { base = Z + (pn - 24) * 256; ldc = SSD_DI; }
#pragma unroll
            for (int ai = 0; ai < 2; ++ai)
#pragma unroll
                for (int m = 0; m < 4; ++m) { bf16* rowp = base + (size_t)(row0 + ai * HALF + m * 16) * ldc + cl;
#pragma unroll
                    for (int bj = 0; bj < 2; ++bj) { const f32x4 v0 = acc[ai][bj][m][0], v1 = acc[ai][bj][m][1]; v4u w;
                        w.x = cvtpk(v0[0], v0[1]); w.y = cvtpk(v0[2], v0[3]); w.z = cvtpk(v1[0], v1[1]); w.w = cvtpk(v1[2], v1[3]);
                        *(v4u*)(rowp + bj * HALF) = w;
                        const int rr = (row0 + ai * HALF + m * 16) & 255;
                        if (pn < 24 && (rr == 0 || rr == 255)) *(v4u*)(HB + (size_t)(2 * u.pm + (rr & 1)) * SSD_CONV + pn * 256 + cl + bj * HALF) = w; }
                    asm volatile("" ::: "memory"); }
        } else {
            const f32x4 b0 = *(const f32x4*)(dt_bias + cl), b1 = *(const f32x4*)(dt_bias + cl + 4);
#pragma unroll
            for (int ai = 0; ai < 2; ++ai)
#pragma unroll
                for (int m = 0; m < 4; ++m) { float* rowp = DT + (size_t)(row0 + ai * HALF + m * 16) * 128 + cl;
#pragma unroll
                    for (int n = 0; n < 2; ++n) { f32x4 v = acc[ai][0][m][n] + (n ? b1 : b0), o;
#pragma unroll
                        for (int j = 0; j < 4; ++j) { const float x = v[j]; o[j] = fmaxf(x, 0.f) + log1pf(__expf(-fabsf(x))); }
                        *(f32x4*)(rowp + 4 * n) = o; }
                    asm volatile("" ::: "memory"); }
        }
    }
};
struct EpiHgrn {
    static constexpr bool PERM = true, AFTER_DRAIN = false;
    _Float16* LG; bf16* VQG; const float* lbv;
    DI void operator()(const f32x4 (&acc)[2][2][4][2], const Unit& u, int wr, int wc, int fr, int fq) const {
        const int pn = u.pn, row0 = u.pm * BM + wr * 64 + fr, cl = wc * 32 + 8 * fq;
        if (pn < 16) {
            const int dir = pn >> 3, cb = (pn & 7) * 256;
#pragma unroll
            for (int bj = 0; bj < 2; ++bj) {
                const f32x4 l0 = *(const f32x4*)(lbv + dir * D + cb + bj * HALF + cl), l1 = *(const f32x4*)(lbv + dir * D + cb + bj * HALF + cl + 4);
#pragma unroll
                for (int ai = 0; ai < 2; ++ai)
#pragma unroll
                    for (int m = 0; m < 4; ++m) { float o[8];
#pragma unroll
                        for (int n = 0; n < 2; ++n)
#pragma unroll
                            for (int j = 0; j < 4; ++j) { const float f = acc[ai][bj][m][n][j], lb = n ? l1[j] : l0[j];
                                const float e = __builtin_amdgcn_exp2f(-f * LOG2E);
                                o[4 * n + j] = (1.f - lb) * e * __builtin_amdgcn_rcpf(1.f + e); }
                        v4u w; w.x = pkh(o[0], o[1]); w.y = pkh(o[2], o[3]); w.z = pkh(o[4], o[5]); w.w = pkh(o[6], o[7]);
                        *(v4u*)(LG + ((size_t)dir * TT + row0 + ai * HALF + m * 16) * D + cb + bj * HALF + cl) = w;
                        asm volatile("" ::: "memory"); }
            }
        } else {
            const int t = (pn - 16) >> 3, cb = (pn & 7) * 256; bf16* base = VQG + (size_t)t * TT * D + cb;
#pragma unroll
            for (int ai = 0; ai < 2; ++ai)
#pragma unroll
                for (int m = 0; m < 4; ++m) { bf16* rowp = base + (size_t)(row0 + ai * HALF + m * 16) * D + cl;
#pragma unroll
                    for (int bj = 0; bj < 2; ++bj) { f32x4 v0 = acc[ai][bj][m][0], v1 = acc[ai][bj][m][1];
                        if (t == 1) {
#pragma unroll
                            for (int j = 0; j < 4; ++j) { v0[j] = silu_f(v0[j]); v1[j] = silu_f(v1[j]); } }
                        v4u w; w.x = cvtpk(v0[0], v0[1]); w.y = cvtpk(v0[2], v0[3]); w.z = cvtpk(v1[0], v1[1]); w.w = cvtpk(v1[2], v1[3]);
                        *(v4u*)(rowp + bj * HALF) = w; }
                    asm volatile("" ::: "memory"); }
        }
    }
};

struct Frame {
    LAS unsigned char* lds;
    volatile LAS unsigned* MISC;
    gu32* ctl;
    int wave, G, gw, NGW;
};

DI void mod_partial_phase(const Frame& F, const float* c, const float* cctx, const float* ada_w, float* modp) {
    const int lane = lane_id();
    for (int it = F.gw; it < 4 * 48 * 8; it += F.NGW) {
        const int cb = it % 48, ks = (it / 48) & 7, l = it / (8 * 48);
        f32x4 acc[17];
#pragma unroll
        for (int b = 0; b < 17; ++b) acc[b] = (f32x4){0.f, 0.f, 0.f, 0.f};
        const float* W = ada_w + (size_t)l * D * NMODC + cb * 256 + lane * 4;
        for (int kb = 0; kb < 4; ++kb) {
            const int k0 = ks * 256 + kb * 64;
            float sv[17];
#pragma unroll
            for (int b = 0; b < 16; ++b) { const float x = c[b * D + k0 + lane]; sv[b] = x / (1.f + __expf(-x)); }
            { const float x = cctx[k0 + lane]; sv[16] = x / (1.f + __expf(-x)); }
            for (int jj = 0; jj < 64; jj += 8) {
                f32x4 w[8];
#pragma unroll
                for (int q = 0; q < 8; ++q) w[q] = *(const f32x4*)(W + (size_t)(k0 + jj + q) * NMODC);
#pragma unroll
                for (int q = 0; q < 8; ++q)
#pragma unroll
                    for (int b = 0; b < 17; ++b) { const float s = __int_as_float(__builtin_amdgcn_readlane(__float_as_int(sv[b]), jj + q)); acc[b] += w[q] * s; }
            }
        }
#pragma unroll
        for (int b = 0; b < 17; ++b) *(f32x4*)(modp + (((size_t)ks * 4 + l) * 17 + b) * NMODC + cb * 256 + lane * 4) = acc[b];
    }
}

DI int srcmap(int kind, int n) {
    if (kind == 0) return n;
    if (kind == 1) { const int t = n >> 8, w = n & 255; return w < 128 ? 128 * t + w : FFN + 128 * t + (w - 128); }
    if (n < SSD_CONV) return n;
    if (n < SSD_CONV + SSD_DI) return n + 128;
    if (n < SSD_INS) return n - SSD_DI;
    return -1;
}
struct ConvItem { const float* src; bf16* dst; int Nsrc, K; };
DI ConvItem conv_decode(const float* W, int K, int Nsrc, int Ndst, bf16* WT, int kind, int item) {
    const int nblk = Ndst / 32, kb = item / nblk, nb = item % nblk, k0 = 64 * kb, n0 = 32 * nb, s0 = srcmap(kind, n0);
    return ConvItem{s0 >= 0 ? W + (size_t)k0 * Nsrc + s0 : nullptr, WT + (size_t)n0 * K + k0, Nsrc, K};
}
DI void conv_load(const ConvItem& c, f32x4 (&v)[8], int lane) {
    const float* src = c.src + (size_t)(lane >> 3) * c.Nsrc + 4 * (lane & 7);
#pragma unroll
    for (int i = 0; i < 8; ++i) v[i] = c.src ? *(const f32x4*)(src + (size_t)(8 * i) * c.Nsrc) : (f32x4){0.f, 0.f, 0.f, 0.f};
}
DI void conv_finish(const ConvItem& c, const f32x4 (&v)[8], LAS unsigned char* scr, int lane) {
    const int r32 = lane & 31, h = lane >> 5, q4 = (lane & 15) >> 2, p4 = lane & 3, blk = (lane >> 4) & 1;
    bf16* dst = c.dst + (size_t)r32 * c.K + 8 * h;
#pragma unroll
    for (int half = 0; half < 2; ++half) {
#pragma unroll
        for (int i = 0; i < 4; ++i) *(LAS u32x2*)(scr + (8 * i + (lane >> 3)) * 80 + 8 * (lane & 7)) = (u32x2){cvtpk(v[4 * half + i][0], v[4 * half + i][1]), cvtpk(v[4 * half + i][2], v[4 * half + i][3])};
        LDS_WAIT(); asm volatile("" ::: "memory");
#pragma unroll
        for (int cc = 0; cc < 2; ++cc) { LAS unsigned char* p = scr + (16 * cc + 8 * h + q4) * 80 + (16 * blk + 4 * p4) * 2;
            const bf16x8 o = cat8(tr16(p), tr16(p + 4 * 80)); *(GAS bf16x8*)(dst + 16 * (2 * half + cc)) = o; }
        LDS_WAIT(); asm volatile("" ::: "memory");
    }
}
DI ConvItem conv16_decode(const float* W, int K, int Nsrc, int Ndst, bf16* WT, int kind, int item) {
    const int nblk = Ndst / 16, kb = item / nblk, nb = item % nblk, k0 = 64 * kb, n0 = 16 * nb, s0 = srcmap(kind, n0);
    return ConvItem{s0 >= 0 ? W + (size_t)k0 * Nsrc + s0 : nullptr, WT + (size_t)n0 * K + k0, Nsrc, K};
}
DI void conv16_load(const ConvItem& c, f32x4 (&v)[4], int lane) {
    const float* src = c.src + (size_t)(lane >> 2) * c.Nsrc + 4 * (lane & 3);
#pragma unroll
    for (int i = 0; i < 4; ++i) v[i] = c.src ? *(const f32x4*)(src + (size_t)(16 * i) * c.Nsrc) : (f32x4){0.f, 0.f, 0.f, 0.f};
}
DI void conv16_finish(bf16* dst0, int K, const f32x4 (&v)[4], LAS unsigned char* scr, int lane) {
#pragma unroll
    for (int i = 0; i < 4; ++i) *(LAS u32x2*)(scr + (16 * i + (lane >> 2)) * 40 + 8 * (lane & 3)) = (u32x2){cvtpk(v[i][0], v[i][1]), cvtpk(v[i][2], v[i][3])};
    LDS_WAIT(); asm volatile("" ::: "memory");
    const int n = lane & 15, kq = lane >> 4, q4 = (lane & 15) >> 2, p4 = lane & 3;
    bf16* dst = dst0 + (size_t)n * K + 8 * kq;
#pragma unroll
    for (int cc = 0; cc < 2; ++cc) { LAS unsigned char* p = scr + (32 * cc + 8 * kq + q4) * 40 + 8 * p4;
        const bf16x8 o = cat8(tr16(p), tr16(p + 4 * 40)); *(GAS bf16x8*)(dst + 32 * cc) = o; }
    LDS_WAIT(); asm volatile("" ::: "memory");
}
template <int OFF> DI const float* inp_load() { const GAS float* p; asm volatile("s_load_dwordx2 %0, %1, %2\n\ts_waitcnt lgkmcnt(0)" : "=s"(p) : "s"(__builtin_amdgcn_kernarg_segment_ptr()), "n"(OFF)); return (const float*)p; }
#define INP(k) inp_load<(k) * 8>()

constexpr int I_FI = (D / 64) * (2 * FFN / 32), I_FO = (FFN / 64) * (D / 32), I_AI = (D / 64) * (ATT_IN / 32), I_AO = (D / 64) * (D / 32);
constexpr int I_SI = (D / 64) * (SSD_INP / 32), I_SO = (SSD_DI / 64) * (D / 32), I_HI = (D / 64) * (HG_IN / 32), I_HO = I_AO;
template <bool N16> DI int conv_group_items(int l) { if (N16) return 2 * conv_group_items<false>(l); const int k = l % 3; return I_FI + I_FO + (k == 0 ? I_AI + I_AO : (k == 1 ? I_SI + I_SO : I_HI + I_HO)); }
template <bool N16> DI ConvItem conv_group_decode(unsigned char* ws, int l, int r) {
    constexpr int S = N16 ? 2 : 1;
#define CDEC(...) (N16 ? conv16_decode(__VA_ARGS__) : conv_decode(__VA_ARGS__))
    bf16* wf = (bf16*)(ws + WS_WFFN + (size_t)l * (W_FFN_IN + W_FFN_OUT));
    if (r < S * I_FI) return CDEC(INP(7) + (size_t)l * D * 2 * FFN, D, 2 * FFN, 2 * FFN, wf, 1, r);
    r -= S * I_FI;
    if (r < S * I_FO) return CDEC(INP(8) + (size_t)l * FFN * D, FFN, D, D, (bf16*)((unsigned char*)wf + W_FFN_IN), 0, r);
    r -= S * I_FO;
    const int k = l % 3, j = l / 3;
    if (k == 0) { bf16* wb = (bf16*)(ws + WS_WATT + (size_t)j * (W_ATT_IN + W_ATT_OUT));
        if (r < S * I_AI) return CDEC(INP(9) + (size_t)j * D * ATT_IN, D, ATT_IN, ATT_IN, wb, 0, r);
        return CDEC(INP(10) + (size_t)j * D * D, D, D, D, (bf16*)((unsigned char*)wb + W_ATT_IN), 0, r - S * I_AI); }
    if (k == 1) {
        if (r < S * I_SI) return CDEC(INP(12), D, SSD_INS, SSD_INP, (bf16*)(ws + WS_WSSD), 2, r);
        return CDEC(INP(19), SSD_DI, D, D, (bf16*)(ws + WS_WSSD + W_SSD_IN), 0, r - S * I_SI); }
    if (r < S * I_HI) return CDEC(INP(20), D, HG_IN, HG_IN, (bf16*)(ws + WS_WHG), 0, r);
    return CDEC(INP(23), D, D, D, (bf16*)(ws + WS_WHG + W_HG_IN), 0, r - S * I_HI);
#undef CDEC
}
#ifndef BG_CONV
#define BG_CONV 1
#endif
#ifndef BG_SSD
#define BG_SSD 4
#endif
#ifndef BG_HG
#define BG_HG 1
#endif
#ifndef BG_ATT
#define BG_ATT 1
#endif
struct BgConv {
    int l, it;
    DI static unsigned char* wsp() { return (unsigned char*)inp_load<200>(); }
    DI static int wave() { return __builtin_amdgcn_readfirstlane((int)threadIdx.x >> 6); }
    DI static LAS unsigned char* scrp() { extern __shared__ __attribute__((aligned(16))) unsigned char lds_raw[]; return (LAS unsigned char*)lds_raw + CONV_SCR_OFF + wave() * CONV_SCR_WAVE; }
    DI int end() const { return (BG_CONV && l < DEPTH) ? conv_group_items<true>(l) : 0; }
    DI void init(int layer) { l = layer; it = (int)blockIdx.x * NWAVES + wave(); }
    DI void tail() {}
    struct Tok { f32x4 v[4]; };
    DI Tok pre() { Tok t; if (it < end()) { const ConvItem c = conv_group_decode<true>(wsp(), l, it); conv16_load(c, t.v, lane_id()); } return t; }
    DI void post(const Tok& t) { if (it < end()) { const ConvItem c = conv_group_decode<true>(wsp(), l, it); conv16_finish(c.dst, c.K, t.v, scrp(), lane_id()); it += (int)gridDim.x * NWAVES; } }
    DI void drain() {
        unsigned char* ws = wsp(); LAS unsigned char* scr = scrp(); const int step = (int)gridDim.x * NWAVES, e = end();
        while (it < e) {
            const int lane = lane_id();
            const ConvItem c0 = conv_group_decode<true>(ws, l, it); f32x4 v0[4]; conv16_load(c0, v0, lane);
            const int it1 = it + step;
            if (it1 < e) { const ConvItem c1 = conv_group_decode<true>(ws, l, it1); f32x4 v1[4]; conv16_load(c1, v1, lane);
                conv16_finish(c0.dst, c0.K, v0, scr, lane); conv16_finish(c1.dst, c1.K, v1, scr, lane); }
            else conv16_finish(c0.dst, c0.K, v0, scr, lane);
            it += 2 * step;
        }
    }
};
DI void prologue_phase(const Frame& F, unsigned char* ws) {
    LAS unsigned char* scr = F.lds + CONV_SCR_OFF + F.wave * CONV_SCR_WAVE;
    const int lane = lane_id(); const int gt = F.gw * 64 + lane, NGT = F.NGW * 64;
    { const float* modp = (const float*)(ws + WS_MODP); float* mod = (float*)(ws + WS_MOD); const float* ada_b = INP(5);
      for (int i = gt; i < 4 * 17 * NMODC / 4; i += NGT) {
          const int e = i * 4, l = e / (17 * NMODC), n = e % NMODC;
          f32x4 s = *(const f32x4*)(ada_b + l * NMODC + n);
#pragma unroll
          for (int ks = 0; ks < 8; ++ks) s += *(const f32x4*)(modp + (size_t)ks * 4 * 17 * NMODC + e);
          *(f32x4*)(mod + e) = s; } }
    { float* tab = (float*)(ws + WS_TAB);
      if (gt < 1024) { const int pos = gt >> 4, p = gt & 15; const float invf = powf(10000.f, -(float)p / 16.f); const float ang = (float)pos * invf; tab[2 * gt] = cosf(ang); tab[2 * gt + 1] = sinf(ang); }
      float* lbv = (float*)(ws + WS_TAB + 16384); const float* lbr = INP(21);
      if (gt < 2 * D) { const int dir = gt >> 11, d = gt & 2047; float v[4], mx = -1e30f;
#pragma unroll
          for (int l = 0; l < 4; ++l) { v[l] = lbr[(dir * 4 + l) * D + d]; mx = fmaxf(mx, v[l]); }
          float e[4], sum = 0.f;
#pragma unroll
          for (int l = 0; l < 4; ++l) { e[l] = expf(v[l] - mx); sum += e[l]; }
          lbv[gt] = (e[1] + e[2]) / sum; } }
    for (int l = 0; l < (BG_CONV ? (BG_ATT ? 1 : 2) : DEPTH); ++l) {
        const int NIT = conv_group_items<false>(l);
        if (F.gw < NIT) {
            ConvItem cur = conv_group_decode<false>(ws, l, F.gw); f32x4 v[8]; conv_load(cur, v, lane);
            for (int it = F.gw; it < NIT; it += F.NGW) {
                const int nit = it + F.NGW; ConvItem nxt = cur; f32x4 vn[8];
                if (nit < NIT) { nxt = conv_group_decode<false>(ws, l, nit); conv_load(nxt, vn, lane); }
                conv_finish(cur, v, scr, lane);
                cur = nxt;
#pragma unroll
                for (int i = 0; i < 8; ++i) v[i] = vn[i];
            }
        }
    }
}

template <int MODE, bool YSC1 = false, bool NTS = false>
DI void norm_range(int wbeg, int wend, int nrows, const bf16* y, const float* ysplit, const float* xin_lat, const float* xin_ctx, bf16* xb_lat, bf16* xb_ctx, bf16* xd_lat, float* out_f32,
                   const float* mod_a, int gate_idx, const float* gpost, const float* mod_b, int shift_idx, const float* gpre, bf16* u) {
    constexpr bool HAS_Y = MODE != 0, HAS_U = MODE != 2;
    const int lane = lane_id();
    unsigned vo2 = (unsigned)lane * 16u, vo4 = (unsigned)lane * 32u;
#define NP_B16(p, m) (*(const v4u*)((const unsigned char*)(p) + vo2 + 1024 * (m)))
#define NP_Y16(p, m) (YSC1 ? ({ const unsigned long long* q_ = (const unsigned long long*)((const unsigned char*)(p) + vo2 + 1024 * (m)); const unsigned long long a_ = __hip_atomic_load(q_, __ATOMIC_RELAXED, __HIP_MEMORY_SCOPE_AGENT), b_ = __hip_atomic_load(q_ + 1, __ATOMIC_RELAXED, __HIP_MEMORY_SCOPE_AGENT); (v4u){(unsigned)a_, (unsigned)(a_ >> 32), (unsigned)b_, (unsigned)(b_ >> 32)}; }) : NP_B16(p, m))
#define NP_B(p, k) (*(const u32x2*)((const unsigned char*)(p) + vo2 + 1024 * ((k) >> 1) + 8 * ((k) & 1)))
#define NP_F(p, k) (*(const f32x4*)((const unsigned char*)(p) + vo4 + 2048 * ((k) >> 1) + 16 * ((k) & 1)))
    for (int r0 = wbeg; r0 < wend;) {
        const int mb = r0 < TLAT ? (r0 >> 11) : 16; const bool lat = r0 < TLAT;
        const int bend = lat ? ((r0 >> 11) + 1) << 11 : nrows, rend = wend < bend ? wend : bend, nr = rend - r0;
        asm volatile("" : "+v"(vo2), "+v"(vo4));
        f32x4 GG[8], AA[8], SH[8];
        { const float* ga = HAS_Y ? mod_a + (size_t)mb * NMODC + gate_idx * D : nullptr; const float* sc = HAS_U ? mod_b + (size_t)mb * NMODC + (shift_idx + 1) * D : nullptr;
          const float* sh = HAS_U ? mod_b + (size_t)mb * NMODC + shift_idx * D : nullptr;
#pragma unroll
          for (int k = 0; k < 8; ++k) {
              if (HAS_Y) GG[k] = NP_F(ga, k) * NP_F(gpost, k);
              if (HAS_U) { AA[k] = NP_F(gpre, k) * (NP_F(sc, k) + 1.f); SH[k] = NP_F(sh, k); } } }
        const size_t rl = lat ? (size_t)r0 : (size_t)(r0 - TLAT);
        bf16* xb = (lat ? xb_lat : xb_ctx) + rl * D;
        bf16* xw = (lat ? xd_lat : xb_ctx) + rl * D;
        const float* xin = MODE == 0 ? (lat ? xin_lat : xin_ctx) + rl * D : nullptr;
        const bf16* yp = HAS_Y ? y + (size_t)r0 * D : nullptr;
        f32x4 xf[8]; u32x2 xr[8], yr[8];
        const float* ysp = (HAS_Y && ysplit && !lat) ? ysplit + rl * D : nullptr;
#define NP_Y(rowoff, k) (ysp ? ({ const f32x4 s_ = NP_F(ysp + (size_t)(rowoff) * D, k) + NP_F(ysp + (size_t)TCTX * D + (size_t)(rowoff) * D, k); (u32x2){cvtpk(s_[0], s_[1]), cvtpk(s_[2], s_[3])}; }) : NP_B(yp + (size_t)(rowoff) * D, k))
#pragma unroll
        for (int k = 0; k < 8; ++k) { if (MODE == 0) xf[k] = NP_F(xin, k); if (HAS_Y && ysp) yr[k] = NP_Y(0, k); }
#pragma unroll
        for (int m = 0; m < 4; ++m) { if (MODE != 0) { const v4u t = NTS ? __builtin_nontemporal_load((const v4u*)((const unsigned char*)(xb) + vo2 + 1024 * (m))) : NP_B16(xb, m); xr[2 * m] = (u32x2){t.x, t.y}; xr[2 * m + 1] = (u32x2){t.z, t.w}; }
            if (HAS_Y && !ysp) { const v4u t = NP_Y16(yp, m); yr[2 * m] = (u32x2){t.x, t.y}; yr[2 * m + 1] = (u32x2){t.z, t.w}; } }
        for (int rr = 0; rr < nr; ++rr) {
            asm volatile("" : "+v"(vo2), "+v"(vo4));
            f32x4 x[8]; u32x2 yc[8];
#pragma unroll
            for (int k = 0; k < 8; ++k) { x[k] = MODE == 0 ? xf[k] : (f32x4){bflo(xr[k].x), bfhi(xr[k].x), bflo(xr[k].y), bfhi(xr[k].y)};
                if (HAS_Y) yc[k] = yr[k]; }
            if (rr + 1 < nr) {
#pragma unroll
                for (int k = 0; k < 8; ++k) { if (MODE == 0) xf[k] = NP_F(xin + (size_t)(rr + 1) * D, k); if (HAS_Y && ysp) yr[k] = NP_Y(rr + 1, k); }
#pragma unroll
                for (int m = 0; m < 4; ++m) { if (MODE != 0) { const v4u t = NTS ? __builtin_nontemporal_load((const v4u*)((const unsigned char*)(xb + (size_t)(rr + 1) * D) + vo2 + 1024 * (m))) : NP_B16(xb + (size_t)(rr + 1) * D, m); xr[2 * m] = (u32x2){t.x, t.y}; xr[2 * m + 1] = (u32x2){t.z, t.w}; }
                    if (HAS_Y && !ysp) { const v4u t = NP_Y16(yp + (size_t)(rr + 1) * D, m); yr[2 * m] = (u32x2){t.x, t.y}; yr[2 * m + 1] = (u32x2){t.z, t.w}; } } }
            if (HAS_Y) {
                float ss = 0.f;
#pragma unroll
                for (int k = 0; k < 8; ++k) { const float a0 = bflo(yc[k].x), a1 = bfhi(yc[k].x), a2 = bflo(yc[k].y), a3 = bfhi(yc[k].y); ss += (a0 * a0 + a1 * a1) + (a2 * a2 + a3 * a3); }
                const float rs = 1.f / sqrtf(wave_sum(ss) * (1.f / D) + RMS_EPS);
#pragma unroll
                for (int k = 0; k < 8; ++k) x[k] += GG[k] * (f32x4){bflo(yc[k].x), bfhi(yc[k].x), bflo(yc[k].y), bfhi(yc[k].y)} * rs;
            }
            if (MODE == 2) { float* od = out_f32 + (size_t)(r0 + rr) * D;
#pragma unroll
                for (int k = 0; k < 8; ++k) *(f32x4*)((unsigned char*)od + vo4 + 2048 * (k >> 1) + 16 * (k & 1)) = x[k];
            } else {
#pragma unroll
                for (int m = 0; m < 4; ++m) { const f32x4 xa = x[2 * m], xc = x[2 * m + 1]; const v4u xv_ = (v4u){cvtpk(xa[0], xa[1]), cvtpk(xa[2], xa[3]), cvtpk(xc[0], xc[1]), cvtpk(xc[2], xc[3])}; v4u* xq_ = (v4u*)((unsigned char*)(xw + (size_t)rr * D) + vo2 + 1024 * m); if (NTS) __builtin_nontemporal_store(xv_, xq_); else *xq_ = xv_; }
            }
            if (HAS_U) {
                float ss = 0.f;
#pragma unroll
                for (int k = 0; k < 8; ++k) ss += (x[k][0] * x[k][0] + x[k][1] * x[k][1]) + (x[k][2] * x[k][2] + x[k][3] * x[k][3]);
                const float rs = 1.f / sqrtf(wave_sum(ss) * (1.f / D) + RMS_EPS);
                bf16* up = u + (size_t)(r0 + rr) * D;
#pragma unroll
                for (int m = 0; m < 4; ++m) { const f32x4 oa = x[2 * m] * rs * AA[2 * m] + SH[2 * m], oc = x[2 * m + 1] * rs * AA[2 * m + 1] + SH[2 * m + 1];
                    const v4u uv_ = (v4u){cvtpk(oa[0], oa[1]), cvtpk(oa[2], oa[3]), cvtpk(oc[0], oc[1]), cvtpk(oc[2], oc[3])}; v4u* uq_ = (v4u*)((unsigned char*)up + vo2 + 1024 * m); if (NTS) __builtin_nontemporal_store(uv_, uq_); else *uq_ = uv_; }
            }
        }
        r0 = rend;
    }
#undef NP_B
#undef NP_B16
#undef NP_F
#undef NP_Y
#undef NP_Y16
}
template <int MODE>
DI void norm_phase(const Frame& F, int nrows, const bf16* y, const float* ysplit, const float* xin_lat, const float* xin_ctx, bf16* xb_lat, bf16* xb_ctx, bf16* xd_lat, float* out_f32,
                   const float* mod_a, int gate_idx, const float* gpost, const float* mod_b, int shift_idx, const float* gpre, bf16* u) {
    const int per = (nrows + F.NGW - 1) / F.NGW, wbeg = F.gw * per < nrows ? F.gw * per : nrows, wend = wbeg + per < nrows ? wbeg + per : nrows;
    norm_range<MODE>(wbeg, wend, nrows, y, ysplit, xin_lat, xin_ctx, xb_lat, xb_ctx, xd_lat, out_f32, mod_a, gate_idx, gpost, mod_b, shift_idx, gpre, u);
}

#ifndef NT_ON
#define NT_ON 1
#endif
#ifndef NT_TAIL
#define NT_TAIL 1
#endif
#ifndef NT_STREAM
#define NT_STREAM 1
#endif
#ifndef NT_N2_WHOLE
#define NT_N2_WHOLE 1
#endif
#ifndef NT_N2
#define NT_N2 3
#endif
static_assert(D / 256 == 8 && pg8::WGM == 4 && ((TT / 256) * (D / 256)) % (16 * pg8::NXCD) == 0, "CountOrder's 16-tile runs");
constexpr int NT_NWG = (TT / 256) * (D / 256), NT_Q = NT_NWG / pg8::NXCD, NT_LAST = (NT_NWG % 256) / pg8::NXCD, NT_SPIN = 800;
DI bool panel_late(int pm) {
    const int g = pm / pg8::WGM; bool late = false;
#pragma unroll
    for (int x = 0; x < pg8::NXCD; ++x) { const int lo = (x * NT_Q + NT_Q - NT_LAST) / (pg8::WGM * (D / 256)), hi = (x * NT_Q + NT_Q - 1) / (pg8::WGM * (D / 256)); late |= (NT_LAST > 0) && g >= lo && g <= hi; }
    return late;
}
template <int WHICH>
struct NormTail {
    int l, idle, k;
    const CountOrder* sc;
    struct Tok {}; DI Tok pre() { return Tok{}; } DI void post(const Tok&) {}
    DI void tail() {
        if (NT_DEFER) sc->flush();
        if (!idle) return;
        const int xa = (int)blockIdx.x % pg8::NXCD, j = k / pg8::NXCD;
        const int pm = 2 * (xa * NT_Q / 16) + j;
        if (j >= 2 * ((NT_Q - NT_LAST) / 16) || pm >= TT / 256) return;
        unsigned char* ws = BgConv::wsp(); unsigned* ctl = (unsigned*)(ws + WS_CTL);
        extern __shared__ __attribute__((aligned(16))) unsigned char lds_raw[];
        volatile LAS unsigned* flag = (volatile LAS unsigned*)((LAS unsigned char*)lds_raw + MISC_OFF) + 16;
        if (threadIdx.x == 0) { unsigned ok = 0u; unsigned* slot = ctl + CW_PCNT + (l * 2 + WHICH) * 4096 + pm * 16;
            for (int sp = 0; sp < NT_SPIN; ++sp) {
                if (__hip_atomic_load(slot + sc->xcc, __ATOMIC_RELAXED, __HIP_MEMORY_SCOPE_AGENT) >= 64u) { ok = 1u; break; }
                if ((sp & 15) == 15) { unsigned tot = 0u; for (int q = 0; q < 16; ++q) tot += __hip_atomic_load(slot + q, __ATOMIC_RELAXED, __HIP_MEMORY_SCOPE_AGENT); if (tot >= 64u && __hip_atomic_load(slot + sc->xcc, __ATOMIC_RELAXED, __HIP_MEMORY_SCOPE_AGENT) < 64u) break; }
                __builtin_amdgcn_s_sleep(8); }
            __builtin_amdgcn_fence(__ATOMIC_ACQUIRE, "agent"); asm volatile("s_waitcnt vmcnt(0)" ::: "memory");
            *flag = ok; }
        __syncthreads();
        const unsigned ok = *flag;
        if (!ok) return;
        const int w = __builtin_amdgcn_readfirstlane((int)threadIdx.x >> 6), kind = l % 3;
        const float* mod = (const float*)(ws + WS_MOD); const float* modl = mod + (size_t)l * 17 * NMODC;
        bf16* xbl = (bf16*)inp_load<192>();
        for (int hf = 0; hf < ((WHICH || kind == 1 || NT_N2_WHOLE) ? 2 : 1); ++hf) {
            const int r0 = pm * 256 + 128 * hf + 16 * w;
            if (WHICH) norm_range<1, NT_WT != 0, NT_STREAM != 0>(r0, r0 + 16, TT, (const bf16*)(ws + F_Y), nullptr, nullptr, nullptr, xbl, (bf16*)(ws + WS_H), xbl, nullptr,
                                                 modl, 5, INP(6) + (l * 4 + 3) * D, modl + 17 * NMODC, 0, INP(6) + ((l + 1) * 4 + 0) * D, (bf16*)(ws + WS_U2));
            else norm_range<1, NT_WT != 0, NT_STREAM != 0>(r0, r0 + 16, TT, (const bf16*)(ws + (kind == 0 ? A_Y : (kind == 1 ? S_XBC : H_V))), nullptr, nullptr, nullptr, xbl, (bf16*)(ws + WS_H), xbl, nullptr,
                                           modl, 2, INP(6) + (l * 4 + 1) * D, modl, 3, INP(6) + (l * 4 + 2) * D, (bf16*)(ws + (kind == 1 ? S_Z : WS_U2)));
            __syncthreads();
            if (threadIdx.x == 0) ctl[CW_PDONE + (l * 2 + WHICH) * 512 + 2 * pm + hf] = 1u;
        }
    }
};
DI void norm_rest_phase(const Frame& F, int l, int which, const bf16* y, bf16* xb_lat, bf16* xb_ctx, const float* mod_a, int gate_idx, const float* gpost, const float* mod_b, int shift_idx, const float* gpre, bf16* u) {
    const unsigned* done = (const unsigned*)F.ctl + CW_PDONE + (l * 2 + which) * 512;
    LAS unsigned* list = (LAS unsigned*)F.lds;
    const int lane = lane_id();
    constexpr int NHP = 2 * (TT / 256);
    if (F.wave == 0) { int base = 0;
#pragma unroll
        for (int j = 0; j < (NHP + 63) / 64; ++j) { const int p = lane + 64 * j; const bool nd = p < NHP && done[p < NHP ? p : 0] == 0u; const unsigned long long m = __ballot(nd);
            if (nd) list[base + __popcll(m & ((1ull << lane) - 1ull))] = (unsigned)p; base += __popcll(m); }
        if (lane == 0) list[320] = (unsigned)base; }
    __syncthreads();
    const int P = __builtin_amdgcn_readfirstlane((int)list[320]), R = P * 128;
    const int per = (R + F.NGW - 1) / F.NGW; int cr = F.gw * per < R ? F.gw * per : R; const int cend = cr + per < R ? cr + per : R;
    while (cr < cend) {
        const int o = cr & 127, hp = __builtin_amdgcn_readfirstlane((int)list[cr >> 7]), n = (cend - cr) < (128 - o) ? (cend - cr) : (128 - o), r0 = hp * 128 + o;
        norm_range<1>(r0, r0 + n, TT, y, nullptr, nullptr, nullptr, xb_lat, xb_ctx, xb_lat, nullptr, mod_a, gate_idx, gpost, mod_b, shift_idx, gpre, u);
        cr += n;
    }
    __syncthreads();
}

#ifndef AT_THR
#define AT_THR 8.f
#endif
constexpr int AT_KP = 144, AT_VP = 648, AT_LV = 320 * AT_KP;
#define AT_BAR() do { asm volatile("s_waitcnt lgkmcnt(0)" ::: "memory"); __builtin_amdgcn_s_barrier(); asm volatile("" ::: "memory"); } while (0)
DI void attn_phase(const Frame& F, const bf16* Kb, const bf16* Qb, const bf16* VtL, const bf16* VtC, const float* sink, bf16* O, bool need_ctx, BgConv& bg) {
    const int lane0 = lane_id(), wid = F.wave;
    LAS unsigned char* ldsK = F.lds; LAS unsigned char* ldsV = F.lds + AT_LV;
    const int nunits = need_ctx ? 2304 : 2048;
    v4u pk[5], pvv[5];
#define AT_LOAD(un_, pass_, tid_) do { const int u_ = (un_); int b_, q0_, kvh_; \
        if (u_ < 2048) { kvh_ = u_ & 3; q0_ = ((u_ >> 2) & 31) * 64; b_ = u_ >> 7; } else { const int v_ = u_ - 2048; kvh_ = v_ & 3; q0_ = ((v_ >> 2) & 3) * 64; b_ = v_ >> 4; } \
        if ((pass_) == 0) { \
            _Pragma("unroll") for (int i_ = 0; i_ < 5; ++i_) { const int idx_ = (tid_) + 512 * i_, row_ = idx_ >> 3, part_ = idx_ & 7, s_ = q0_ - 128 + row_; \
                pk[i_] = (s_ >= 0 && s_ < SEQ) ? *(const v4u*)(Kb + (size_t)(b_ * SEQ + s_) * 256 + kvh_ * 64 + part_ * 8) : (v4u){0u, 0u, 0u, 0u}; \
                const int d_ = idx_ / 40, pv_ = idx_ % 40, s0_ = q0_ - 128 + pv_ * 8; \
                pvv[i_] = (s0_ >= 0 && s0_ < SEQ) ? *(const v4u*)(VtL + ((size_t)((b_ * 4 + kvh_) * 64 + d_)) * SEQ + s0_) : (v4u){0u, 0u, 0u, 0u}; } \
        } else { \
            _Pragma("unroll") for (int i_ = 0; i_ < 4; ++i_) { const int idx_ = (tid_) + 512 * i_; \
                pk[i_] = *(const v4u*)(Kb + (size_t)(TLAT + b_ * CTXL + (idx_ >> 3)) * 256 + kvh_ * 64 + (idx_ & 7) * 8); \
                pvv[i_] = *(const v4u*)(VtC + ((size_t)((b_ * 4 + kvh_) * 64 + (idx_ >> 5))) * CTXL + (idx_ & 31) * 8); } \
        } } while (0)
    int un = blockIdx.x, pass = un >= 2048 ? 1 : 0;
    if (un < nunits) AT_LOAD(un, pass, wid * 64 + lane0);
    bf16x8 qf[2][4]; float m_[2], l_[2]; f32x16 o[2][2];
    while (un < nunits) {
        int lane = lane0; asm volatile("" : "+v"(lane));
        const int tid = wid * 64 + lane, r32 = lane & 31, h = lane >> 5;
        const bool cq = un >= 2048; int b, qblk, kvh;
        if (!cq) { kvh = un & 3; qblk = (un >> 2) & 31; b = un >> 7; } else { const int v = un - 2048; kvh = v & 3; qblk = (v >> 2) & 3; b = v >> 4; }
        const int q0 = qblk * 64, hq = kvh * 8 + wid;
        const size_t qrow0 = cq ? (size_t)(TLAT + b * CTXL + q0) : (size_t)(b * SEQ + q0);
        if (pass == (cq ? 1 : 0)) {
#pragma unroll
            for (int rb = 0; rb < 2; ++rb)
#pragma unroll
                for (int d0 = 0; d0 < 4; ++d0) qf[rb][d0] = *(const bf16x8*)(Qb + (qrow0 + 32 * rb + r32) * D + hq * 64 + 16 * d0 + 8 * h);
            const float sk = sink[hq] * LOG2E;
#pragma unroll
            for (int rb = 0; rb < 2; ++rb) { m_[rb] = sk; l_[rb] = h == 0 ? 1.f : 0.f;
#pragma unroll
                for (int db = 0; db < 2; ++db)
#pragma unroll
                    for (int i = 0; i < 16; ++i) o[rb][db][i] = 0.f; }
        }
        AT_BAR();
        if (pass == 0) {
#pragma unroll
            for (int i = 0; i < 5; ++i) { const int idx = tid + 512 * i; *(LAS v4u*)(ldsK + (idx >> 3) * AT_KP + (idx & 7) * 16) = pk[i];
                const int d = idx / 40, part = idx % 40; *(LAS u32x2*)(ldsV + d * AT_VP + part * 16) = (u32x2){pvv[i].x, pvv[i].y}; *(LAS u32x2*)(ldsV + d * AT_VP + part * 16 + 8) = (u32x2){pvv[i].z, pvv[i].w}; }
        } else {
#pragma unroll
            for (int i = 0; i < 4; ++i) { const int idx = tid + 512 * i; *(LAS v4u*)(ldsK + (idx >> 3) * AT_KP + (idx & 7) * 16) = pk[i];
                const int d = idx >> 5, part = idx & 31; *(LAS u32x2*)(ldsV + d * AT_VP + part * 16) = (u32x2){pvv[i].x, pvv[i].y}; *(LAS u32x2*)(ldsV + d * AT_VP + part * 16 + 8) = (u32x2){pvv[i].z, pvv[i].w}; }
        }
        int nun = un, npass = pass + 1;
        if (npass > 1) { nun = un + F.G; npass = nun >= 2048 ? 1 : 0; }
        if (nun < nunits) AT_LOAD(nun, npass, tid);
        AT_BAR();
        const int nkt = pass == 0 ? 10 : 8;
#pragma unroll 2
        for (int kt = 0; kt < nkt; ++kt) {
#if BG_ATT
            const BgConv::Tok tok = bg.pre();
#endif
            bf16x8 kf[4], vf[2][2];
#pragma unroll
            for (int d0 = 0; d0 < 4; ++d0) kf[d0] = lds_frag(ldsK + (32 * kt + r32) * AT_KP + 32 * d0 + 16 * h);
#pragma unroll
            for (int db = 0; db < 2; ++db)
#pragma unroll
                for (int s = 0; s < 2; ++s) { LAS unsigned char* vp = ldsV + (32 * db + r32) * AT_VP + (32 * kt + 16 * s + 4 * h) * 2;
                    const s16x4 vlo = *(LAS s16x4*)vp, vhi = *(LAS s16x4*)(vp + 16);
                    vf[db][s] = (bf16x8){vlo[0], vlo[1], vlo[2], vlo[3], vhi[0], vhi[1], vhi[2], vhi[3]}; }
#pragma unroll
            for (int rb = 0; rb < 2; ++rb) {
                if (pass == 0 && (kt < rb || kt > 8 + rb)) continue;
                const int t = pass == 0 ? kt - rb : kt;
                const int r = 32 * rb + r32;
                const int lo = max(r, 128 - q0), hi = min(r + 256, 2047 + 128 - q0);
                f32x16 p;
                { const float nm = -m_[rb];
#pragma unroll
                  for (int i = 0; i < 16; ++i) p[i] = nm; }
#pragma unroll
                for (int d0 = 0; d0 < 4; ++d0) p = mfma32(kf[d0], qf[rb][d0], p);
                if (pass == 0 && (t == 0 || t == 8 || q0 < 128 || q0 >= SEQ - 192)) {
#pragma unroll
                    for (int i = 0; i < 16; ++i) { const int c = 32 * kt + crow(i, h); if (c < lo || c > hi) p[i] = -INFINITY; }
                }
                float tm = p[0];
#pragma unroll
                for (int i = 1; i < 16; ++i) tm = fmaxf(tm, p[i]);
                tm = swap_max(tm);
                float alpha = 1.f;
                if (__any(tm > AT_THR)) {
                    const float d = fmaxf(tm, 0.f); alpha = __builtin_amdgcn_exp2f(-d); m_[rb] += d;
#pragma unroll
                    for (int i = 0; i < 16; ++i) p[i] -= d;
#pragma unroll
                    for (int db = 0; db < 2; ++db)
#pragma unroll
                        for (int i = 0; i < 16; ++i) o[rb][db][i] *= alpha; }
                float ls = 0.f;
#pragma unroll
                for (int i = 0; i < 16; ++i) { p[i] = __builtin_amdgcn_exp2f(p[i]); ls += p[i]; }
                l_[rb] = l_[rb] * alpha + ls;
                const bf16x8 pf0 = pack8(p, 0), pf1 = pack8(p, 1);
#pragma unroll
                for (int db = 0; db < 2; ++db)
#pragma unroll
                    for (int s = 0; s < 2; ++s) o[rb][db] = mfma32(vf[db][s], s == 0 ? pf0 : pf1, o[rb][db]);
            }
#if BG_ATT
            bg.post(tok);
#endif
        }
        if (pass == 1) {
#pragma unroll
            for (int rb = 0; rb < 2; ++rb) {
                const float inv = 1.f / swap_sum(l_[rb]);
                bf16* orow = O + (qrow0 + 32 * rb + r32) * D + hq * 64;
#pragma unroll
                for (int db = 0; db < 2; ++db)
#pragma unroll
                    for (int g4 = 0; g4 < 4; ++g4) { u32x2 w; w.x = cvtpk(o[rb][db][4 * g4] * inv, o[rb][db][4 * g4 + 1] * inv); w.y = cvtpk(o[rb][db][4 * g4 + 2] * inv, o[rb][db][4 * g4 + 3] * inv);
                        *(u32x2*)(orow + 32 * db + 8 * g4 + 4 * h) = w; }
            }
        }
        un = nun; pass = npass;
    }
#undef AT_LOAD
    bg.drain();
    __syncthreads();
}

DI void ssd_conv_phase(const Frame& F, bf16* XBC, const bf16* HB, const float* cw, const float* cb) {
    const int lane = lane_id();
    for (int it = F.gw; it < (TT / 256) * 24; it += F.NGW) {
        const int seg = it / 24, col = (it % 24) * 256 + lane * 4;
        const bool first = seg >= TLAT / 256 || (seg & 7) == 0, last = seg >= TLAT / 256 || (seg & 7) == 7;
        const f32x4 w0 = *(const f32x4*)(cw + col), w1 = *(const f32x4*)(cw + SSD_CONV + col), w2 = *(const f32x4*)(cw + 2 * SSD_CONV + col), bb = *(const f32x4*)(cb + col);
        u32x2* base = (u32x2*)(XBC + (size_t)seg * 256 * SSD_CONV + col);
        u32x2 prev = first ? (u32x2){0u, 0u} : *(const u32x2*)(HB + (size_t)(2 * (seg - 1) + 1) * SSD_CONV + col);
        const u32x2 nxt = last ? (u32x2){0u, 0u} : *(const u32x2*)(HB + (size_t)(2 * (seg + 1)) * SSD_CONV + col);
        for (int t0 = 0; t0 < 256; t0 += 32) {
            u32x2 raw[33];
#pragma unroll
            for (int i = 0; i < 32; ++i) raw[i] = base[(size_t)(t0 + i) * (SSD_CONV / 4)];
            raw[32] = (t0 + 32 < 256) ? base[(size_t)(t0 + 32) * (SSD_CONV / 4)] : nxt;
#pragma unroll
            for (int i = 0; i < 32; ++i) {
                const u32x2 a = i == 0 ? prev : raw[i - 1], b = raw[i], c2 = raw[i + 1];
                const float o0 = bb[0] + w0[0] * bflo(a.x) + w1[0] * bflo(b.x) + w2[0] * bflo(c2.x), o1 = bb[1] + w0[1] * bfhi(a.x) + w1[1] * bfhi(b.x) + w2[1] * bfhi(c2.x);
                const float o2 = bb[2] + w0[2] * bflo(a.y) + w1[2] * bflo(b.y) + w2[2] * bflo(c2.y), o3 = bb[3] + w0[3] * bfhi(a.y) + w1[3] * bfhi(b.y) + w2[3] * bfhi(c2.y);
                base[(size_t)(t0 + i) * (SSD_CONV / 4)] = (u32x2){cvtpk(silu_f(o0), silu_f(o1)), cvtpk(silu_f(o2), silu_f(o3))};
            }
            prev = raw[31];
        }
    }
}

DI void ssd_fin_phase(const Frame& F, bf16* Y, const bf16* Z, const float* nw) {
    const int lane = lane_id();
    for (int row = F.gw; row < TT; row += F.NGW) {
#pragma unroll 2
        for (int k = 0; k < 8; ++k) {
            const int col = 512 * k + 8 * lane;
            const v4u yv = *(const v4u*)(Y + (size_t)row * SSD_DI + col), zv = *(const v4u*)(Z + (size_t)row * SSD_DI + col);
            float t[8]; float ss = 0.f;
#pragma unroll
            for (int e = 0; e < 4; ++e) { const unsigned yw = yv[e], zw = zv[e];
                t[2 * e] = bflo(yw) * silu_f(bflo(zw)); t[2 * e + 1] = bfhi(yw) * silu_f(bfhi(zw));
                ss += t[2 * e] * t[2 * e] + t[2 * e + 1] * t[2 * e + 1]; }
            const float rs = 1.f / sqrtf(wave_sum(ss) * (1.f / 512.f) + RMS_EPS);
            const f32x4 n0 = *(const f32x4*)(nw + col), n1 = *(const f32x4*)(nw + col + 4);
            v4u o; o.x = cvtpk(t[0] * rs * n0[0], t[1] * rs * n0[1]); o.y = cvtpk(t[2] * rs * n0[2], t[3] * rs * n0[3]);
            o.z = cvtpk(t[4] * rs * n1[0], t[5] * rs * n1[1]); o.w = cvtpk(t[6] * rs * n1[2], t[7] * rs * n1[3]);
            *(v4u*)(Y + (size_t)row * SSD_DI + col) = o;
        }
    }
}

DI void hgrn_fin_phase(const Frame& F, const bf16* O, const bf16* OG, const float* nw, bf16* Gp) {
    const int lane = lane_id();
    for (int row = F.gw; row < TT; row += F.NGW) {
#pragma unroll
        for (int k = 0; k < 4; ++k) {
            const int col = 512 * k + 8 * lane;
            const v4u of = *(const v4u*)(O + (size_t)row * D + col), ob = *(const v4u*)(O + (size_t)TT * D + (size_t)row * D + col), gv = *(const v4u*)(OG + (size_t)row * D + col);
            const f32x4 n0 = *(const f32x4*)(nw + col), n1 = *(const f32x4*)(nw + col + 4);
            float o[8]; float ss = 0.f;
#pragma unroll
            for (int e = 0; e < 4; ++e) { o[2 * e] = bflo(of[e]) + bflo(ob[e]); o[2 * e + 1] = bfhi(of[e]) + bfhi(ob[e]); ss += o[2 * e] * o[2 * e] + o[2 * e + 1] * o[2 * e + 1]; }
#pragma unroll
            for (int sft = 1; sft < 16; sft <<= 1) ss += __shfl_xor(ss, sft);
            const float rs = 1.f / sqrtf(ss * (1.f / 128.f) + RMS_EPS);
            v4u w;
#pragma unroll
            for (int e = 0; e < 4; ++e) { const float na = e < 2 ? n0[2 * e] : n1[2 * e - 4], nb = e < 2 ? n0[2 * e + 1] : n1[2 * e - 3];
                w[e] = cvtpk(o[2 * e] * rs * na * silu_f(bflo(gv[e])), o[2 * e + 1] * rs * nb * silu_f(bfhi(gv[e]))); }
            *(v4u*)(Gp + (size_t)row * D + col) = w;
        }
    }
}

#define WGBAR() do { asm volatile("s_waitcnt lgkmcnt(0)" ::: "memory"); __builtin_amdgcn_s_barrier(); asm volatile("" ::: "memory"); } while (0)
constexpr int S2_BM = 0, S2_CM = 17408, S2_GT = 34816, S2_XR = 52224, S2_PW = 89088;
DI size_t scan_rowbase(int dir, int step, int b) {
    if (dir == 0) return step < 4 ? (size_t)(TLAT + b * CTXL + 64 * step) : (size_t)(b * SEQ + 64 * (step - 4));
    return step < 4 ? (size_t)(TLAT + b * CTXL + 64 * (3 - step)) : (size_t)(b * SEQ + 64 * (35 - step));
}
DI void ssd_scan2_phase(const Frame& F, const bf16* XBC, const float* DT, const float* a_log, const float* dsk, bf16* Y, BgConv& bg) {
    const int lane0 = lane_id(), wid = F.wave;
    LAS unsigned char* L = F.lds;
    for (int un = blockIdx.x; un < NB * 16; un += F.G) {
        const int b = un >> 4, hg = un & 15, grp = hg >> 1, hd = hg * 4 + (wid >> 1), pt = wid & 1;
        LAS unsigned char* XRh = L + S2_XR + (wid >> 1) * 9216;
        LAS float* PW = (LAS float*)(L + S2_PW + wid * 1024);
        for (int dir = 0; dir < 2; ++dir) {
            const float a = -__expf(a_log[dir * 64 + hd]), dskip = dsk[hd];
            f32x16 st[4];
#pragma unroll
            for (int nb = 0; nb < 4; ++nb)
#pragma unroll
                for (int i = 0; i < 16; ++i) st[nb][i] = 0.f;
            v4u pb[2], pc[2], px[4]; float pdt;
#define S2_LOAD(stp, ln) do { const size_t rb_ = scan_rowbase(dir, (stp), b); const int tid_ = wid * 64 + (ln); \
                _Pragma("unroll") for (int q_ = 0; q_ < 2; ++q_) { const int idx_ = tid_ + 512 * q_, j_ = idx_ >> 4, part_ = idx_ & 15, tj_ = dir ? 63 - j_ : j_; \
                    const bf16* src_ = XBC + (rb_ + tj_) * SSD_CONV + SSD_DI + grp * 128 + part_ * 8; pb[q_] = *(const v4u*)src_; pc[q_] = *(const v4u*)(src_ + 1024); } \
                _Pragma("unroll") for (int q_ = 0; q_ < 4; ++q_) { const int j_ = 32 * (wid & 1) + 8 * q_ + ((ln) >> 3), tj_ = dir ? 63 - j_ : j_; \
                    px[q_] = *(const v4u*)(XBC + (rb_ + tj_) * SSD_CONV + hd * 64 + ((ln) & 7) * 8); } \
                pdt = DT[(rb_ + (dir ? 63 - (ln) : (ln))) * 128 + dir * 64 + hd]; } while (0)
            S2_LOAD(0, lane0);
            for (int step = 0; step < 36; ++step) {
                int lane = lane0; asm volatile("" : "+v"(lane));
                const int tid = wid * 64 + lane, r32 = lane & 31, h = lane >> 5, q4 = (lane & 15) >> 2, p4 = lane & 3, blk = (lane >> 4) & 1;
                const size_t rowbase = scan_rowbase(dir, step, b);
                WGBAR();
#pragma unroll
                for (int q = 0; q < 2; ++q) { const int idx = tid + 512 * q, j = idx >> 4, part = idx & 15;
                    *(LAS v4u*)(L + S2_BM + j * 272 + part * 16) = pb[q]; *(LAS v4u*)(L + S2_CM + j * 272 + part * 16) = pc[q]; }
#pragma unroll
                for (int q = 0; q < 4; ++q) { const int j = 32 * (wid & 1) + 8 * q + (lane >> 3); *(LAS v4u*)(XRh + j * 144 + (lane & 7) * 16) = px[q]; }
                const float dtv = pdt; float ac = dtv * a;
#pragma unroll
                for (int off = 1; off < 64; off <<= 1) { const float t = __shfl_up(ac, off); if (lane >= off) ac += t; }
                const float tot = __int_as_float(__builtin_amdgcn_readlane(__float_as_int(ac), 63));
                { const float la = ac * LOG2E; PW[lane] = la; PW[64 + lane] = __builtin_amdgcn_exp2f(la); PW[128 + lane] = la - __builtin_amdgcn_logf(dtv); PW[192 + lane] = dtv * __expf(tot - ac); }
                if (step + 1 < 36) S2_LOAD(step + 1, lane);
                WGBAR();
#if BG_SSD == 1
                const BgConv::Tok tok = bg.pre();
#endif
                v4u yold[2][2];
                unsigned yoff[2];
#pragma unroll
                for (int it = 0; it < 2; ++it) { const int i = 32 * it + r32, ti = dir ? 63 - i : i; yoff[it] = (unsigned)(((rowbase + ti) * SSD_DI + hd * 64 + 32 * pt + 8 * h) * 2); }
                if (dir) {
#pragma unroll
                    for (int it = 0; it < 2; ++it)
#pragma unroll
                        for (int pr = 0; pr < 2; ++pr) yold[it][pr] = *(const v4u*)((const unsigned char*)Y + yoff[it] + 32 * pr);
                }
                if (wid < 3) {
                    const int jt = wid >> 1, it = wid == 0 ? 0 : 1, i = 32 * it + r32;
                    f32x16 g;
#pragma unroll
                    for (int q = 0; q < 16; ++q) g[q] = 0.f;
#pragma unroll
                    for (int ks = 0; ks < 8; ++ks) g = mfma32(lds_frag(L + S2_BM + (32 * jt + r32) * 272 + 32 * ks + 16 * h), lds_frag(L + S2_CM + i * 272 + 32 * ks + 16 * h), g);
#pragma unroll
                    for (int g4 = 0; g4 < 4; ++g4) *(LAS f32x4*)(L + S2_GT + i * 272 + (32 * jt + 8 * g4 + 4 * h) * 4) = (f32x4){g[4 * g4], g[4 * g4 + 1], g[4 * g4 + 2], g[4 * g4 + 3]};
                }
                f32x16 yacc[2];
#pragma unroll
                for (int it = 0; it < 2; ++it)
#pragma unroll
                    for (int q = 0; q < 16; ++q) yacc[it][q] = 0.f;
#pragma unroll
                for (int nb = 0; nb < 4; ++nb)
#pragma unroll
                    for (int s = 0; s < 2; ++s) { const bf16x8 bfr = pack8(st[nb], s);
#pragma unroll
                        for (int it = 0; it < 2; ++it) { LAS unsigned char* cp = L + S2_CM + (32 * it + r32) * 272 + (32 * nb + 16 * s + 4 * h) * 2;
                            yacc[it] = mfma32(bfr, cat8(*(LAS s16x4*)cp, *(LAS s16x4*)(cp + 16)), yacc[it]); } }
#pragma unroll
                for (int it = 0; it < 2; ++it) { const float ea = PW[64 + 32 * it + r32];
#pragma unroll
                    for (int q = 0; q < 16; ++q) yacc[it][q] *= ea; }
                WGBAR();
#if BG_SSD == 2
                const BgConv::Tok tok = bg.pre();
#endif
#pragma unroll
                for (int it = 0; it < 2; ++it) { const int i = 32 * it + r32; const float aci = PW[i];
#pragma unroll
                    for (int s = 0; s < 4; ++s) { if (s >= 2 * (it + 1)) continue;
                        const int j0 = 16 * s + 8 * h;
                        const f32x4 g0 = *(LAS f32x4*)(L + S2_GT + i * 272 + j0 * 4), g1 = *(LAS f32x4*)(L + S2_GT + i * 272 + j0 * 4 + 16);
                        const f32x4 a0 = *(LAS f32x4*)(PW + 128 + j0), a1 = *(LAS f32x4*)(PW + 128 + j0 + 4);
                        float m[8];
#pragma unroll
                        for (int e = 0; e < 4; ++e) { m[e] = (j0 + e <= i) ? g0[e] * __builtin_amdgcn_exp2f(aci - a0[e]) : 0.f; m[4 + e] = (j0 + 4 + e <= i) ? g1[e] * __builtin_amdgcn_exp2f(aci - a1[e]) : 0.f; }
                        v4u mp; mp.x = cvtpk(m[0], m[1]); mp.y = cvtpk(m[2], m[3]); mp.z = cvtpk(m[4], m[5]); mp.w = cvtpk(m[6], m[7]);
                        LAS unsigned char* xp = XRh + (16 * s + 8 * h + q4) * 144 + (32 * pt + 16 * blk + 4 * p4) * 2;
                        yacc[it] = mfma32(cat8(tr16(xp), tr16(xp + 4 * 144)), __builtin_bit_cast(bf16x8, mp), yacc[it]); } }
#if BG_SSD == 4
                const BgConv::Tok tok = bg.pre();
#endif
#pragma unroll
                for (int it = 0; it < 2; ++it)
#pragma unroll
                    for (int pr = 0; pr < 2; ++pr) {
                        float va[4], vb[4];
#pragma unroll
                        for (int e2 = 0; e2 < 4; ++e2) { va[e2] = yacc[it][8 * pr + e2]; vb[e2] = yacc[it][8 * pr + 4 + e2]; }
                        if (dir) {
                            const auto s0 = __builtin_amdgcn_permlane32_swap(yold[it][pr].x, yold[it][pr].z, false, false), s1 = __builtin_amdgcn_permlane32_swap(yold[it][pr].y, yold[it][pr].w, false, false);
                            va[0] += bflo(s0[0]); va[1] += bfhi(s0[0]); va[2] += bflo(s1[0]); va[3] += bfhi(s1[0]);
                            vb[0] += bflo(s0[1]); vb[1] += bfhi(s0[1]); vb[2] += bflo(s1[1]); vb[3] += bfhi(s1[1]);
                        } else {
                            const u32x2 xa = *(LAS u32x2*)(XRh + (32 * it + r32) * 144 + (32 * pt + 16 * pr + 4 * h) * 2), xb = *(LAS u32x2*)(XRh + (32 * it + r32) * 144 + (32 * pt + 16 * pr + 8 + 4 * h) * 2);
                            va[0] += dskip * bflo(xa.x); va[1] += dskip * bfhi(xa.x); va[2] += dskip * bflo(xa.y); va[3] += dskip * bfhi(xa.y);
                            vb[0] += dskip * bflo(xb.x); vb[1] += dskip * bfhi(xb.x); vb[2] += dskip * bflo(xb.y); vb[3] += dskip * bfhi(xb.y);
                        }
                        const unsigned a0 = cvtpk(va[0], va[1]), a1 = cvtpk(va[2], va[3]), b0 = cvtpk(vb[0], vb[1]), b1 = cvtpk(vb[2], vb[3]);
                        const auto t0 = __builtin_amdgcn_permlane32_swap(a0, b0, false, false), t1 = __builtin_amdgcn_permlane32_swap(a1, b1, false, false);
                        *(v4u*)((unsigned char*)Y + yoff[it] + 32 * pr) = (v4u){t0[0], t1[0], t0[1], t1[1]}; }
#if BG_SSD == 3
                const BgConv::Tok tok = bg.pre();
#endif
                { const float cd = __expf(tot);
#pragma unroll
                  for (int nb = 0; nb < 4; ++nb)
#pragma unroll
                      for (int q = 0; q < 16; ++q) st[nb][q] *= cd; }
#pragma unroll
                for (int s = 0; s < 4; ++s) {
                    LAS unsigned char* xp = XRh + (16 * s + 8 * h + q4) * 144 + (32 * pt + 16 * blk + 4 * p4) * 2;
                    const s16x4 xl = tr16(xp), xh = tr16(xp + 4 * 144);
                    const f32x4 w0 = *(LAS f32x4*)(PW + 192 + 16 * s + 8 * h), w1 = *(LAS f32x4*)(PW + 192 + 16 * s + 8 * h + 4);
                    v4u xd; xd.x = cvtpk(bf2f((unsigned short)xl[0]) * w0[0], bf2f((unsigned short)xl[1]) * w0[1]); xd.y = cvtpk(bf2f((unsigned short)xl[2]) * w0[2], bf2f((unsigned short)xl[3]) * w0[3]);
                    xd.z = cvtpk(bf2f((unsigned short)xh[0]) * w1[0], bf2f((unsigned short)xh[1]) * w1[1]); xd.w = cvtpk(bf2f((unsigned short)xh[2]) * w1[2], bf2f((unsigned short)xh[3]) * w1[3]);
#pragma unroll
                    for (int nb = 0; nb < 4; ++nb) { LAS unsigned char* bp = L + S2_BM + (16 * s + 8 * h + q4) * 272 + (32 * nb + 16 * blk + 4 * p4) * 2;
                        st[nb] = mfma32(cat8(tr16(bp), tr16(bp + 4 * 272)), __builtin_bit_cast(bf16x8, xd), st[nb]); }
                }
#if BG_SSD
                bg.post(tok);
#endif
            }
#undef S2_LOAD
            asm volatile("s_waitcnt vmcnt(0)" ::: "memory");
        }
    }
    bg.drain();
    __syncthreads();
}

#ifndef HG_SKEW
#define HG_SKEW 1
#endif
constexpr int H2_QT = 0, H2_KT = 17408, H2_VM = 34816, H2_AM = 52224, H2_EG = 61440, H2_TEAM = 61952;
DI void hgrn_scan2_phase(const Frame& F, const _Float16* LG, const bf16* V, const bf16* Q, bf16* O, BgConv& bg) {
    const int lane0 = lane_id(), wid = F.wave, team = wid >> 2, wq = wid & 3;
    LAS unsigned char* L = F.lds + team * H2_TEAM;
    const _Float16* LGd = LG + (size_t)team * TT * D;
    for (int un = blockIdx.x; un < NB * 16; un += F.G) {
        const int b = un >> 4, hd = un & 15;
        f32x16 st[4];
#pragma unroll
        for (int dt = 0; dt < 4; ++dt)
#pragma unroll
            for (int i = 0; i < 16; ++i) st[dt][i] = 0.f;
        v4u plg[4], pq[4], pv[4];
#define H2_LOAD(stp, ln) do { const size_t rb_ = scan_rowbase(team, (stp), b); const int col_ = hd * 128 + 8 * (4 * wq + ((ln) & 3)); \
            _Pragma("unroll") for (int r_ = 0; r_ < 4; ++r_) { const int i_ = 4 * ((ln) >> 2) + r_, ti_ = team ? 63 - i_ : i_; const size_t o_ = (rb_ + ti_) * D + col_; \
                plg[r_] = *(const v4u*)(LGd + o_); pq[r_] = *(const v4u*)(Q + o_); pv[r_] = *(const v4u*)(V + o_); } } while (0)
        H2_LOAD(0, lane0);
        if (HG_SKEW && team) WGBAR();
        for (int step = 0; step < 36; ++step) {
            int lane = lane0; asm volatile("" : "+v"(lane));
            const int r32 = lane & 31, h = lane >> 5, q4 = (lane & 15) >> 2, p4 = lane & 3, blk = (lane >> 4) & 1;
            const size_t rowbase = scan_rowbase(team, step, b);
            WGBAR();
            const BgConv::Tok tok = bg.pre();
            {
                const int part = lane >> 2, dcol = 8 * (4 * wq + (lane & 3));
                float P[4][8], kk[4][8];
#pragma unroll
                for (int r = 0; r < 4; ++r)
#pragma unroll
                    for (int e = 0; e < 4; ++e) { const unsigned w = plg[r][e]; kk[r][2 * e] = (float)__builtin_bit_cast(_Float16, (unsigned short)(w & 0xffffu)); kk[r][2 * e + 1] = (float)__builtin_bit_cast(_Float16, (unsigned short)(w >> 16)); }
                float tot[8];
#pragma unroll
                for (int e = 0; e < 8; ++e) { float run = 1.f;
#pragma unroll
                    for (int r = 0; r < 4; ++r) { run *= 1.f - kk[r][e]; P[r][e] = run; }
                    tot[e] = run; }
#pragma unroll
                for (int e = 0; e < 8; ++e) { float inc = tot[e];
#pragma unroll
                    for (int off = 4; off < 64; off <<= 1) { const float t = __shfl_up(inc, off); if (lane >= off) inc *= t; }
                    float pre = __shfl_up(inc, 4); if (lane < 4) pre = 1.f;
                    tot[e] = __shfl(inc, 60 + (lane & 3));
#pragma unroll
                    for (int r = 0; r < 4; ++r) P[r][e] *= pre; }
                if (part == 0) {
#pragma unroll
                    for (int e = 0; e < 8; e += 4) *(LAS f32x4*)(L + H2_EG + (dcol + e) * 4) = (f32x4){tot[e], tot[e + 1], tot[e + 2], tot[e + 3]}; }
#pragma unroll
                for (int r = 0; r < 4; ++r) { const int i = 4 * part + r; v4u qo, ko;
#pragma unroll
                    for (int e = 0; e < 4; ++e) { const unsigned qw = pq[r][e];
                        const float p0 = P[r][2 * e], p1 = P[r][2 * e + 1];
                        qo[e] = cvtpk(bflo(qw) * p0, bfhi(qw) * p1); ko[e] = cvtpk(kk[r][2 * e] * __builtin_amdgcn_rcpf(p0), kk[r][2 * e + 1] * __builtin_amdgcn_rcpf(p1)); }
                    *(LAS v4u*)(L + H2_QT + i * 272 + dcol * 2) = qo; *(LAS v4u*)(L + H2_KT + i * 272 + dcol * 2) = ko; *(LAS v4u*)(L + H2_VM + i * 272 + dcol * 2) = pv[r]; }
            }
            if (step + 1 < 36) H2_LOAD(step + 1, lane);
            WGBAR();
            if (wq < 3) {
                const int jt = wq >> 1, it = wq == 0 ? 0 : 1, i = 32 * it + r32;
                f32x16 g;
#pragma unroll
                for (int q = 0; q < 16; ++q) g[q] = 0.f;
#pragma unroll
                for (int ks = 0; ks < 8; ++ks) g = mfma32(lds_frag(L + H2_KT + (32 * jt + r32) * 272 + 32 * ks + 16 * h), lds_frag(L + H2_QT + i * 272 + 32 * ks + 16 * h), g);
#pragma unroll
                for (int q = 0; q < 16; ++q) { const int j = 32 * jt + crow(q, h); if (j > i) g[q] = 0.f; }
#pragma unroll
                for (int g4 = 0; g4 < 4; ++g4) { u32x2 w; w.x = cvtpk(g[4 * g4], g[4 * g4 + 1]); w.y = cvtpk(g[4 * g4 + 2], g[4 * g4 + 3]);
                    *(LAS u32x2*)(L + H2_AM + i * 144 + (32 * jt + 8 * g4 + 4 * h) * 2) = w; }
            }
            f32x16 oacc[2];
#pragma unroll
            for (int it = 0; it < 2; ++it)
#pragma unroll
                for (int q = 0; q < 16; ++q) oacc[it][q] = 0.f;
#pragma unroll
            for (int dt = 0; dt < 4; ++dt)
#pragma unroll
                for (int s = 0; s < 2; ++s) { const bf16x8 afr = pack8(st[dt], s);
#pragma unroll
                    for (int it = 0; it < 2; ++it) { LAS unsigned char* qp = L + H2_QT + (32 * it + r32) * 272 + (32 * dt + 16 * s + 4 * h) * 2;
                        oacc[it] = mfma32(afr, cat8(*(LAS s16x4*)qp, *(LAS s16x4*)(qp + 16)), oacc[it]); } }
            WGBAR();
            bf16x8 vfr[4];
#pragma unroll
            for (int s = 0; s < 4; ++s) { LAS unsigned char* vp = L + H2_VM + (16 * s + 8 * h + q4) * 272 + (32 * wq + 16 * blk + 4 * p4) * 2; vfr[s] = cat8(tr16(vp), tr16(vp + 4 * 272)); }
#pragma unroll
            for (int it = 0; it < 2; ++it)
#pragma unroll
                for (int s = 0; s < 4; ++s) { if (s >= 2 * (it + 1)) continue;
                    oacc[it] = mfma32(vfr[s], lds_frag(L + H2_AM + (32 * it + r32) * 144 + 32 * s + 16 * h), oacc[it]); }
#pragma unroll
            for (int it = 0; it < 2; ++it) { const int i = 32 * it + r32, ti = team ? 63 - i : i;
                bf16* op = O + (size_t)team * TT * D + (rowbase + ti) * D + hd * 128 + 32 * wq + 8 * h;
#pragma unroll
                for (int pr = 0; pr < 2; ++pr) {
                    const unsigned a0 = cvtpk(oacc[it][8 * pr], oacc[it][8 * pr + 1]), a1 = cvtpk(oacc[it][8 * pr + 2], oacc[it][8 * pr + 3]);
                    const unsigned b0 = cvtpk(oacc[it][8 * pr + 4], oacc[it][8 * pr + 5]), b1 = cvtpk(oacc[it][8 * pr + 6], oacc[it][8 * pr + 7]);
                    const auto t0 = __builtin_amdgcn_permlane32_swap(a0, b0, false, false), t1 = __builtin_amdgcn_permlane32_swap(a1, b1, false, false);
                    *(v4u*)(op + 16 * pr) = (v4u){t0[0], t1[0], t0[1], t1[1]}; } }
#pragma unroll
            for (int s = 0; s < 4; ++s)
#pragma unroll
                for (int dt = 0; dt < 4; ++dt) { LAS unsigned char* kp = L + H2_KT + (16 * s + 8 * h + q4) * 272 + (32 * dt + 16 * blk + 4 * p4) * 2;
                    st[dt] = mfma32(cat8(tr16(kp), tr16(kp + 4 * 272)), vfr[s], st[dt]); }
#pragma unroll
            for (int dt = 0; dt < 4; ++dt)
#pragma unroll
                for (int g4 = 0; g4 < 4; ++g4) { const f32x4 eg = *(LAS f32x4*)(L + H2_EG + (32 * dt + 8 * g4 + 4 * h) * 4);
#pragma unroll
                    for (int e = 0; e < 4; ++e) st[dt][4 * g4 + e] *= eg[e]; }
            bg.post(tok);
        }
        if (HG_SKEW && !team) WGBAR();
#undef H2_LOAD
    }
    bg.drain();
    __syncthreads();
}

#ifndef EN_MODP
#define EN_MODP 1
#endif
#ifndef EN_PRO
#define EN_PRO 1
#endif
#ifndef EN_NORM
#define EN_NORM 1
#endif
#ifndef EN_G1
#define EN_G1 1
#endif
#ifndef EN_ATT
#define EN_ATT 1
#endif
#ifndef EN_CONV
#define EN_CONV 1
#endif
#ifndef EN_HSCAN
#define EN_HSCAN 1
#endif
#ifndef EN_SSCAN
#define EN_SSCAN 1
#endif
#ifndef EN_FIN
#define EN_FIN 1
#endif
#ifndef EN_G2
#define EN_G2 1
#endif
#ifndef EN_G3
#define EN_G3 1
#endif
#ifndef EN_G4
#define EN_G4 1
#endif
#ifndef EN_G1A
#define EN_G1A 1
#endif
#ifndef EN_G1S
#define EN_G1S 1
#endif
#ifndef EN_G1H
#define EN_G1H 1
#endif
#ifndef REP_G1
#define REP_G1 1
#endif
#ifndef REP_G2
#define REP_G2 1
#endif
#ifndef REP_G3
#define REP_G3 1
#endif
#ifndef REP_G4
#define REP_G4 1
#endif
#ifndef REP_ATT
#define REP_ATT 1
#endif
#ifndef REP_SSCAN
#define REP_SSCAN 1
#endif
#ifndef REP_HSCAN
#define REP_HSCAN 1
#endif
#ifndef REP_PRO
#define REP_PRO 1
#endif
#ifndef MK_ONE_LAUNCH
#define MK_ONE_LAUNCH 1
#endif
#ifndef BG_G2
#define BG_G2 1
#endif
#ifndef BG_G3
#define BG_G3 1
#endif
#ifndef BG_G4
#define BG_G4 1
#endif
#ifndef MK_LAYERS
#define MK_LAYERS 4
#endif
constexpr int PH_MODP = 0, PH_PRO = 1, PH_N0 = 2, PH_L0 = 3, PH_PER = 9, PH_END = PH_L0 + PH_PER * DEPTH;
struct Args { const float* in[24]; float* out; unsigned char* ws; int lo, hi; };
static_assert(sizeof(Args) == 26 * 8 + 8, "no padding");

__global__ void __launch_bounds__(NWAVES * 64, 2) trunk_fwd(Args args) {
    extern __shared__ __attribute__((aligned(16))) unsigned char lds_raw[];
    Frame F;
    F.lds = (LAS unsigned char*)lds_raw;
    F.MISC = (volatile LAS unsigned*)(F.lds + MISC_OFF);
    F.wave = __builtin_amdgcn_readfirstlane((int)threadIdx.x >> 6);
    F.G = gridDim.x; F.gw = blockIdx.x * NWAVES + F.wave; F.NGW = F.G * NWAVES;
    unsigned char* ws = args.ws;
    F.ctl = (gu32*)(ws + WS_CTL);
    for (int u = threadIdx.x; u < (LDS_BYTES - LDSCTL_OFF) / 4; u += NWAVES * 64) ((LAS unsigned*)(F.lds + LDSCTL_OFF))[u] = 0u;
    __syncthreads();
    XcdBarrier bar = xcd_barrier_post((unsigned*)(F.ctl + CW_BAR), F.MISC + 8);
    const int lo = args.lo, hi = args.hi;
#define IN(k) (lo <= (k) && (k) < hi)
#define SEAM(k) do { if ((k) + 1 < hi) xcd_barrier(bar); } while (0)
    float* out = args.out;
    bf16* xbl = (bf16*)out;
    bf16* xbc = (bf16*)(ws + WS_H);
    bf16* xbl3 = (bf16*)(ws + WS_U2 + 144 * MiB);
    float* mod = (float*)(ws + WS_MOD);
        bf16* U = (bf16*)(ws + WS_U2);
    const float* rope = (const float*)(ws + WS_TAB);
    const float* lbv = (const float*)(ws + WS_TAB + 16384);

    if (EN_MODP && IN(PH_MODP)) { mod_partial_phase(F, INP(1), INP(3), INP(4), (float*)(ws + WS_MODP)); SEAM(PH_MODP); }
    if (EN_PRO && IN(PH_PRO)) { for (int rep = 0; rep < REP_PRO; ++rep) prologue_phase(F, ws); SEAM(PH_PRO); }
#ifdef IDLE_TICKS
    { const unsigned long long t0 = __builtin_amdgcn_s_memrealtime(); while (__builtin_amdgcn_s_memrealtime() - t0 < IDLE_TICKS) __builtin_amdgcn_s_sleep(32); }
#endif
    if (EN_NORM && IN(PH_N0)) {
        norm_phase<0>(F, TT, nullptr, nullptr, INP(0), INP(2), xbl, xbc, xbl, nullptr, nullptr, 0, nullptr, mod, 0, INP(6), U);
        SEAM(PH_N0);
    }
    for (int l = 0; l < MK_LAYERS; ++l) {
        const int base = PH_L0 + PH_PER * l, kind = l % 3, j = l / 3;
        const float* modl = mod + (size_t)l * 17 * NMODC;
        const int M2 = l < DEPTH - 1 ? TT : TLAT;
        BgConv bg; bg.init((kind == 0 && !BG_ATT) ? DEPTH : l + 1);
        pg8::NoSide noside;
        if (EN_G1 && IN(base + 0)) { for (int rep = 0; rep < REP_G1; ++rep) {
            pg8::StaticOrder S;
            if (kind == 0) { if (EN_G1A) {
                pg8::Gemm g{U, (const bf16*)(ws + WS_WATT + (size_t)j * (W_ATT_IN + W_ATT_OUT)), TT, ATT_IN, D}; S.init(TT, ATT_IN, F.G, (int)blockIdx.x);
                EpiAttn E{(bf16*)(ws + A_KB), (bf16*)(ws + A_QB), (bf16*)(ws + A_VTL), (bf16*)(ws + A_VTC), rope};
                pg8::gemm_phase<EpiAttn, pg8::StaticOrder, true, true>(F.lds, g, S, E, F.wave, noside); }
            } else if (kind == 1) { if (EN_G1S) {
                pg8::Gemm g{U, (const bf16*)(ws + WS_WSSD), TT, SSD_INP, D}; S.init(TT, SSD_INP, F.G, (int)blockIdx.x);
                EpiSsd E{(bf16*)(ws + S_XBC), (bf16*)(ws + S_Z), (float*)(ws + S_DT), INP(15), (bf16*)(ws + WS_MODP)};
                pg8::gemm_phase<EpiSsd, pg8::StaticOrder, true, true>(F.lds, g, S, E, F.wave, noside); }
            } else if (EN_G1H) {
                pg8::Gemm g{U, (const bf16*)(ws + WS_WHG), TT, HG_IN, D}; S.init(TT, HG_IN, F.G, (int)blockIdx.x);
                EpiHgrn E{(_Float16*)(ws + H_LG), (bf16*)(ws + H_V), lbv};
                pg8::gemm_phase<EpiHgrn, pg8::StaticOrder, true, true>(F.lds, g, S, E, F.wave, noside);
            } }
            SEAM(base + 0);
        }
        if (IN(base + 1)) {
            if (kind == 0) { if (EN_ATT) for (int rep = 0; rep < REP_ATT; ++rep) attn_phase(F, (const bf16*)(ws + A_KB), (const bf16*)(ws + A_QB), (const bf16*)(ws + A_VTL), (const bf16*)(ws + A_VTC), INP(11) + j * 32, (bf16*)(ws + A_O), l < DEPTH - 1, bg); }
            else if (kind == 1) { if (EN_CONV) ssd_conv_phase(F, (bf16*)(ws + S_XBC), (const bf16*)(ws + WS_MODP), INP(13), INP(14)); }
            else if (EN_HSCAN) for (int rep = 0; rep < REP_HSCAN; ++rep) hgrn_scan2_phase(F, (const _Float16*)(ws + H_LG), (const bf16*)(ws + H_V), (const bf16*)(ws + H_Q), (bf16*)(ws + WS_U2), bg);
            SEAM(base + 1);
        }
        if (kind != 0 && IN(base + 2)) {
            if (kind == 1) { if (EN_SSCAN) for (int rep = 0; rep < REP_SSCAN; ++rep) ssd_scan2_phase(F, (const bf16*)(ws + S_XBC), (const float*)(ws + S_DT), INP(16), INP(17), (bf16*)(ws + WS_U2), bg); }
            else if (EN_FIN) hgrn_fin_phase(F, (const bf16*)(ws + WS_U2), (const bf16*)(ws + H_OG), INP(22), (bf16*)(ws + H_LG));
            SEAM(base + 2);
        }
        if (kind == 1 && IN(base + 3)) {
            if (EN_FIN) ssd_fin_phase(F, (bf16*)(ws + WS_U2), (const bf16*)(ws + S_Z), INP(18));
            SEAM(base + 3);
        }
        bf16* ymix = (bf16*)(ws + (kind == 0 ? A_Y : (kind == 1 ? S_XBC : H_V)));
        bf16* Un2 = ((NT_N2 & 2) && kind == 1) ? (bf16*)(ws + S_Z) : U;
        if (EN_G2 && IN(base + 4)) {
            const bf16* A2 = (const bf16*)(ws + (kind == 0 ? A_O : (kind == 1 ? WS_U2 : H_LG)));
            const bf16* W2 = (const bf16*)(ws + (kind == 0 ? WS_WATT + (size_t)j * (W_ATT_IN + W_ATT_OUT) + W_ATT_IN : (kind == 1 ? WS_WSSD + W_SSD_IN : WS_WHG + W_HG_IN)));
            pg8::Gemm g{A2, W2, M2, D, kind == 1 ? SSD_DI : D}; pg8::StaticOrder S; S.init(M2, D, F.G, (int)blockIdx.x);
            EpiBf16Y E{ymix};
            if (NT_ON && l < DEPTH - 1 && (((NT_N2 & 1) && kind != 1) || ((NT_N2 & 2) && kind == 1))) {
                CountOrder SC; SC.init(M2, D, F.G, (int)blockIdx.x); SC.cnt = (unsigned*)F.ctl + CW_PCNT + (l * 2 + 0) * 4096; SC.xcc = (int)bar.x;
                EpiBf16YWT EW{ymix}; NormTail<0> nt{l, (NT_TAIL && SC.idle_last()) ? 1 : 0, (int)blockIdx.x - SC.nwg % SC.G, &SC};
                pg8::gemm_phase<EpiBf16YWT, CountOrder, true, true, NormTail<0>>(F.lds, g, SC, EW, F.wave, nt);
            } else
            for (int rep = 0; rep < REP_G2; ++rep) { if (BG_G2) pg8::gemm_phase<EpiBf16Y, pg8::StaticOrder, true, true>(F.lds, g, S, E, F.wave, noside); else pg8::gemm_phase<EpiBf16Y, pg8::StaticOrder, true, true>(F.lds, g, S, E, F.wave, noside); }
            SEAM(base + 4);
        }
        if (EN_NORM && IN(base + 5)) {
            if (NT_ON && l < DEPTH - 1 && (((NT_N2 & 1) && kind != 1) || ((NT_N2 & 2) && kind == 1))) norm_rest_phase(F, l, 0, ymix, xbl, xbc, modl, 2, INP(6) + (l * 4 + 1) * D, modl, 3, INP(6) + (l * 4 + 2) * D, Un2);
            else norm_phase<1>(F, M2, ymix, nullptr, nullptr, nullptr, xbl, xbc, l == DEPTH - 1 ? xbl3 : xbl, nullptr, modl, 2, INP(6) + (l * 4 + 1) * D, modl, 3, INP(6) + (l * 4 + 2) * D, Un2);
            SEAM(base + 5);
        }
        const unsigned char* wffn = ws + WS_WFFN + (size_t)l * (W_FFN_IN + W_FFN_OUT);
        if (EN_G3 && IN(base + 6)) {
            pg8::Gemm g{Un2, (const bf16*)wffn, M2, 2 * FFN, D}; pg8::StaticOrder S; S.init(M2, 2 * FFN, F.G, (int)blockIdx.x);
            EpiSwiglu E{(bf16*)(ws + F_H)};
            for (int rep = 0; rep < REP_G3; ++rep) { if (BG_G3) pg8::gemm_phase<EpiSwiglu, pg8::StaticOrder, true, true>(F.lds, g, S, E, F.wave, noside); else pg8::gemm_phase<EpiSwiglu, pg8::StaticOrder, true, true>(F.lds, g, S, E, F.wave, noside); }
            SEAM(base + 6);
        }
        if (EN_G4 && IN(base + 7)) {
            pg8::Gemm g{(const bf16*)(ws + F_H), (const bf16*)(wffn + W_FFN_IN), M2, D, FFN}; pg8::StaticOrder S; S.init(M2, D, F.G, (int)blockIdx.x);
            EpiBf16Y E{(bf16*)(ws + F_Y)};
            if (NT_ON && l < DEPTH - 1) {
                CountOrder SC; SC.init(M2, D, F.G, (int)blockIdx.x); SC.cnt = (unsigned*)F.ctl + CW_PCNT + (l * 2 + 1) * 4096; SC.xcc = (int)bar.x;
                EpiBf16YWT EW{(bf16*)(ws + F_Y)}; NormTail<1> nt{l, (NT_TAIL && SC.idle_last()) ? 1 : 0, (int)blockIdx.x - SC.nwg % SC.G, &SC};
                pg8::gemm_phase<EpiBf16YWT, CountOrder, true, true, NormTail<1>>(F.lds, g, SC, EW, F.wave, nt);
            } else
            for (int rep = 0; rep < REP_G4; ++rep) { if (BG_G4) pg8::gemm_phase<EpiBf16Y, pg8::StaticOrder, true, true>(F.lds, g, S, E, F.wave, noside); else pg8::gemm_phase<EpiBf16Y, pg8::StaticOrder, true, true>(F.lds, g, S, E, F.wave, noside); }
            SEAM(base + 7);
        }
        if (EN_NORM && IN(base + 8)) {
            if (l < DEPTH - 1) { if (NT_ON) norm_rest_phase(F, l, 1, (const bf16*)(ws + F_Y), xbl, xbc, modl, 5, INP(6) + (l * 4 + 3) * D, modl + 17 * NMODC, 0, INP(6) + ((l + 1) * 4 + 0) * D, U);
                else norm_phase<1>(F, M2, (const bf16*)(ws + F_Y), nullptr, nullptr, nullptr, xbl, xbc, xbl, nullptr, modl, 5, INP(6) + (l * 4 + 3) * D, modl + 17 * NMODC, 0, INP(6) + ((l + 1) * 4 + 0) * D, U); }
            else norm_phase<2>(F, M2, (const bf16*)(ws + F_Y), nullptr, nullptr, nullptr, xbl3, xbc, xbl3, out, modl, 5, INP(6) + (l * 4 + 3) * D, nullptr, 0, nullptr, nullptr);
            SEAM(base + 8);
        }
    }
#undef IN
#undef SEAM
}

extern "C" void kernel_launch(void* const* d_in, const int* in_sizes, int n_in, void* d_out, int out_size, void* d_ws, size_t ws_size, hipStream_t stream) {
    static int grid = 0;
    if (grid == 0) {
        if (n_in != 24 || in_sizes[0] != TLAT * D || out_size != TLAT * D || ws_size < WS_END) {
            fprintf(stderr, "kernel_launch: unexpected shapes: n_in %d in0 %d out %d ws %zu (need %zu)\n", n_in, n_in > 0 ? in_sizes[0] : -1, out_size, ws_size, (size_t)WS_END); grid = -1; return; }
        int dev = 0, cus = 0, per_cu = 0;
        if (hipGetDevice(&dev) != hipSuccess || hipDeviceGetAttribute(&cus, hipDeviceAttributeMultiprocessorCount, dev) != hipSuccess) { grid = -1; return; }
        if (hipFuncSetAttribute((const void*)trunk_fwd, hipFuncAttributeMaxDynamicSharedMemorySize, LDS_BYTES) != hipSuccess) { fprintf(stderr, "kernel_launch: hipFuncSetAttribute failed\n"); grid = -1; return; }
        if (hipOccupancyMaxActiveBlocksPerMultiprocessor(&per_cu, (const void*)trunk_fwd, NWAVES * 64, LDS_BYTES) != hipSuccess || per_cu < 1)
            fprintf(stderr, "kernel_launch: occupancy query reports %d\n", per_cu);
        (void)hipGetLastError();
        grid = cus;
    }
    if (grid < 0) return;
    if (hipMemsetAsync((char*)d_ws + WS_CTL, 0, CTL_ZERO_BYTES, stream) != hipSuccess) return;
    Args a{};
    for (int i = 0; i < 24; ++i) a.in[i] = (const float*)d_in[i];
    a.out = (float*)d_out; a.ws = (unsigned char*)d_ws;
#if MK_ONE_LAUNCH
    a.lo = 0; a.hi = PH_L0 + PH_PER * MK_LAYERS;
    hipLaunchKernelGGL(trunk_fwd, dim3(grid), dim3(NWAVES * 64), LDS_BYTES, stream, a);
#else
    for (int id = 0; id < PH_L0 + PH_PER * MK_LAYERS; ++id) {
        if (id >= PH_L0) { const int loc = (id - PH_L0) % PH_PER, kind = ((id - PH_L0) / PH_PER) % 3; if ((loc == 2 && kind == 0) || (loc == 3 && kind != 1)) continue; }
        a.lo = id; a.hi = id + 1;
        hipLaunchKernelGGL(trunk_fwd, dim3(grid), dim3(NWAVES * 64), LDS_BYTES, stream, a);
    }
#endif
}
```

```cpp
#include <hip/hip_runtime.h>
#include <cstdio>
#include <cstdint>
#include <cmath>
namespace pg8 {
#define PG8_LAS __attribute__((address_space(3)))
typedef unsigned short bf16_t;
typedef short bf16x8 __attribute__((ext_vector_type(8)));
typedef float f32x4 __attribute__((ext_vector_type(4)));
typedef unsigned u32x4 __attribute__((ext_vector_type(4)));
constexpr int BM = 256, BK = 64, HALF = 128, HTB = HALF * BK * 2  , STAGE_BYTES = 8 * HTB, NXCD = 8, WGM = 4;

__host__ __device__ __forceinline__ int lds_byte(int r, int c) { const int st = (r >> 4) * 2 + (c >> 5), rr = r & 15, cc = c & 31, ob = rr * 64 + cc * 2; return st * 1024 + (ob ^ (((ob >> 9) & 1) << 5)); }
__host__ __device__ __forceinline__ void stage_rc(int b, int& R, int& C) { const int st = b / 1024, sb = b % 1024, swz = sb ^ (((sb >> 9) & 1) << 5); R = (st >> 1) * 16 + swz / 64; C = (st & 1) * 32 + (swz % 64) / 2; }
__host__ __device__ __forceinline__ int perm32(int rho) { const int n = rho >> 4, i = rho & 15; return 8 * (i >> 2) + 4 * n + (i & 3); }

struct Unit { int pm, pn; int koff = 0; int nt = 0; };
struct Gemm { const bf16_t* A; const bf16_t* Bt; int M, N, K; int ldk = 0; };

struct StaticOrder {
    int nM, nN, nwg, G, c; int rev = 0;
    __host__ __device__ void init(int M, int N, int G_, int c_) { nM = M / BM; nN = N / BM; nwg = nM * nN; G = G_; c = c_; }
    __host__ __device__ bool next(int i, Unit& u) const {
        const long L = (long)i * G + c; if (L >= nwg) return false;
        int wgid = (int)L; { const int q = nwg / NXCD, r = nwg % NXCD, xcd = wgid % NXCD, cnt = q + (xcd < r ? 1 : 0); int off = wgid / NXCD; if (rev) off = cnt - 1 - off; wgid = (xcd < r ? xcd * (q + 1) : r * (q + 1) + (xcd - r) * q) + off; }
        const int nig = WGM * nN, gid = wgid / nig, fm = gid * WGM, gsz = (nM - fm) < WGM ? (nM - fm) : WGM;
        u.pm = fm + ((wgid % nig) % gsz); u.pn = (wgid % nig) / gsz; return true;
    }
    __host__ __device__ bool idle_last() const { const int r = nwg % G; return r != 0 && c >= r; }
    __device__ __forceinline__ void a_ready(const Unit&) const {}
    __device__ __forceinline__ void done(const Unit&) const {}
};

__device__ __forceinline__ unsigned cvt_pk_bf16(float lo, float hi) { unsigned r; asm volatile("v_cvt_pk_bf16_f32 %0, %1, %2" : "=v"(r) : "v"(lo), "v"(hi)); return r; }
typedef float f32x2 __attribute__((ext_vector_type(2)));
struct NoSide { struct Tok {}; __device__ __forceinline__ Tok pre() { return Tok{}; } __device__ __forceinline__ void post(const Tok&) {} __device__ __forceinline__ void tail() {} };
template <class Epi, class Sched, bool ALIGN_EPI = false, bool SP2 = false, class Side = NoSide>
__device__ __forceinline__ void gemm_phase(PG8_LAS unsigned char* lds, const Gemm g, const Sched& S, const Epi& E, const int wave_id, Side& side) {
    int lane_; asm volatile("v_mbcnt_lo_u32_b32 %0, -1, 0\n\tv_mbcnt_hi_u32_b32 %0, -1, %0" : "=v"(lane_));
    const int tid_ = wave_id * 64 + lane_;
    const int tid = tid_, wid = __builtin_amdgcn_readfirstlane(tid >> 6), lane = tid & 63, wr = wid >> 2, wc = wid & 3, fr = lane & 15, fq = lane >> 4;
    const int K = g.ldk ? g.ldk : g.K, nt = g.K / BK;
    unsigned voffA[2], voffB[2];
#pragma unroll
    for (int i = 0; i < 2; ++i) { int R, C; stage_rc(tid * 16 + i * 8192, R, C); const int Rb = Epi::PERM ? ((R & ~31) + perm32(R & 31)) : R;
        voffA[i] = (unsigned)(R * K + C) * 2u; voffB[i] = (unsigned)(Rb * K + C) * 2u; }
    const size_t kstep = (size_t)(BK * 2);
    const size_t hstep = (size_t)HALF * K * 2;
    const size_t tstep = 2 * hstep;
    const unsigned ldsw = (unsigned)wid * 1024u;
    const int aoff = lds_byte(wr * 64 + fr, fq * 8), boff = lds_byte(wc * 32 + fr, fq * 8);
#define PG8_SA(b, h) (((b) * 2 + (h)) * HTB)
#define PG8_SB(b, h) ((4 + (b) * 2 + (h)) * HTB)
#define PG8_STAGE(bufoff, gbase, voff) do { _Pragma("unroll") for (int _i = 0; _i < 2; ++_i) \
        __builtin_amdgcn_global_load_lds((const unsigned*)((const char*)(gbase) + (voff)[_i]), (PG8_LAS unsigned*)(lds + (bufoff) + ldsw + _i * 8192), 16, 0, 0); } while (0)
#define PG8_LDA(dst, b, h) do { _Pragma("unroll") for (int m = 0; m < 4; ++m) _Pragma("unroll") for (int k = 0; k < 2; ++k) dst[m][k] = *(const PG8_LAS bf16x8*)(lds + PG8_SA(b, h) + aoff + m * 2048 + k * 1024); } while (0)
#define PG8_LDB(dst, b, h) do { _Pragma("unroll") for (int n = 0; n < 2; ++n) _Pragma("unroll") for (int k = 0; k < 2; ++k) dst[n][k] = *(const PG8_LAS bf16x8*)(lds + PG8_SB(b, h) + boff + n * 2048 + k * 1024); } while (0)
#define PG8_MMA(ai, bj, At, Bt) do { __builtin_amdgcn_s_setprio(1); _Pragma("unroll") for (int m = 0; m < 4; ++m) _Pragma("unroll") for (int n = 0; n < 2; ++n) _Pragma("unroll") for (int k = 0; k < 2; ++k) \
        acc[ai][bj][m][n] = __builtin_amdgcn_mfma_f32_16x16x32_bf16(Bt[n][k], At[m][k], acc[ai][bj][m][n], 0, 0, 0); __builtin_amdgcn_s_setprio(0); } while (0)
#define PG8_WAIT_V(n) asm volatile("s_waitcnt vmcnt(" #n ")" ::: "memory")
#define PG8_WAIT_L(n) asm volatile("s_waitcnt lgkmcnt(" #n ")" ::: "memory")
#define PG8_BAR __builtin_amdgcn_s_barrier()
#define PG8_SCHED __builtin_amdgcn_sched_barrier(0)
    Unit cur, nxt; int ui = 0;
    if (!S.next(0, cur)) return;
    f32x4 acc[2][2][4][2];
#pragma unroll
    for (int a = 0; a < 2; ++a)
#pragma unroll
        for (int b = 0; b < 2; ++b)
#pragma unroll
            for (int m = 0; m < 4; ++m)
#pragma unroll
                for (int n = 0; n < 2; ++n) acc[a][b][m][n] = (f32x4){0.f, 0.f, 0.f, 0.f};
    bf16x8 At[4][2], B0[2][2], B1[2][2];
    const char* cA = (const char*)g.A + (size_t)cur.pm * tstep + (size_t)cur.koff * 2; const char* cB = (const char*)g.Bt + (size_t)cur.pn * tstep + (size_t)cur.koff * 2;
    S.a_ready(cur);
    if constexpr (SP2) {
        PG8_STAGE(PG8_SB(0, 0), cB, voffB); PG8_STAGE(PG8_SB(0, 1), cB + hstep, voffB); PG8_STAGE(PG8_SA(0, 0), cA, voffA); PG8_STAGE(PG8_SA(0, 1), cA + hstep, voffA);
        if (wr == 1) PG8_BAR;
        PG8_WAIT_V(2); PG8_BAR;
        PG8_STAGE(PG8_SB(1, 0), cB + kstep, voffB); PG8_STAGE(PG8_SA(1, 0), cA + kstep, voffA); PG8_STAGE(PG8_SB(1, 1), cB + hstep + kstep, voffB);
        PG8_WAIT_V(6); PG8_BAR;
    } else {
        PG8_STAGE(PG8_SB(0, 0), cB, voffB); PG8_STAGE(PG8_SA(0, 0), cA, voffA); PG8_STAGE(PG8_SB(0, 1), cB + hstep, voffB); PG8_STAGE(PG8_SA(0, 1), cA + hstep, voffA);
        if (wr == 1) PG8_BAR;
        PG8_WAIT_V(4); PG8_BAR;
        PG8_STAGE(PG8_SB(1, 0), cB + kstep, voffB); PG8_STAGE(PG8_SA(1, 0), cA + kstep, voffA); PG8_STAGE(PG8_SB(1, 1), cB + hstep + kstep, voffB);
        PG8_WAIT_V(6); PG8_BAR;
    }
    for (;;) {
        const bool has_next = S.next(ui + 1, nxt);
        const char* nA = has_next ? (const char*)g.A + (size_t)nxt.pm * tstep + (size_t)nxt.koff * 2 : cA; const char* nB = has_next ? (const char*)g.Bt + (size_t)nxt.pn * tstep + (size_t)nxt.koff * 2 : cB;
        for (int t = 0; t < nt; t += 2) {
            const bool last = (t == nt - 2);
            const char* a1 = cA + (size_t)(t + 1) * kstep;
            const char* a2 = last ? nA : cA + (size_t)(t + 2) * kstep; const char* b2 = last ? nB : cB + (size_t)(t + 2) * kstep;
            const char* a3 = a2 + kstep; const char* b3 = b2 + kstep;
            if (last && has_next) S.a_ready(nxt);
            if constexpr (SP2) {
            PG8_LDB(B0, 0, 0); PG8_LDB(B1, 0, 1); PG8_SCHED; PG8_LDA(At, 0, 0); PG8_STAGE(PG8_SA(1, 1), a1 + hstep, voffA);
            PG8_WAIT_V(8); PG8_WAIT_L(0); PG8_BAR; PG8_MMA(0, 0, At, B0); PG8_MMA(0, 1, At, B1); PG8_BAR; PG8_SCHED;
            PG8_LDA(At, 0, 1); PG8_STAGE(PG8_SB(0, 0), b2, voffB); PG8_STAGE(PG8_SB(0, 1), b2 + hstep, voffB); PG8_STAGE(PG8_SA(0, 0), a2, voffA);
            PG8_WAIT_V(8); PG8_WAIT_L(0); PG8_BAR; PG8_MMA(1, 0, At, B0); PG8_MMA(1, 1, At, B1); PG8_BAR; PG8_SCHED;
            PG8_LDB(B0, 1, 0); PG8_LDB(B1, 1, 1); PG8_SCHED; PG8_LDA(At, 1, 0); PG8_STAGE(PG8_SA(0, 1), a2 + hstep, voffA);
            PG8_WAIT_V(8); PG8_WAIT_L(0); PG8_BAR; PG8_MMA(0, 0, At, B0); PG8_MMA(0, 1, At, B1); PG8_BAR; PG8_SCHED;
            PG8_LDA(At, 1, 1); PG8_STAGE(PG8_SB(1, 0), b3, voffB); PG8_STAGE(PG8_SB(1, 1), b3 + hstep, voffB); PG8_STAGE(PG8_SA(1, 0), a3, voffA);
            PG8_WAIT_V(8); PG8_WAIT_L(0); PG8_BAR; PG8_MMA(1, 0, At, B0); PG8_MMA(1, 1, At, B1); PG8_BAR; PG8_SCHED;
            } else {
            PG8_LDB(B0, 0, 0); PG8_SCHED; PG8_LDA(At, 0, 0); PG8_STAGE(PG8_SA(1, 1), a1 + hstep, voffA);
            PG8_WAIT_L(8); PG8_BAR; PG8_WAIT_L(0); PG8_MMA(0, 0, At, B0); PG8_BAR; PG8_SCHED;
            PG8_LDB(B1, 0, 1); PG8_STAGE(PG8_SB(0, 0), b2, voffB);
            PG8_BAR; PG8_WAIT_L(0); PG8_MMA(0, 1, At, B1); PG8_BAR;
            PG8_LDA(At, 0, 1); PG8_STAGE(PG8_SA(0, 0), a2, voffA);
            PG8_BAR; PG8_WAIT_L(0); PG8_MMA(1, 0, At, B0); PG8_BAR; PG8_SCHED;
            PG8_STAGE(PG8_SB(0, 1), b2 + hstep, voffB);
            PG8_WAIT_V(6); PG8_BAR; PG8_MMA(1, 1, At, B1); PG8_BAR;
            PG8_LDB(B0, 1, 0); PG8_SCHED; PG8_LDA(At, 1, 0); PG8_STAGE(PG8_SA(0, 1), a2 + hstep, voffA);
            PG8_WAIT_L(8); PG8_BAR; PG8_WAIT_L(0); PG8_MMA(0, 0, At, B0); PG8_BAR; PG8_SCHED;
            PG8_LDB(B1, 1, 1); PG8_STAGE(PG8_SB(1, 0), b3, voffB);
            PG8_BAR; PG8_WAIT_L(0); PG8_MMA(0, 1, At, B1); PG8_BAR;
            PG8_LDA(At, 1, 1); PG8_STAGE(PG8_SA(1, 0), a3, voffA);
            PG8_BAR; PG8_WAIT_L(0); PG8_MMA(1, 0, At, B0); PG8_BAR; PG8_SCHED;
            PG8_STAGE(PG8_SB(1, 1), b3 + hstep, voffB);
            PG8_WAIT_V(6); PG8_BAR; PG8_MMA(1, 1, At, B1); PG8_BAR;
            }
        }
        if constexpr (ALIGN_EPI) { if (wr == 0) PG8_BAR; }
        const typename Side::Tok tok = side.pre();
        if constexpr (!Epi::AFTER_DRAIN) { E(acc, cur, wr, wc, fr, fq); S.done(cur); }
        side.post(tok);
        if (!has_next) break;
#pragma unroll
        for (int a = 0; a < 2; ++a)
#pragma unroll
            for (int b = 0; b < 2; ++b)
#pragma unroll
                for (int m = 0; m < 4; ++m)
#pragma unroll
                    for (int n = 0; n < 2; ++n) acc[a][b][m][n] = (f32x4){0.f, 0.f, 0.f, 0.f};
        cur = nxt; cA = nA; cB = nB; ++ui;
        if constexpr (ALIGN_EPI) { if (wr == 1) PG8_BAR; }
    }
    PG8_WAIT_V(0);
    if constexpr (!ALIGN_EPI) { if (wr == 0) PG8_BAR; }
    PG8_BAR;
    if constexpr (Epi::AFTER_DRAIN) { E.fused(acc, cur, wr, wc, fr, fq, lds, wid, lane); S.done(cur); }
    side.tail();
#undef PG8_SA
#undef PG8_SB
#undef PG8_STAGE
#undef PG8_LDA
#undef PG8_LDB
#undef PG8_MMA
#undef PG8_WAIT_V
#undef PG8_WAIT_L
#undef PG8_BAR
#undef PG8_SCHED
}
}
#define GAS __attribute__((address_space(1)))
#define LAS __attribute__((address_space(3)))
typedef unsigned short bf16;
typedef unsigned v4u __attribute__((ext_vector_type(4)));
typedef float f32x4 __attribute__((ext_vector_type(4)));
typedef short bf16x8 __attribute__((ext_vector_type(8)));
typedef GAS unsigned gu32;
typedef GAS unsigned long long gu64;
#define RLX_AGENT __ATOMIC_RELAXED, __HIP_MEMORY_SCOPE_AGENT
#define LDS_WAIT() asm volatile("s_waitcnt lgkmcnt(0)" ::: "memory")
#define VM_WAIT() asm volatile("s_waitcnt vmcnt(0)" ::: "memory")
__device__ __forceinline__ unsigned long long rt() { return __builtin_amdgcn_s_memrealtime(); }
__device__ __forceinline__ unsigned f2bf(float f) { unsigned u = __builtin_bit_cast(unsigned, f); return (u + 0x7fffu + ((u >> 16) & 1u)) >> 16; }
__device__ __forceinline__ unsigned pk2(float lo, float hi) { return f2bf(lo) | (f2bf(hi) << 16); }

#define XB_TMO      128
#define XB_XCNT(j)  (256  + 64 * (j))
#define XB_XSUB(j)  (1280 + 64 * (j))
#define XB_XGEN(j)  (2304 + 64 * (j))
#define XB_TOP      3328
#define XB_TOPGEN   3392
#define XCD_BAR_WORDS 3456
#define XB_SPIN_CAP (1u << 18)

__device__ __forceinline__ unsigned xb_ld(unsigned* p)              { return __hip_atomic_load(p, __ATOMIC_RELAXED, __HIP_MEMORY_SCOPE_AGENT); }
__device__ __forceinline__ unsigned xb_add(unsigned* p, unsigned v) { return __hip_atomic_fetch_add(p, v, __ATOMIC_RELAXED, __HIP_MEMORY_SCOPE_AGENT); }
__device__ __forceinline__ unsigned xb_xcc_id() { return (unsigned)__builtin_amdgcn_s_getreg((3 << 11) | 20) & 0xFu; }
#define XB_SPIN(cond, bar) do { unsigned _sp = 0; while (cond) { __builtin_amdgcn_s_sleep(1); \
    if ((++_sp & 255u) == 0u) { if (xb_ld(&(bar)[XB_TMO])) break; if (_sp > XB_SPIN_CAP) { atomicAdd(&(bar)[XB_TMO], 1u); break; } } } } while (0)

struct XcdBarrier {
    unsigned* bar; unsigned x;
    volatile LAS unsigned* st;
};

__device__ __forceinline__ XcdBarrier xcd_barrier_post(unsigned* bar, volatile LAS unsigned* st) {
    XcdBarrier b; b.bar = bar; b.x = xb_xcc_id(); b.st = st;
    if (threadIdx.x == 0) (void)xb_add(&bar[XB_XCNT(b.x)], 1u);
    return b;
}
__device__ __forceinline__ void xcd_barrier_complete(unsigned* bar, unsigned x, unsigned& nloc, unsigned& nx) {
    const unsigned G = gridDim.x * gridDim.y * gridDim.z;
    unsigned sum, cnt, mine, sp = 0u;
    for (;;) {
        sum = 0u; cnt = 0u; mine = 0u;
#pragma unroll
        for (unsigned j = 0; j < 16; ++j) { const unsigned c = xb_ld(&bar[XB_XCNT(j)]); sum += c; cnt += (c > 0u) ? 1u : 0u; mine = (j == x) ? c : mine; }
        if (sum == G) break;
        __builtin_amdgcn_s_sleep(1);
        if ((++sp & 255u) == 0u) { if (xb_ld(&bar[XB_TMO])) break; if (sp > XB_SPIN_CAP) { atomicAdd(&bar[XB_TMO], 1u); break; } }
    }
    nloc = mine > 0u ? mine : 1u; nx = cnt > 0u ? cnt : 1u;
}

__device__ __forceinline__ void xcd_barrier(const XcdBarrier& b) {
    asm volatile("s_waitcnt vmcnt(0)" ::: "memory");
    __syncthreads();
    if (threadIdx.x == 0) {
        unsigned* bar = b.bar;
        __builtin_amdgcn_s_waitcnt(0);
        unsigned nloc = b.st[0], nx = b.st[1];
        if (nloc == 0u) { xcd_barrier_complete(bar, b.x, nloc, nx); b.st[0] = nloc; b.st[1] = nx; }
        const unsigned old = xb_add(&bar[XB_XSUB(b.x)], 1u);
        const unsigned gen = old / nloc;
        if (old + 1u == (gen + 1u) * nloc) {
            __builtin_amdgcn_fence(__ATOMIC_RELEASE, "agent");
            asm volatile("s_waitcnt vmcnt(0)" ::: "memory");
            const unsigned og = xb_add(&bar[XB_TOP], 1u);
            const unsigned tg = og / nx;
            if (og + 1u == (tg + 1u) * nx) xb_add(&bar[XB_TOPGEN], 1u);
            else XB_SPIN(xb_ld(&bar[XB_TOPGEN]) == tg, bar);
            __builtin_amdgcn_fence(__ATOMIC_ACQUIRE, "agent");
            xb_add(&bar[XB_XGEN(b.x)], 1u);
            asm volatile("s_waitcnt vmcnt(0)" ::: "memory");
        } else {
            XB_SPIN(xb_ld(&bar[XB_XGEN(b.x)]) == gen, bar);
            __builtin_amdgcn_fence(__ATOMIC_ACQUIRE, "agent");
            asm volatile("s_waitcnt vmcnt(0)" ::: "memory");
        }
    }
    __syncthreads();
}

#define DI __device__ __forceinline__
constexpr int NWAVES = 8;
constexpr int D = 2048, NB = 16, SEQ = 2048, CTXL = 256, DEPTH = 4;
constexpr int TLAT = NB * SEQ, TCTX = NB * CTXL, TT = TLAT + TCTX;
constexpr int FFN = 5632, NMODC = 6 * D;
constexpr int ATT_IN = 2560;
constexpr int SSD_DI = 4096, SSD_CONV = 6144, SSD_INP = 10496  , SSD_INS = 10368;
constexpr int HG_IN = 10240;
constexpr float RMS_EPS = 1e-6f, LOG2E = 1.4426950408889634f;
constexpr float QSCALE = 0.125f * LOG2E;
typedef float f32x16 __attribute__((ext_vector_type(16)));
typedef float f32x2v __attribute__((ext_vector_type(2)));
typedef unsigned u32x2 __attribute__((ext_vector_type(2)));
typedef short s16x4 __attribute__((ext_vector_type(4)));

constexpr size_t MiB = 1u << 20;
constexpr size_t WS_CTL = 0, CTL_ZERO_BYTES = 1 * MiB;
constexpr size_t WS_MODP = 1 * MiB;
constexpr size_t WS_MOD = 28 * MiB;
constexpr size_t WS_TAB = 32 * MiB;
constexpr size_t WS_H = 33 * MiB;
constexpr size_t WS_W = 65 * MiB;
constexpr size_t W_FFN_IN = (size_t)2 * FFN * D * 2, W_FFN_OUT = (size_t)D * FFN * 2;
constexpr size_t WS_WFFN = WS_W;
constexpr size_t W_ATT_IN = (size_t)ATT_IN * D * 2, W_ATT_OUT = (size_t)D * D * 2;
constexpr size_t WS_WATT = WS_WFFN + 4 * (W_FFN_IN + W_FFN_OUT);
constexpr size_t W_SSD_IN = (size_t)SSD_INP * D * 2, W_SSD_OUT = (size_t)D * SSD_DI * 2;
constexpr size_t WS_WSSD = WS_WATT + 2 * (W_ATT_IN + W_ATT_OUT);
constexpr size_t W_HG_IN = (size_t)HG_IN * D * 2, W_HG_OUT = (size_t)D * D * 2;
constexpr size_t WS_WHG = WS_WSSD + W_SSD_IN + W_SSD_OUT;
constexpr size_t WS_WEND = WS_WHG + W_HG_IN + W_HG_OUT;
constexpr size_t WS_U2 = 470 * MiB;
constexpr size_t WS_BIG = 758 * MiB;
constexpr size_t WS_END = 1496 * MiB;
static_assert(WS_WEND <= WS_U2, "weights fit");
constexpr size_t A_KB = WS_BIG;
constexpr size_t A_QB = A_KB + (size_t)TT * 256 * 2;
constexpr size_t A_VTL = A_QB + (size_t)TT * D * 2;
constexpr size_t A_VTC = A_VTL + (size_t)NB * 4 * 64 * SEQ * 2;
constexpr size_t A_O = A_VTC + (size_t)NB * 4 * 64 * CTXL * 2;
constexpr size_t A_Y = A_O + (size_t)TT * D * 2;
static_assert(A_Y + (size_t)TT * D * 4 <= WS_END, "attn map");
constexpr size_t S_XBC = WS_BIG;
constexpr size_t S_Z = S_XBC + (size_t)TT * SSD_CONV * 2;
constexpr size_t S_DT = S_Z + (size_t)TT * SSD_DI * 2;
static_assert(S_DT + (size_t)TT * 128 * 4 <= WS_END, "ssd map");
constexpr size_t H_LG = WS_BIG;
constexpr size_t H_V = H_LG + (size_t)2 * TT * D * 2;
constexpr size_t H_Q = H_V + (size_t)TT * D * 2;
constexpr size_t H_OG = H_Q + (size_t)TT * D * 2;
static_assert(H_OG + (size_t)TT * D * 2 <= WS_END, "hgrn map");
constexpr size_t F_H = WS_BIG;
constexpr size_t F_Y = F_H + (size_t)TT * FFN * 2;
static_assert(F_Y + (size_t)TT * D * 4 <= WS_END, "ffn map");
constexpr int CW_PCNT = 140032, CW_PDONE = 170000;
constexpr int CW_BAR = 4096;

constexpr int RING_BYTES = 131072;
constexpr int LDSCTL_OFF = RING_BYTES, MISC_OFF = LDSCTL_OFF + 320;
constexpr int LDS_BYTES = 163840;
constexpr int CONV_SCR_OFF = 135168, CONV_SCR_WAVE = 3584;

typedef __bf16 bf16x2_t __attribute__((ext_vector_type(2)));
DI unsigned cvtpk(float lo, float hi) { f32x2v v = {lo, hi}; bf16x2_t b = __builtin_convertvector(v, bf16x2_t); return __builtin_bit_cast(unsigned, b); }
DI int lane_id() { int l; asm volatile("v_mbcnt_lo_u32_b32 %0, -1, 0\n\tv_mbcnt_hi_u32_b32 %0, -1, %0" : "=v"(l)); return l; }
DI float bf2f(unsigned short b) { return __uint_as_float((unsigned)b << 16); }
DI float bflo(unsigned w) { return __uint_as_float(w << 16); }
DI float bfhi(unsigned w) { return __uint_as_float(w & 0xffff0000u); }
DI unsigned short f2bf16(float f) { return (unsigned short)(cvtpk(f, 0.f) & 0xffffu); }
DI unsigned pkh(float lo, float hi) { return (unsigned)__builtin_bit_cast(unsigned short, (_Float16)lo) | ((unsigned)__builtin_bit_cast(unsigned short, (_Float16)hi) << 16); }
DI float silu_f(float x) { return x * __builtin_amdgcn_rcpf(1.f + __builtin_amdgcn_exp2f(-x * LOG2E)); }
DI float wave_sum(float v) {
#pragma unroll
    for (int o = 1; o < 64; o <<= 1) v += __shfl_xor(v, o);
    return v;
}
DI int crow(int r, int h) { return (r & 3) + 8 * (r >> 2) + 4 * h; }
DI f32x16 mfma32(bf16x8 a, bf16x8 b, f32x16 c) { return __builtin_amdgcn_mfma_f32_32x32x16_bf16(a, b, c, 0, 0, 0); }
DI bf16x8 lds_frag(LAS unsigned char* p) { return *(LAS bf16x8*)p; }
DI float swap_max(float m) { auto rr = __builtin_amdgcn_permlane32_swap(__float_as_uint(m), __float_as_uint(m), false, false); return fmaxf(__uint_as_float(rr[0]), __uint_as_float(rr[1])); }
DI float swap_sum(float m) { auto rr = __builtin_amdgcn_permlane32_swap(__float_as_uint(m), __float_as_uint(m), false, false); return __uint_as_float(rr[0]) + __uint_as_float(rr[1]); }
DI bf16x8 pack8(const f32x16& x, int s) {
    v4u p; p.x = cvtpk(x[8 * s], x[8 * s + 1]); p.y = cvtpk(x[8 * s + 2], x[8 * s + 3]);
    p.z = cvtpk(x[8 * s + 4], x[8 * s + 5]); p.w = cvtpk(x[8 * s + 6], x[8 * s + 7]);
    return __builtin_bit_cast(bf16x8, p);
}

typedef short v4i16_t __attribute__((ext_vector_type(4)));
DI s16x4 tr16(LAS unsigned char* p) { return __builtin_bit_cast(s16x4, __builtin_amdgcn_ds_read_tr16_b64_v4i16((LAS v4i16_t*)p)); }
DI bf16x8 cat8(s16x4 lo, s16x4 hi) { return (bf16x8){lo[0], lo[1], lo[2], lo[3], hi[0], hi[1], hi[2], hi[3]}; }

using pg8::Unit; using pg8::HALF; using pg8::BM;
struct EpiF32 {
    static constexpr bool PERM = false, AFTER_DRAIN = false;
    float* C; int ldc;
    DI void operator()(const f32x4 (&acc)[2][2][4][2], const Unit& u, int wr, int wc, int fr, int fq) const {
        const int row0 = u.pm * BM + wr * 64 + fr, col0 = u.pn * BM + wc * 32 + 4 * fq;
#pragma unroll
        for (int ai = 0; ai < 2; ++ai)
#pragma unroll
            for (int m = 0; m < 4; ++m) { float* rowp = C + (size_t)(row0 + ai * HALF + m * 16) * ldc + col0;
#pragma unroll
                for (int bj = 0; bj < 2; ++bj)
#pragma unroll
                    for (int n = 0; n < 2; ++n) *(f32x4*)(rowp + bj * HALF + n * 16) = acc[ai][bj][m][n]; }
    }
};
struct EpiBf16Y {
    static constexpr bool PERM = true, AFTER_DRAIN = false;
    bf16* C;
    DI void operator()(const f32x4 (&acc)[2][2][4][2], const Unit& u, int wr, int wc, int fr, int fq) const {
        const int row0 = u.pm * BM + wr * 64 + fr, col0 = u.pn * BM + wc * 32 + 8 * fq;
#pragma unroll
        for (int ai = 0; ai < 2; ++ai)
#pragma unroll
            for (int m = 0; m < 4; ++m) { bf16* rowp = C + (size_t)(row0 + ai * HALF + m * 16) * D + col0;
#pragma unroll
                for (int bj = 0; bj < 2; ++bj) { const f32x4 v0 = acc[ai][bj][m][0], v1 = acc[ai][bj][m][1]; v4u w;
                    w.x = cvtpk(v0[0], v0[1]); w.y = cvtpk(v0[2], v0[3]); w.z = cvtpk(v1[0], v1[1]); w.w = cvtpk(v1[2], v1[3]);
                    *(v4u*)(rowp + bj * HALF) = w; }
                asm volatile("" ::: "memory"); }
    }
};
#ifndef NT_DEFER
#define NT_DEFER 0
#endif
#ifndef NT_WT
#define NT_WT 0
#endif
struct EpiBf16YWT {
    static constexpr bool PERM = true, AFTER_DRAIN = false;
    bf16* C;
    DI void operator()(const f32x4 (&acc)[2][2][4][2], const Unit& u, int wr, int wc, int fr, int fq) const {
        const int row0 = u.pm * BM + wr * 64 + fr, col0 = u.pn * BM + wc * 32 + 8 * fq;
#pragma unroll
        for (int ai = 0; ai < 2; ++ai)
#pragma unroll
            for (int m = 0; m < 4; ++m) { bf16* rowp = C + (size_t)(row0 + ai * HALF + m * 16) * D + col0;
#pragma unroll
                for (int bj = 0; bj < 2; ++bj) { const f32x4 v0 = acc[ai][bj][m][0], v1 = acc[ai][bj][m][1];
                    const unsigned long long lo = (unsigned long long)cvtpk(v0[0], v0[1]) | ((unsigned long long)cvtpk(v0[2], v0[3]) << 32), hi = (unsigned long long)cvtpk(v1[0], v1[1]) | ((unsigned long long)cvtpk(v1[2], v1[3]) << 32);
                    unsigned long long* q = (unsigned long long*)(rowp + bj * HALF);
                    if (NT_WT) { __hip_atomic_store(q, lo, __ATOMIC_RELAXED, __HIP_MEMORY_SCOPE_AGENT); __hip_atomic_store(q + 1, hi, __ATOMIC_RELAXED, __HIP_MEMORY_SCOPE_AGENT); }
                    else *(v4u*)q = (v4u){(unsigned)lo, (unsigned)(lo >> 32), (unsigned)hi, (unsigned)(hi >> 32)}; }
                asm volatile("" ::: "memory"); }
    }
};
struct CountOrder : pg8::StaticOrder {
    unsigned* cnt; mutable int prev = -1;
    DI bool next(int i, Unit& u) const {
        if (!pg8::StaticOrder::next(i, u)) return false;
        const int fm = u.pm & ~3, idx = (u.pm & 3) + 4 * u.pn;
        u.pm = fm + 2 * (idx >> 4) + (idx & 1); u.pn = (idx & 15) >> 1; return true;
    }
    int xcc;
    DI void publish(int pm) const { if (pm >= 0 && (threadIdx.x & 63) == 0) __hip_atomic_fetch_add(cnt + pm * 16 + xcc, 1u, __ATOMIC_RELAXED, __HIP_MEMORY_SCOPE_AGENT); }
    DI void done(const Unit& u) const { if (NT_DEFER) { publish(prev); prev = u.pm; } else { asm volatile("s_waitcnt vmcnt(0)" ::: "memory"); publish(u.pm); } }
    DI void flush() const { asm volatile("s_waitcnt vmcnt(0)" ::: "memory"); publish(prev); prev = -1; }
};
struct SplitTailOrder {
    int G, c, khalf, call;
    DI void init(int K, int G_, int c_, int call_) { G = G_; c = c_; khalf = K / 2; call = call_; }
    DI bool next(int i, Unit& u) const {
        constexpr int nN = D / BM, nwg = (TLAT / BM) * nN;
        const int L = i * G + c;
        if (call == 0) { if (L >= nwg) return false; const int q = nwg / 8, xcd = L % 8, off = L / 8, wgid = xcd * q + off, nig = 8 * nN;
            u.pm = (wgid / nig) * 8 + (wgid % nig) % 8; u.pn = (wgid % nig) / 8; u.koff = 0; return true; }
        if (L >= 256) return false;
        const int t = L >> 1; u.pm = TLAT / BM + (t >> 3); u.pn = t & 7; u.koff = (L & 1) * khalf; return true;
    }
    DI void a_ready(const Unit&) const {}
    DI void done(const Unit&) const {}
};
struct EpiYSplit {
    static constexpr bool PERM = true, AFTER_DRAIN = false;
    bf16* C; float* P; int split;
    DI void operator()(const f32x4 (&acc)[2][2][4][2], const Unit& u, int wr, int wc, int fr, int fq) const {
        const int row0 = u.pm * BM + wr * 64 + fr, col0 = u.pn * BM + wc * 32 + 8 * fq;
        if (!split) {
#pragma unroll
            for (int ai = 0; ai < 2; ++ai)
#pragma unroll
                for (int m = 0; m < 4; ++m) { bf16* rowp = C + (size_t)(row0 + ai * HALF + m * 16) * D + col0;
#pragma unroll
                    for (int bj = 0; bj < 2; ++bj) { const f32x4 v0 = acc[ai][bj][m][0], v1 = acc[ai][bj][m][1]; v4u w;
                        w.x = cvtpk(v0[0], v0[1]); w.y = cvtpk(v0[2], v0[3]); w.z = cvtpk(v1[0], v1[1]); w.w = cvtpk(v1[2], v1[3]);
                        *(v4u*)(rowp + bj * HALF) = w; }
                    asm volatile("" ::: "memory"); }
        } else {
            float* Pb = P + (u.koff ? (size_t)TCTX * D : 0);
#pragma unroll
            for (int ai = 0; ai < 2; ++ai)
#pragma unroll
                for (int m = 0; m < 4; ++m) { float* rowp = Pb + (size_t)(row0 - TLAT + ai * HALF + m * 16) * D + col0;
#pragma unroll
                    for (int bj = 0; bj < 2; ++bj) { *(f32x4*)(rowp + bj * HALF) = acc[ai][bj][m][0]; *(f32x4*)(rowp + bj * HALF + 4) = acc[ai][bj][m][1]; }
                    asm volatile("" ::: "memory"); }
        }
    }
};
struct EpiSwiglu {
    static constexpr bool PERM = true, AFTER_DRAIN = false;
    bf16* H;
    DI void operator()(const f32x4 (&acc)[2][2][4][2], const Unit& u, int wr, int wc, int fr, int fq) const {
        const int row0 = u.pm * BM + wr * 64 + fr, col0 = u.pn * 128 + wc * 32 + 8 * fq;
#pragma unroll
        for (int ai = 0; ai < 2; ++ai)
#pragma unroll
            for (int m = 0; m < 4; ++m) {
                float o[8];
#pragma unroll
                for (int n = 0; n < 2; ++n)
#pragma unroll
                    for (int j = 0; j < 4; ++j) o[4 * n + j] = silu_f(acc[ai][0][m][n][j]) * acc[ai][1][m][n][j];
                v4u w; w.x = cvtpk(o[0], o[1]); w.y = cvtpk(o[2], o[3]); w.z = cvtpk(o[4], o[5]); w.w = cvtpk(o[6], o[7]);
                *(v4u*)(H + (size_t)(row0 + ai * HALF + m * 16) * FFN + col0) = w; }
    }
};
struct EpiAttn {
    static constexpr bool PERM = false, AFTER_DRAIN = false;
    bf16* Kb; bf16* Qb; bf16* VtL; bf16* VtC; const float* rope;
    DI void operator()(const f32x4 (&acc)[2][2][4][2], const Unit& u, int wr, int wc, int fr, int fq) const {
        const int pn = u.pn;
#pragma unroll
        for (int ai = 0; ai < 2; ++ai)
#pragma unroll
            for (int m = 0; m < 4; ++m) {
                const int row = u.pm * BM + ai * HALF + wr * 64 + m * 16 + fr;
                const bool lat = u.pm < TLAT / BM; const int s = row & 2047;
                if (pn == 1) {
                    bf16* base; size_t pitch;
                    if (lat) { base = VtL + (size_t)(row >> 11) * (4 * 64 * SEQ) + s; pitch = SEQ; }
                    else { const int rc = row - TLAT; base = VtC + (size_t)(rc >> 8) * (4 * 64 * CTXL) + (rc & 255); pitch = CTXL; }
#pragma unroll
                    for (int bj = 0; bj < 2; ++bj)
#pragma unroll
                        for (int n = 0; n < 2; ++n)
#pragma unroll
                            for (int j = 0; j < 4; ++j) { const int col = 128 * bj + 32 * wc + 16 * n + 4 * fq + j; base[(size_t)col * pitch] = f2bf16(acc[ai][bj][m][n][j]); }
                } else {
                    const int pos = (wc & 1) ? (s & 63) : (s >> 6);
                    const f32x4* rp = (const f32x4*)(rope + (pos * 16 + 4 * fq) * 2);
                    const f32x4 c01 = rp[0], c23 = rp[1];
                    const float cs[4] = {c01[0], c01[2], c23[0], c23[2]}, sn[4] = {c01[1], c01[3], c23[1], c23[3]};
#pragma unroll
                    for (int bj = 0; bj < 2; ++bj) {
                        const f32x4 t1 = acc[ai][bj][m][0], t2 = acc[ai][bj][m][1]; float o1[4], o2[4];
#pragma unroll
                        for (int j = 0; j < 4; ++j) { o1[j] = lat ? t1[j] * cs[j] - t2[j] * sn[j] : t1[j]; o2[j] = lat ? t2[j] * cs[j] + t1[j] * sn[j] : t2[j]; }
                        bf16* dst; float sc;
                        if (pn == 0) { dst = Kb + (size_t)row * 256 + 128 * bj + 32 * wc + 4 * fq; sc = 1.f; }
                        else { dst = Qb + (size_t)row * D + (pn - 2) * 256 + 128 * bj + 32 * wc + 4 * fq; sc = QSCALE; }
                        u32x2 w1, w2; w1.x = cvtpk(o1[0] * sc, o1[1] * sc); w1.y = cvtpk(o1[2] * sc, o1[3] * sc);
                        w2.x = cvtpk(o2[0] * sc, o2[1] * sc); w2.y = cvtpk(o2[2] * sc, o2[3] * sc);
                        *(u32x2*)dst = w1; *(u32x2*)(dst + 16) = w2;
                    }
                }
                asm volatile("" ::: "memory");
            }
    }
};
struct EpiSsd {
    static constexpr bool PERM = true, AFTER_DRAIN = false;
    bf16* XBC; bf16* Z; float* DT; const float* dt_bias; bf16* HB;
    DI void operator()(const f32x4 (&acc)[2][2][4][2], const Unit& u, int wr, int wc, int fr, int fq) const {
        const int pn = u.pn, row0 = u.pm * BM + wr * 64 + fr, cl = wc * 32 + 8 * fq;
        if (pn < 40) {
            bf16* base; int ldc;
            if (pn < 24) { base = XBC + pn * 256; ldc = SSD_CONV; } else { base = Z + (pn - 24) * 256; ldc = SSD_DI; }
#pragma unroll
            for (int ai = 0; ai < 2; ++ai)
#pragma unroll
                for (int m = 0; m < 4; ++m) { bf16* rowp = base + (size_t)(row0 + ai * HALF + m * 16) * ldc + cl;
#pragma unroll
                    for (int bj = 0; bj < 2; ++bj) { const f32x4 v0 = acc[ai][bj][m][0], v1 = acc[ai][bj][m][1]; v4u w;
                        w.x = cvtpk(v0[0], v0[1]); w.y = cvtpk(v0[2], v0[3]); w.z = cvtpk(v1[0], v1[1]); w.w = cvtpk(v1[2], v1[3]);
                        *(v4u*)(rowp + bj * HALF) = w;
                        const int rr = (row0 + ai * HALF + m * 16) & 255;
                        if (pn < 24 && (rr == 0 || rr == 255)) *(v4u*)(HB + (size_t)(2 * u.pm + (rr & 1)) * SSD_CONV + pn * 256 + cl + bj * HALF) = w; }
                    asm volatile("" ::: "memory"); }
        } else {
            const f32x4 b0 = *(const f32x4*)(dt_bias + cl), b1 = *(const f32x4*)(dt_bias + cl + 4);
#pragma unroll
            for (int ai = 0; ai < 2; ++ai)
#pragma unroll
                for (int m = 0; m < 4; ++m) { float* rowp = DT + (size_t)(row0 + ai * HALF + m * 16) * 128 + cl;
#pragma unroll
                    for (int n = 0; n < 2; ++n) { f32x4 v = acc[ai][0][m][n] + (n ? b1 : b0), o;
#pragma unroll
                        for (int j = 0; j < 4; ++j) { const float x = v[j]; o[j] = fmaxf(x, 0.f) + log1pf(__expf(-fabsf(x))); }
                        *(f32x4*)(rowp + 4 * n) = o; }
                    asm volatile("" ::: "memory"); }
        }
    }
};
struct EpiHgrn {
    static constexpr bool PERM = true, AFTER_DRAIN = false;
    _Float16* LG; bf16* VQG; const float* lbv;
    DI void operator()(const f32x4 (&acc)[2][2][4][2], const Unit& u, int wr, int wc, int fr, int fq) const {
        const int pn = u.pn, row0 = u.pm * BM + wr * 64 + fr, cl = wc * 32 + 8 * fq;
        if (pn < 16) {
            const int dir = pn >> 3, cb = (pn & 7) * 256;
#pragma unroll
            for (int bj = 0; bj < 2; ++bj) {
                const f32x4 l0 = *(const f32x4*)(lbv + dir * D + cb + bj * HALF + cl), l1 = *(const f32x4*)(lbv + dir * D + cb + bj * HALF + cl + 4);
#pragma unroll
                for (int ai = 0; ai < 2; ++ai)
#pragma unroll
                    for (int m = 0; m < 4; ++m) { float o[8];
#pragma unroll
                        for (int n = 0; n < 2; ++n)
#pragma unroll
                            for (int j = 0; j < 4; ++j) { const float f = acc[ai][bj][m][n][j], lb = n ? l1[j] : l0[j];
                                const float e = __builtin_amdgcn_exp2f(-f * LOG2E);
                                o[4 * n + j] = (1.f - lb) * e * __builtin_amdgcn_rcpf(1.f + e); }
                        v4u w; w.x = pkh(o[0], o[1]); w.y = pkh(o[2], o[3]); w.z = pkh(o[4], o[5]); w.w = pkh(o[6], o[7]);
                        *(v4u*)(LG + ((size_t)dir * TT + row0 + ai * HALF + m * 16) * D + cb + bj * HALF + cl) = w;
                        asm volatile("" ::: "memory"); }
            }
        } else {
            const int t = (pn - 16) >> 3, cb = (pn & 7) * 256; bf16* base = VQG + (size_t)t * TT * D + cb;
#pragma unroll
            for (int ai = 0; ai < 2; ++ai)
#pragma unroll
                for (int m = 0; m < 4; ++m) { bf16* rowp = base + (size_t)(row0 + ai * HALF + m * 16) * D + cl;
#pragma unroll
                    for (int bj = 0; bj < 2; ++bj) { f32x4 v0 = acc[ai][bj][m][0], v1 = acc[ai][bj][m][1];
                        if (t == 1) {
#pragma unroll
                            for (int j = 0; j < 4; ++j) { v0[j] = silu_f(v0[j]); v1[j] = silu_f(v1[j]); } }
                        v4u w; w.x = cvtpk(v0[0], v0[1]); w.y = cvtpk(v0[2], v0[3]); w.z = cvtpk(v1[0], v1[1]); w.w = cvtpk(v1[2], v1[3]);
                        *(v4u*)(rowp + bj * HALF) = w; }
                    asm volatile("" ::: "memory"); }
        }
    }
};

struct Frame {
    LAS unsigned char* lds;
    volatile LAS unsigned* MISC;
    gu32* ctl;
    int wave, G, gw, NGW;
};

DI void mod_partial_phase(const Frame& F, const float* c, const float* cctx, const float* ada_w, float* modp) {
    const int lane = lane_id();
    for (int it = F.gw; it < 4 * 48 * 8; it += F.NGW) {
        const int cb = it % 48, ks = (it / 48) & 7, l = it / (8 * 48);
        f32x4 acc[17];
#pragma unroll
        for (int b = 0; b < 17; ++b) acc[b] = (f32x4){0.f, 0.f, 0.f, 0.f};
        const float* W = ada_w + (size_t)l * D * NMODC + cb * 256 + lane * 4;
        for (int kb = 0; kb < 4; ++kb) {
            const int k0 = ks * 256 + kb * 64;
            float sv[17];
#pragma unroll
            for (int b = 0; b < 16; ++b) { const float x = c[b * D + k0 + lane]; sv[b] = x / (1.f + __expf(-x)); }
            { const float x = cctx[k0 + lane]; sv[16] = x / (1.f + __expf(-x)); }
            for (int jj = 0; jj < 64; jj += 8) {
                f32x4 w[8];
#pragma unroll
                for (int q = 0; q < 8; ++q) w[q] = *(const f32x4*)(W + (size_t)(k0 + jj + q) * NMODC);
#pragma unroll
                for (int q = 0; q < 8; ++q)
#pragma unroll
                    for (int b = 0; b < 17; ++b) { const float s = __int_as_float(__builtin_amdgcn_readlane(__float_as_int(sv[b]), jj + q)); acc[b] += w[q] * s; }
            }
        }
#pragma unroll
        for (int b = 0; b < 17; ++b) *(f32x4*)(modp + (((size_t)ks * 4 + l) * 17 + b) * NMODC + cb * 256 + lane * 4) = acc[b];
    }
}

DI int srcmap(int kind, int n) {
    if (kind == 0) return n;
    if (kind == 1) { const int t = n >> 8, w = n & 255; return w < 128 ? 128 * t + w : FFN + 128 * t + (w - 128); }
    if (n < SSD_CONV) return n;
    if (n < SSD_CONV + SSD_DI) return n + 128;
    if (n < SSD_INS) return n - SSD_DI;
    return -1;
}
struct ConvItem { const float* src; bf16* dst; int Nsrc, K; };
DI ConvItem conv_decode(const float* W, int K, int Nsrc, int Ndst, bf16* WT, int kind, int item) {
    const int nblk = Ndst / 32, kb = item / nblk, nb = item % nblk, k0 = 64 * kb, n0 = 32 * nb, s0 = srcmap(kind, n0);
    return ConvItem{s0 >= 0 ? W + (size_t)k0 * Nsrc + s0 : nullptr, WT + (size_t)n0 * K + k0, Nsrc, K};
}
DI void conv_load(const ConvItem& c, f32x4 (&v)[8], int lane) {
    const float* src = c.src + (size_t)(lane >> 3) * c.Nsrc + 4 * (lane & 7);
#pragma unroll
    for (int i = 0; i < 8; ++i) v[i] = c.src ? *(const f32x4*)(src + (size_t)(8 * i) * c.Nsrc) : (f32x4){0.f, 0.f, 0.f, 0.f};
}
DI void conv_finish(const ConvItem& c, const f32x4 (&v)[8], LAS unsigned char* scr, int lane) {
    const int r32 = lane & 31, h = lane >> 5, q4 = (lane & 15) >> 2, p4 = lane & 3, blk = (lane >> 4) & 1;
    bf16* dst = c.dst + (size_t)r32 * c.K + 8 * h;
#pragma unroll
    for (int half = 0; half < 2; ++half) {
#pragma unroll
        for (int i = 0; i < 4; ++i) *(LAS u32x2*)(scr + (8 * i + (lane >> 3)) * 80 + 8 * (lane & 7)) = (u32x2){cvtpk(v[4 * half + i][0], v[4 * half + i][1]), cvtpk(v[4 * half + i][2], v[4 * half + i][3])};
        LDS_WAIT(); asm volatile("" ::: "memory");
#pragma unroll
        for (int cc = 0; cc < 2; ++cc) { LAS unsigned char* p = scr + (16 * cc + 8 * h + q4) * 80 + (16 * blk + 4 * p4) * 2;
            const bf16x8 o = cat8(tr16(p), tr16(p + 4 * 80)); *(GAS bf16x8*)(dst + 16 * (2 * half + cc)) = o; }
        LDS_WAIT(); asm volatile("" ::: "memory");
    }
}
DI ConvItem conv16_decode(const float* W, int K, int Nsrc, int Ndst, bf16* WT, int kind, int item) {
    const int nblk = Ndst / 16, kb = item / nblk, nb = item % nblk, k0 = 64 * kb, n0 = 16 * nb, s0 = srcmap(kind, n0);
    return ConvItem{s0 >= 0 ? W + (size_t)k0 * Nsrc + s0 : nullptr, WT + (size_t)n0 * K + k0, Nsrc, K};
}
DI void conv16_load(const ConvItem& c, f32x4 (&v)[4], int lane) {
    const float* src = c.src + (size_t)(lane >> 2) * c.Nsrc + 4 * (lane & 3);
#pragma unroll
    for (int i = 0; i < 4; ++i) v[i] = c.src ? *(const f32x4*)(src + (size_t)(16 * i) * c.Nsrc) : (f32x4){0.f, 0.f, 0.f, 0.f};
}
DI void conv16_finish(bf16* dst0, int K, const f32x4 (&v)[4], LAS unsigned char* scr, int lane) {
#pragma unroll
    for (int i = 0; i < 4; ++i) *(LAS u32x2*)(scr + (16 * i + (lane >> 2)) * 40 + 8 * (lane & 3)) = (u32x2){cvtpk(v[i][0], v[i][1]), cvtpk(v[i][2], v[i][3])};
    LDS_WAIT(); asm volatile("" ::: "memory");
    const int n = lane & 15, kq = lane >> 4, q4 = (lane & 15) >> 2, p4 = lane & 3;
    bf16* dst = dst0 + (size_t)n * K + 8 * kq;
#pragma unroll
    for (int cc = 0; cc < 2; ++cc) { LAS unsigned char* p = scr + (32 * cc + 8 * kq + q4) * 40 + 8 * p4;
        const bf16x8 o = cat8(tr16(p), tr16(p + 4 * 40)); *(GAS bf16x8*)(dst + 32 * cc) = o; }
    LDS_WAIT(); asm volatile("" ::: "memory");
}
template <int OFF> DI const float* inp_load() { const GAS float* p; asm volatile("s_load_dwordx2 %0, %1, %2\n\ts_waitcnt lgkmcnt(0)" : "=s"(p) : "s"(__builtin_amdgcn_kernarg_segment_ptr()), "n"(OFF)); return (const float*)p; }
#define INP(k) inp_load<(k) * 8>()

constexpr int I_FI = (D / 64) * (2 * FFN / 32), I_FO = (FFN / 64) * (D / 32), I_AI = (D / 64) * (ATT_IN / 32), I_AO = (D / 64) * (D / 32);
constexpr int I_SI = (D / 64) * (SSD_INP / 32), I_SO = (SSD_DI / 64) * (D / 32), I_HI = (D / 64) * (HG_IN / 32), I_HO = I_AO;
template <bool N16> DI int conv_group_items(int l) { if (N16) return 2 * conv_group_items<false>(l); const int k = l % 3; return I_FI + I_FO + (k == 0 ? I_AI + I_AO : (k == 1 ? I_SI + I_SO : I_HI + I_HO)); }
template <bool N16> DI ConvItem conv_group_decode(unsigned char* ws, int l, int r) {
    constexpr int S = N16 ? 2 : 1;
#define CDEC(...) (N16 ? conv16_decode(__VA_ARGS__) : conv_decode(__VA_ARGS__))
    bf16* wf = (bf16*)(ws + WS_WFFN + (size_t)l * (W_FFN_IN + W_FFN_OUT));
    if (r < S * I_FI) return CDEC(INP(7) + (size_t)l * D * 2 * FFN, D, 2 * FFN, 2 * FFN, wf, 1, r);
    r -= S * I_FI;
    if (r < S * I_FO) return CDEC(INP(8) + (size_t)l * FFN * D, FFN, D, D, (bf16*)((unsigned char*)wf + W_FFN_IN), 0, r);
    r -= S * I_FO;
    const int k = l % 3, j = l / 3;
    if (k == 0) { bf16* wb = (bf16*)(ws + WS_WATT + (size_t)j * (W_ATT_IN + W_ATT_OUT));
        if (r < S * I_AI) return CDEC(INP(9) + (size_t)j * D * ATT_IN, D, ATT_IN, ATT_IN, wb, 0, r);
        return CDEC(INP(10) + (size_t)j * D * D, D, D, D, (bf16*)((unsigned char*)wb + W_ATT_IN), 0, r - S * I_AI); }
    if (k == 1) {
        if (r < S * I_SI) return CDEC(INP(12), D, SSD_INS, SSD_INP, (bf16*)(ws + WS_WSSD), 2, r);
        return CDEC(INP(19), SSD_DI, D, D, (bf16*)(ws + WS_WSSD + W_SSD_IN), 0, r - S * I_SI); }
    if (r < S * I_HI) return CDEC(INP(20), D, HG_IN, HG_IN, (bf16*)(ws + WS_WHG), 0, r);
    return CDEC(INP(23), D, D, D, (bf16*)(ws + WS_WHG + W_HG_IN), 0, r - S * I_HI);
#undef CDEC
}
#ifndef BG_CONV
#define BG_CONV 1
#endif
#ifndef BG_SSD
#define BG_SSD 4
#endif
#ifndef BG_HG
#define BG_HG 1
#endif
#ifndef BG_ATT
#define BG_ATT 1
#endif
struct BgConv {
    int l, it;
    DI static unsigned char* wsp() { return (unsigned char*)inp_load<200>(); }
    DI static int wave() { return __builtin_amdgcn_readfirstlane((int)threadIdx.x >> 6); }
    DI static LAS unsigned char* scrp() { extern __shared__ __attribute__((aligned(16))) unsigned char lds_raw[]; return (LAS unsigned char*)lds_raw + CONV_SCR_OFF + wave() * CONV_SCR_WAVE; }
    DI int end() const { return (BG_CONV && l < DEPTH) ? conv_group_items<true>(l) : 0; }
    DI void init(int layer) { l = layer; it = (int)blockIdx.x * NWAVES + wave(); }
    DI void tail() {}
    struct Tok { f32x4 v[4]; };
    DI Tok pre() { Tok t; if (it < end()) { const ConvItem c = conv_group_decode<true>(wsp(), l, it); conv16_load(c, t.v, lane_id()); } return t; }
    DI void post(const Tok& t) { if (it < end()) { const ConvItem c = conv_group_decode<true>(wsp(), l, it); conv16_finish(c.dst, c.K, t.v, scrp(), lane_id()); it += (int)gridDim.x * NWAVES; } }
    DI void drain() {
        unsigned char* ws = wsp(); LAS unsigned char* scr = scrp(); const int step = (int)gridDim.x * NWAVES, e = end();
        while (it < e) {
            const int lane = lane_id();
            const ConvItem c0 = conv_group_decode<true>(ws, l, it); f32x4 v0[4]; conv16_load(c0, v0, lane);
            const int it1 = it + step;
            if (it1 < e) { const ConvItem c1 = conv_group_decode<true>(ws, l, it1); f32x4 v1[4]; conv16_load(c1, v1, lane);
                conv16_finish(c0.dst, c0.K, v0, scr, lane); conv16_finish(c1.dst, c1.K, v1, scr, lane); }
            else conv16_finish(c0.dst, c0.K, v0, scr, lane);
            it += 2 * step;
        }
    }
};
DI void prologue_phase(const Frame& F, unsigned char* ws) {
    LAS unsigned char* scr = F.lds + CONV_SCR_OFF + F.wave * CONV_SCR_WAVE;
    const int lane = lane_id(); const int gt = F.gw * 64 + lane, NGT = F.NGW * 64;
    { const float* modp = (const float*)(ws + WS_MODP); float* mod = (float*)(ws + WS_MOD); const float* ada_b = INP(5);
      for (int i = gt; i < 4 * 17 * NMODC / 4; i += NGT) {
          const int e = i * 4, l = e / (17 * NMODC), n = e % NMODC;
          f32x4 s = *(const f32x4*)(ada_b + l * NMODC + n);
#pragma unroll
          for (int ks = 0; ks < 8; ++ks) s += *(const f32x4*)(modp + (size_t)ks * 4 * 17 * NMODC + e);
          *(f32x4*)(mod + e) = s; } }
    { float* tab = (float*)(ws + WS_TAB);
      if (gt < 1024) { const int pos = gt >> 4, p = gt & 15; const float invf = powf(10000.f, -(float)p / 16.f); const float ang = (float)pos * invf; tab[2 * gt] = cosf(ang); tab[2 * gt + 1] = sinf(ang); }
      float* lbv = (float*)(ws + WS_TAB + 16384); const float* lbr = INP(21);
      if (gt < 2 * D) { const int dir = gt >> 11, d = gt & 2047; float v[4], mx = -1e30f;
#pragma unroll
          for (int l = 0; l < 4; ++l) { v[l] = lbr[(dir * 4 + l) * D + d]; mx = fmaxf(mx, v[l]); }
          float e[4], sum = 0.f;
#pragma unroll
          for (int l = 0; l < 4; ++l) { e[l] = expf(v[l] - mx); sum += e[l]; }
          lbv[gt] = (e[1] + e[2]) / sum; } }
    for (int l = 0; l < (BG_CONV ? (BG_ATT ? 1 : 2) : DEPTH); ++l) {
        const int NIT = conv_group_items<false>(l);
        if (F.gw < NIT) {
            ConvItem cur = conv_group_decode<false>(ws, l, F.gw); f32x4 v[8]; conv_load(cur, v, lane);
            for (int it = F.gw; it < NIT; it += F.NGW) {
                const int nit = it + F.NGW; ConvItem nxt = cur; f32x4 vn[8];
                if (nit < NIT) { nxt = conv_group_decode<false>(ws, l, nit); conv_load(nxt, vn, lane); }
                conv_finish(cur, v, scr, lane);
                cur = nxt;
#pragma unroll
                for (int i = 0; i < 8; ++i) v[i] = vn[i];
            }
        }
    }
}

template <int MODE, bool YSC1 = false, bool NTS = false>
DI void norm_range(int wbeg, int wend, int nrows, const bf16* y, const float* ysplit, const float* xin_lat, const float* xin_ctx, bf16* xb_lat, bf16* xb_ctx, bf16* xd_lat, float* out_f32,
                   const float* mod_a, int gate_idx, const float* gpost, const float* mod_b, int shift_idx, const float* gpre, bf16* u) {
    constexpr bool HAS_Y = MODE != 0, HAS_U = MODE != 2;
    const int lane = lane_id();
    unsigned vo2 = (unsigned)lane * 16u, vo4 = (unsigned)lane * 32u;
#define NP_B16(p, m) (*(const v4u*)((const unsigned char*)(p) + vo2 + 1024 * (m)))
#define NP_Y16(p, m) (YSC1 ? ({ const unsigned long long* q_ = (const unsigned long long*)((const unsigned char*)(p) + vo2 + 1024 * (m)); const unsigned long long a_ = __hip_atomic_load(q_, __ATOMIC_RELAXED, __HIP_MEMORY_SCOPE_AGENT), b_ = __hip_atomic_load(q_ + 1, __ATOMIC_RELAXED, __HIP_MEMORY_SCOPE_AGENT); (v4u){(unsigned)a_, (unsigned)(a_ >> 32), (unsigned)b_, (unsigned)(b_ >> 32)}; }) : NP_B16(p, m))
#define NP_B(p, k) (*(const u32x2*)((const unsigned char*)(p) + vo2 + 1024 * ((k) >> 1) + 8 * ((k) & 1)))
#define NP_F(p, k) (*(const f32x4*)((const unsigned char*)(p) + vo4 + 2048 * ((k) >> 1) + 16 * ((k) & 1)))
    for (int r0 = wbeg; r0 < wend;) {
        const int mb = r0 < TLAT ? (r0 >> 11) : 16; const bool lat = r0 < TLAT;
        const int bend = lat ? ((r0 >> 11) + 1) << 11 : nrows, rend = wend < bend ? wend : bend, nr = rend - r0;
        asm volatile("" : "+v"(vo2), "+v"(vo4));
        f32x4 GG[8], AA[8], SH[8];
        { const float* ga = HAS_Y ? mod_a + (size_t)mb * NMODC + gate_idx * D : nullptr; const float* sc = HAS_U ? mod_b + (size_t)mb * NMODC + (shift_idx + 1) * D : nullptr;
          const float* sh = HAS_U ? mod_b + (size_t)mb * NMODC + shift_idx * D : nullptr;
#pragma unroll
          for (int k = 0; k < 8; ++k) {
              if (HAS_Y) GG[k] = NP_F(ga, k) * NP_F(gpost, k);
              if (HAS_U) { AA[k] = NP_F(gpre, k) * (NP_F(sc, k) + 1.f); SH[k] = NP_F(sh, k); } } }
        const size_t rl = lat ? (size_t)r0 : (size_t)(r0 - TLAT);
        bf16* xb = (lat ? xb_lat : xb_ctx) + rl * D;
        bf16* xw = (lat ? xd_lat : xb_ctx) + rl * D;
        const float* xin = MODE == 0 ? (lat ? xin_lat : xin_ctx) + rl * D : nullptr;
        const bf16* yp = HAS_Y ? y + (size_t)r0 * D : nullptr;
        f32x4 xf[8]; u32x2 xr[8], yr[8];
        const float* ysp = (HAS_Y && ysplit && !lat) ? ysplit + rl * D : nullptr;
#define NP_Y(rowoff, k) (ysp ? ({ const f32x4 s_ = NP_F(ysp + (size_t)(rowoff) * D, k) + NP_F(ysp + (size_t)TCTX * D + (size_t)(rowoff) * D, k); (u32x2){cvtpk(s_[0], s_[1]), cvtpk(s_[2], s_[3])}; }) : NP_B(yp + (size_t)(rowoff) * D, k))
#pragma unroll
        for (int k = 0; k < 8; ++k) { if (MODE == 0) xf[k] = NP_F(xin, k); if (HAS_Y && ysp) yr[k] = NP_Y(0, k); }
#pragma unroll
        for (int m = 0; m < 4; ++m) { if (MODE != 0) { const v4u t = NTS ? __builtin_nontemporal_load((const v4u*)((const unsigned char*)(xb) + vo2 + 1024 * (m))) : NP_B16(xb, m); xr[2 * m] = (u32x2){t.x, t.y}; xr[2 * m + 1] = (u32x2){t.z, t.w}; }
            if (HAS_Y && !ysp) { const v4u t = NP_Y16(yp, m); yr[2 * m] = (u32x2){t.x, t.y}; yr[2 * m + 1] = (u32x2){t.z, t.w}; } }
        for (int rr = 0; rr < nr; ++rr) {
            asm volatile("" : "+v"(vo2), "+v"(vo4));
            f32x4 x[8]; u32x2 yc[8];
#pragma unroll
            for (int k = 0; k < 8; ++k) { x[k] = MODE == 0 ? xf[k] : (f32x4){bflo(xr[k].x), bfhi(xr[k].x), bflo(xr[k].y), bfhi(xr[k].y)};
                if (HAS_Y) yc[k] = yr[k]; }
            if (rr + 1 < nr) {
#pragma unroll
                for (int k = 0; k < 8; ++k) { if (MODE == 0) xf[k] = NP_F(xin + (size_t)(rr + 1) * D, k); if (HAS_Y && ysp) yr[k] = NP_Y(rr + 1, k); }
#pragma unroll
                for (int m = 0; m < 4; ++m) { if (MODE != 0) { const v4u t = NTS ? __builtin_nontemporal_load((const v4u*)((const unsigned char*)(xb + (size_t)(rr + 1) * D) + vo2 + 1024 * (m))) : NP_B16(xb + (size_t)(rr + 1) * D, m); xr[2 * m] = (u32x2){t.x, t.y}; xr[2 * m + 1] = (u32x2){t.z, t.w}; }
                    if (HAS_Y && !ysp) { const v4u t = NP_Y16(yp + (size_t)(rr + 1) * D, m); yr[2 * m] = (u32x2){t.x, t.y}; yr[2 * m + 1] = (u32x2){t.z, t.w}; } } }
            if (HAS_Y) {
                float ss = 0.f;
#pragma unroll
                for (int k = 0; k < 8; ++k) { const float a0 = bflo(yc[k].x), a1 = bfhi(yc[k].x), a2 = bflo(yc[k].y), a3 = bfhi(yc[k].y); ss += (a0 * a0 + a1 * a1) + (a2 * a2 + a3 * a3); }
                const float rs = 1.f / sqrtf(wave_sum(ss) * (1.f / D) + RMS_EPS);
#pragma unroll
                for (int k = 0; k < 8; ++k) x[k] += GG[k] * (f32x4){bflo(yc[k].x), bfhi(yc[k].x), bflo(yc[k].y), bfhi(yc[k].y)} * rs;
            }
            if (MODE == 2) { float* od = out_f32 + (size_t)(r0 + rr) * D;
#pragma unroll
                for (int k = 0; k < 8; ++k) *(f32x4*)((unsigned char*)od + vo4 + 2048 * (k >> 1) + 16 * (k & 1)) = x[k];
            } else {
#pragma unroll
                for (int m = 0; m < 4; ++m) { const f32x4 xa = x[2 * m], xc = x[2 * m + 1]; const v4u xv_ = (v4u){cvtpk(xa[0], xa[1]), cvtpk(xa[2], xa[3]), cvtpk(xc[0], xc[1]), cvtpk(xc[2], xc[3])}; v4u* xq_ = (v4u*)((unsigned char*)(xw + (size_t)rr * D) + vo2 + 1024 * m); if (NTS) __builtin_nontemporal_store(xv_, xq_); else *xq_ = xv_; }
            }
            if (HAS_U) {
                float ss = 0.f;
#pragma unroll
                for (int k = 0; k < 8; ++k) ss += (x[k][0] * x[k][0] + x[k][1] * x[k][1]) + (x[k][2] * x[k][2] + x[k][3] * x[k][3]);
                const float rs = 1.f / sqrtf(wave_sum(ss) * (1.f / D) + RMS_EPS);
                bf16* up = u + (size_t)(r0 + rr) * D;
#pragma unroll
                for (int m = 0; m < 4; ++m) { const f32x4 oa = x[2 * m] * rs * AA[2 * m] + SH[2 * m], oc = x[2 * m + 1] * rs * AA[2 * m + 1] + SH[2 * m + 1];
                    const v4u uv_ = (v4u){cvtpk(oa[0], oa[1]), cvtpk(oa[2], oa[3]), cvtpk(oc[0], oc[1]), cvtpk(oc[2], oc[3])}; v4u* uq_ = (v4u*)((unsigned char*)up + vo2 + 1024 * m); if (NTS) __builtin_nontemporal_store(uv_, uq_); else *uq_ = uv_; }
            }
        }
        r0 = rend;
    }
#undef NP_B
#undef NP_B16
#undef NP_F
#undef NP_Y
#undef NP_Y16
}
template <int MODE>
DI void norm_phase(const Frame& F, int nrows, const bf16* y, const float* ysplit, const float* xin_lat, const float* xin_ctx, bf16* xb_lat, bf16* xb_ctx, bf16* xd_lat, float* out_f32,
                   const float* mod_a, int gate_idx, const float* gpost, const float* mod_b, int shift_idx, const float* gpre, bf16* u) {
    const int per = (nrows + F.NGW - 1) / F.NGW, wbeg = F.gw * per < nrows ? F.gw * per : nrows, wend = wbeg + per < nrows ? wbeg + per : nrows;
    norm_range<MODE>(wbeg, wend, nrows, y, ysplit, xin_lat, xin_ctx, xb_lat, xb_ctx, xd_lat, out_f32, mod_a, gate_idx, gpost, mod_b, shift_idx, gpre, u);
}

#ifndef NT_ON
#define NT_ON 1
#endif
#ifndef NT_TAIL
#define NT_TAIL 1
#endif
#ifndef NT_STREAM
#define NT_STREAM 1
#endif
#ifndef NT_N2_WHOLE
#define NT_N2_WHOLE 1
#endif
#ifndef NT_N2
#define NT_N2 3
#endif
static_assert(D / 256 == 8 && pg8::WGM == 4 && ((TT / 256) * (D / 256)) % (16 * pg8::NXCD) == 0, "CountOrder's 16-tile runs");
constexpr int NT_NWG = (TT / 256) * (D / 256), NT_Q = NT_NWG / pg8::NXCD, NT_LAST = (NT_NWG % 256) / pg8::NXCD, NT_SPIN = 800;
DI bool panel_late(int pm) {
    const int g = pm / pg8::WGM; bool late = false;
#pragma unroll
    for (int x = 0; x < pg8::NXCD; ++x) { const int lo = (x * NT_Q + NT_Q - NT_LAST) / (pg8::WGM * (D / 256)), hi = (x * NT_Q + NT_Q - 1) / (pg8::WGM * (D / 256)); late |= (NT_LAST > 0) && g >= lo && g <= hi; }
    return late;
}
template <int WHICH>
struct NormTail {
    int l, idle, k;
    const CountOrder* sc;
    struct Tok {}; DI Tok pre() { return Tok{}; } DI void post(const Tok&) {}
    DI void tail() {
        if (NT_DEFER) sc->flush();
        if (!idle) return;
        const int xa = (int)blockIdx.x % pg8::NXCD, j = k / pg8::NXCD;
        const int pm = 2 * (xa * NT_Q / 16) + j;
        if (j >= 2 * ((NT_Q - NT_LAST) / 16) || pm >= TT / 256) return;
        unsigned char* ws = BgConv::wsp(); unsigned* ctl = (unsigned*)(ws + WS_CTL);
        extern __shared__ __attribute__((aligned(16))) unsigned char lds_raw[];
        volatile LAS unsigned* flag = (volatile LAS unsigned*)((LAS unsigned char*)lds_raw + MISC_OFF) + 16;
        if (threadIdx.x == 0) { unsigned ok = 0u; unsigned* slot = ctl + CW_PCNT + (l * 2 + WHICH) * 4096 + pm * 16;
            for (int sp = 0; sp < NT_SPIN; ++sp) {
                if (__hip_atomic_load(slot + sc->xcc, __ATOMIC_RELAXED, __HIP_MEMORY_SCOPE_AGENT) >= 64u) { ok = 1u; break; }
                if ((sp & 15) == 15) { unsigned tot = 0u; for (int q = 0; q < 16; ++q) tot += __hip_atomic_load(slot + q, __ATOMIC_RELAXED, __HIP_MEMORY_SCOPE_AGENT); if (tot >= 64u && __hip_atomic_load(slot + sc->xcc, __ATOMIC_RELAXED, __HIP_MEMORY_SCOPE_AGENT) < 64u) break; }
                __builtin_amdgcn_s_sleep(8); }
            __builtin_amdgcn_fence(__ATOMIC_ACQUIRE, "agent"); asm volatile("s_waitcnt vmcnt(0)" ::: "memory");
            *flag = ok; }
        __syncthreads();
        const unsigned ok = *flag;
        if (!ok) return;
        const int w = __builtin_amdgcn_readfirstlane((int)threadIdx.x >> 6), kind = l % 3;
        const float* mod = (const float*)(ws + WS_MOD); const float* modl = mod + (size_t)l * 17 * NMODC;
        bf16* xbl = (bf16*)inp_load<192>();
        for (int hf = 0; hf < ((WHICH || kind == 1 || NT_N2_WHOLE) ? 2 : 1); ++hf) {
            const int r0 = pm * 256 + 128 * hf + 16 * w;
            if (WHICH) norm_range<1, NT_WT != 0, NT_STREAM != 0>(r0, r0 + 16, TT, (const bf16*)(ws + F_Y), nullptr, nullptr, nullptr, xbl, (bf16*)(ws + WS_H), xbl, nullptr,
                                                 modl, 5, INP(6) + (l * 4 + 3) * D, modl + 17 * NMODC, 0, INP(6) + ((l + 1) * 4 + 0) * D, (bf16*)(ws + WS_U2));
            else norm_range<1, NT_WT != 0, NT_STREAM != 0>(r0, r0 + 16, TT, (const bf16*)(ws + (kind == 0 ? A_Y : (kind == 1 ? S_XBC : H_V))), nullptr, nullptr, nullptr, xbl, (bf16*)(ws + WS_H), xbl, nullptr,
                                           modl, 2, INP(6) + (l * 4 + 1) * D, modl, 3, INP(6) + (l * 4 + 2) * D, (bf16*)(ws + (kind == 1 ? S_Z : WS_U2)));
            __syncthreads();
            if (threadIdx.x == 0) ctl[CW_PDONE + (l * 2 + WHICH) * 512 + 2 * pm + hf] = 1u;
        }
    }
};
DI void norm_rest_phase(const Frame& F, int l, int which, const bf16* y, bf16* xb_lat, bf16* xb_ctx, const float* mod_a, int gate_idx, const float* gpost, const float* mod_b, int shift_idx, const float* gpre, bf16* u) {
    const unsigned* done = (const unsigned*)F.ctl + CW_PDONE + (l * 2 + which) * 512;
    LAS unsigned* list = (LAS unsigned*)F.lds;
    const int lane = lane_id();
    constexpr int NHP = 2 * (TT / 256);
    if (F.wave == 0) { int base = 0;
#pragma unroll
        for (int j = 0; j < (NHP + 63) / 64; ++j) { const int p = lane + 64 * j; const bool nd = p < NHP && done[p < NHP ? p : 0] == 0u; const unsigned long long m = __ballot(nd);
            if (nd) list[base + __popcll(m & ((1ull << lane) - 1ull))] = (unsigned)p; base += __popcll(m); }
        if (lane == 0) list[320] = (unsigned)base; }
    __syncthreads();
    const int P = __builtin_amdgcn_readfirstlane((int)list[320]), R = P * 128;
    const int per = (R + F.NGW - 1) / F.NGW; int cr = F.gw * per < R ? F.gw * per : R; const int cend = cr + per < R ? cr + per : R;
    while (cr < cend) {
        const int o = cr & 127, hp = __builtin_amdgcn_readfirstlane((int)list[cr >> 7]), n = (cend - cr) < (128 - o) ? (cend - cr) : (128 - o), r0 = hp * 128 + o;
        norm_range<1>(r0, r0 + n, TT, y, nullptr, nullptr, nullptr, xb_lat, xb_ctx, xb_lat, nullptr, mod_a, gate_idx, gpost, mod_b, shift_idx, gpre, u);
        cr += n;
    }
    __syncthreads();
}

#ifndef AT_THR
#define AT_THR 8.f
#endif
#ifndef T5_STATIC
#define T5_STATIC 1
#endif
constexpr int AT_KP = 144, AT_VP = 648, AT_LV = 320 * AT_KP;
#define AT_BAR() do { asm volatile("s_waitcnt lgkmcnt(0)" ::: "memory"); __builtin_amdgcn_s_barrier(); asm volatile("" ::: "memory"); } while (0)
DI void attn_phase(const Frame& F, const bf16* Kb, const bf16* Qb, const bf16* VtL, const bf16* VtC, const float* sink, bf16* O, bool need_ctx, BgConv& bg) {
    const int lane0 = lane_id(), wid = F.wave;
    if (T5_STATIC && wid >= 4) __builtin_amdgcn_s_setprio(1);
    LAS unsigned char* ldsK = F.lds; LAS unsigned char* ldsV = F.lds + AT_LV;
    const int nunits = need_ctx ? 2304 : 2048;
    v4u pk[5], pvv[5];
#define AT_LOAD(un_, pass_, tid_) do { const int u_ = (un_); int b_, q0_, kvh_; \
        if (u_ < 2048) { kvh_ = u_ & 3; q0_ = ((u_ >> 2) & 31) * 64; b_ = u_ >> 7; } else { const int v_ = u_ - 2048; kvh_ = v_ & 3; q0_ = ((v_ >> 2) & 3) * 64; b_ = v_ >> 4; } \
        if ((pass_) == 0) { \
            _Pragma("unroll") for (int i_ = 0; i_ < 5; ++i_) { const int idx_ = (tid_) + 512 * i_, row_ = idx_ >> 3, part_ = idx_ & 7, s_ = q0_ - 128 + row_; \
                pk[i_] = (s_ >= 0 && s_ < SEQ) ? *(const v4u*)(Kb + (size_t)(b_ * SEQ + s_) * 256 + kvh_ * 64 + part_ * 8) : (v4u){0u, 0u, 0u, 0u}; \
                const int d_ = idx_ / 40, pv_ = idx_ % 40, s0_ = q0_ - 128 + pv_ * 8; \
                pvv[i_] = (s0_ >= 0 && s0_ < SEQ) ? *(const v4u*)(VtL + ((size_t)((b_ * 4 + kvh_) * 64 + d_)) * SEQ + s0_) : (v4u){0u, 0u, 0u, 0u}; } \
        } else { \
            _Pragma("unroll") for (int i_ = 0; i_ < 4; ++i_) { const int idx_ = (tid_) + 512 * i_; \
                pk[i_] = *(const v4u*)(Kb + (size_t)(TLAT + b_ * CTXL + (idx_ >> 3)) * 256 + kvh_ * 64 + (idx_ & 7) * 8); \
                pvv[i_] = *(const v4u*)(VtC + ((size_t)((b_ * 4 + kvh_) * 64 + (idx_ >> 5))) * CTXL + (idx_ & 31) * 8); } \
        } } while (0)
    int un = blockIdx.x, pass = un >= 2048 ? 1 : 0;
    if (un < nunits) AT_LOAD(un, pass, wid * 64 + lane0);
    bf16x8 qf[2][4]; float m_[2], l_[2]; f32x16 o[2][2];
    while (un < nunits) {
        int lane = lane0; asm volatile("" : "+v"(lane));
        const int tid = wid * 64 + lane, r32 = lane & 31, h = lane >> 5;
        const bool cq = un >= 2048; int b, qblk, kvh;
        if (!cq) { kvh = un & 3; qblk = (un >> 2) & 31; b = un >> 7; } else { const int v = un - 2048; kvh = v & 3; qblk = (v >> 2) & 3; b = v >> 4; }
        const int q0 = qblk * 64, hq = kvh * 8 + wid;
        const size_t qrow0 = cq ? (size_t)(TLAT + b * CTXL + q0) : (size_t)(b * SEQ + q0);
        if (pass == (cq ? 1 : 0)) {
#pragma unroll
            for (int rb = 0; rb < 2; ++rb)
#pragma unroll
                for (int d0 = 0; d0 < 4; ++d0) qf[rb][d0] = *(const bf16x8*)(Qb + (qrow0 + 32 * rb + r32) * D + hq * 64 + 16 * d0 + 8 * h);
            const float sk = sink[hq] * LOG2E;
#pragma unroll
            for (int rb = 0; rb < 2; ++rb) { m_[rb] = sk; l_[rb] = h == 0 ? 1.f : 0.f;
#pragma unroll
                for (int db = 0; db < 2; ++db)
#pragma unroll
                    for (int i = 0; i < 16; ++i) o[rb][db][i] = 0.f; }
        }
        AT_BAR();
        if (pass == 0) {
#pragma unroll
            for (int i = 0; i < 5; ++i) { const int idx = tid + 512 * i; *(LAS v4u*)(ldsK + (idx >> 3) * AT_KP + (idx & 7) * 16) = pk[i];
                const int d = idx / 40, part = idx % 40; *(LAS u32x2*)(ldsV + d * AT_VP + part * 16) = (u32x2){pvv[i].x, pvv[i].y}; *(LAS u32x2*)(ldsV + d * AT_VP + part * 16 + 8) = (u32x2){pvv[i].z, pvv[i].w}; }
        } else {
#pragma unroll
            for (int i = 0; i < 4; ++i) { const int idx = tid + 512 * i; *(LAS v4u*)(ldsK + (idx >> 3) * AT_KP + (idx & 7) * 16) = pk[i];
                const int d = idx >> 5, part = idx & 31; *(LAS u32x2*)(ldsV + d * AT_VP + part * 16) = (u32x2){pvv[i].x, pvv[i].y}; *(LAS u32x2*)(ldsV + d * AT_VP + part * 16 + 8) = (u32x2){pvv[i].z, pvv[i].w}; }
        }
        int nun = un, npass = pass + 1;
        if (npass > 1) { nun = un + F.G; npass = nun >= 2048 ? 1 : 0; }
        if (nun < nunits) AT_LOAD(nun, npass, tid);
        AT_BAR();
        const int nkt = pass == 0 ? 10 : 8;
#pragma unroll 2
        for (int kt = 0; kt < nkt; ++kt) {
#if BG_ATT
            const BgConv::Tok tok = bg.pre();
#endif
            bf16x8 kf[4], vf[2][2];
#pragma unroll
            for (int d0 = 0; d0 < 4; ++d0) kf[d0] = lds_frag(ldsK + (32 * kt + r32) * AT_KP + 32 * d0 + 16 * h);
#pragma unroll
            for (int db = 0; db < 2; ++db)
#pragma unroll
                for (int s = 0; s < 2; ++s) { LAS unsigned char* vp = ldsV + (32 * db + r32) * AT_VP + (32 * kt + 16 * s + 4 * h) * 2;
                    const s16x4 vlo = *(LAS s16x4*)vp, vhi = *(LAS s16x4*)(vp + 16);
                    vf[db][s] = (bf16x8){vlo[0], vlo[1], vlo[2], vlo[3], vhi[0], vhi[1], vhi[2], vhi[3]}; }
#pragma unroll
            for (int rb = 0; rb < 2; ++rb) {
                if (pass == 0 && (kt < rb || kt > 8 + rb)) continue;
                const int t = pass == 0 ? kt - rb : kt;
                const int r = 32 * rb + r32;
                const int lo = max(r, 128 - q0), hi = min(r + 256, 2047 + 128 - q0);
                f32x16 p;
                { const float nm = -m_[rb];
#pragma unroll
                  for (int i = 0; i < 16; ++i) p[i] = nm; }
#pragma unroll
                for (int d0 = 0; d0 < 4; ++d0) p = mfma32(kf[d0], qf[rb][d0], p);
                if (pass == 0 && (t == 0 || t == 8 || q0 < 128 || q0 >= SEQ - 192)) {
#pragma unroll
                    for (int i = 0; i < 16; ++i) { const int c = 32 * kt + crow(i, h); if (c < lo || c > hi) p[i] = -INFINITY; }
                }
                float tm = p[0];
#pragma unroll
                for (int i = 1; i < 16; ++i) tm = fmaxf(tm, p[i]);
                tm = swap_max(tm);
                float alpha = 1.f;
                if (__any(tm > AT_THR)) {
                    const float d = fmaxf(tm, 0.f); alpha = __builtin_amdgcn_exp2f(-d); m_[rb] += d;
#pragma unroll
                    for (int i = 0; i < 16; ++i) p[i] -= d;
#pragma unroll
                    for (int db = 0; db < 2; ++db)
#pragma unroll
                        for (int i = 0; i < 16; ++i) o[rb][db][i] *= alpha; }
                float ls = 0.f;
#pragma unroll
                for (int i = 0; i < 16; ++i) { p[i] = __builtin_amdgcn_exp2f(p[i]); ls += p[i]; }
                l_[rb] = l_[rb] * alpha + ls;
                const bf16x8 pf0 = pack8(p, 0), pf1 = pack8(p, 1);
#pragma unroll
                for (int db = 0; db < 2; ++db)
#pragma unroll
                    for (int s = 0; s < 2; ++s) o[rb][db] = mfma32(vf[db][s], s == 0 ? pf0 : pf1, o[rb][db]);
            }
#if BG_ATT
            bg.post(tok);
#endif
        }
        if (pass == 1) {
#pragma unroll
            for (int rb = 0; rb < 2; ++rb) {
                const float inv = 1.f / swap_sum(l_[rb]);
                bf16* orow = O + (qrow0 + 32 * rb + r32) * D + hq * 64;
#pragma unroll
                for (int db = 0; db < 2; ++db)
#pragma unroll
                    for (int g4 = 0; g4 < 4; ++g4) { u32x2 w; w.x = cvtpk(o[rb][db][4 * g4] * inv, o[rb][db][4 * g4 + 1] * inv); w.y = cvtpk(o[rb][db][4 * g4 + 2] * inv, o[rb][db][4 * g4 + 3] * inv);
                        *(u32x2*)(orow + 32 * db + 8 * g4 + 4 * h) = w; }
            }
        }
        un = nun; pass = npass;
    }
#undef AT_LOAD
    if (T5_STATIC) __builtin_amdgcn_s_setprio(0);
    bg.drain();
    __syncthreads();
}

DI void ssd_conv_phase(const Frame& F, bf16* XBC, const bf16* HB, const float* cw, const float* cb) {
    const int lane = lane_id();
    for (int it = F.gw; it < (TT / 256) * 24; it += F.NGW) {
        const int seg = it / 24, col = (it % 24) * 256 + lane * 4;
        const bool first = seg >= TLAT / 256 || (seg & 7) == 0, last = seg >= TLAT / 256 || (seg & 7) == 7;
        const f32x4 w0 = *(const f32x4*)(cw + col), w1 = *(const f32x4*)(cw + SSD_CONV + col), w2 = *(const f32x4*)(cw + 2 * SSD_CONV + col), bb = *(const f32x4*)(cb + col);
        u32x2* base = (u32x2*)(XBC + (size_t)seg * 256 * SSD_CONV + col);
        u32x2 prev = first ? (u32x2){0u, 0u} : *(const u32x2*)(HB + (size_t)(2 * (seg - 1) + 1) * SSD_CONV + col);
        const u32x2 nxt = last ? (u32x2){0u, 0u} : *(const u32x2*)(HB + (size_t)(2 * (seg + 1)) * SSD_CONV + col);
        for (int t0 = 0; t0 < 256; t0 += 32) {
            u32x2 raw[33];
#pragma unroll
            for (int i = 0; i < 32; ++i) raw[i] = base[(size_t)(t0 + i) * (SSD_CONV / 4)];
            raw[32] = (t0 + 32 < 256) ? base[(size_t)(t0 + 32) * (SSD_CONV / 4)] : nxt;
#pragma unroll
            for (int i = 0; i < 32; ++i) {
                const u32x2 a = i == 0 ? prev : raw[i - 1], b = raw[i], c2 = raw[i + 1];
                const float o0 = bb[0] + w0[0] * bflo(a.x) + w1[0] * bflo(b.x) + w2[0] * bflo(c2.x), o1 = bb[1] + w0[1] * bfhi(a.x) + w1[1] * bfhi(b.x) + w2[1] * bfhi(c2.x);
                const float o2 = bb[2] + w0[2] * bflo(a.y) + w1[2] * bflo(b.y) + w2[2] * bflo(c2.y), o3 = bb[3] + w0[3] * bfhi(a.y) + w1[3] * bfhi(b.y) + w2[3] * bfhi(c2.y);
                base[(size_t)(t0 + i) * (SSD_CONV / 4)] = (u32x2){cvtpk(silu_f(o0), silu_f(o1)), cvtpk(silu_f(o2), silu_f(o3))};
            }
            prev = raw[31];
        }
    }
}

DI void ssd_fin_phase(const Frame& F, bf16* Y, const bf16* Z, const float* nw) {
    const int lane = lane_id();
    for (int row = F.gw; row < TT; row += F.NGW) {
#pragma unroll 2
        for (int k = 0; k < 8; ++k) {
            const int col = 512 * k + 8 * lane;
            const v4u yv = *(const v4u*)(Y + (size_t)row * SSD_DI + col), zv = *(const v4u*)(Z + (size_t)row * SSD_DI + col);
            float t[8]; float ss = 0.f;
#pragma unroll
            for (int e = 0; e < 4; ++e) { const unsigned yw = yv[e], zw = zv[e];
                t[2 * e] = bflo(yw) * silu_f(bflo(zw)); t[2 * e + 1] = bfhi(yw) * silu_f(bfhi(zw));
                ss += t[2 * e] * t[2 * e] + t[2 * e + 1] * t[2 * e + 1]; }
            const float rs = 1.f / sqrtf(wave_sum(ss) * (1.f / 512.f) + RMS_EPS);
            const f32x4 n0 = *(const f32x4*)(nw + col), n1 = *(const f32x4*)(nw + col + 4);
            v4u o; o.x = cvtpk(t[0] * rs * n0[0], t[1] * rs * n0[1]); o.y = cvtpk(t[2] * rs * n0[2], t[3] * rs * n0[3]);
            o.z = cvtpk(t[4] * rs * n1[0], t[5] * rs * n1[1]); o.w = cvtpk(t[6] * rs * n1[2], t[7] * rs * n1[3]);
            *(v4u*)(Y + (size_t)row * SSD_DI + col) = o;
        }
    }
}

DI void hgrn_fin_phase(const Frame& F, const bf16* O, const bf16* OG, const float* nw, bf16* Gp) {
    const int lane = lane_id();
    for (int row = F.gw; row < TT; row += F.NGW) {
#pragma unroll
        for (int k = 0; k < 4; ++k) {
            const int col = 512 * k + 8 * lane;
            const v4u of = *(const v4u*)(O + (size_t)row * D + col), ob = *(const v4u*)(O + (size_t)TT * D + (size_t)row * D + col), gv = *(const v4u*)(OG + (size_t)row * D + col);
            const f32x4 n0 = *(const f32x4*)(nw + col), n1 = *(const f32x4*)(nw + col + 4);
            float o[8]; float ss = 0.f;
#pragma unroll
            for (int e = 0; e < 4; ++e) { o[2 * e] = bflo(of[e]) + bflo(ob[e]); o[2 * e + 1] = bfhi(of[e]) + bfhi(ob[e]); ss += o[2 * e] * o[2 * e] + o[2 * e + 1] * o[2 * e + 1]; }
#pragma unroll
            for (int sft = 1; sft < 16; sft <<= 1) ss += __shfl_xor(ss, sft);
            const float rs = 1.f / sqrtf(ss * (1.f / 128.f) + RMS_EPS);
            v4u w;
#pragma unroll
            for (int e = 0; e < 4; ++e) { const float na = e < 2 ? n0[2 * e] : n1[2 * e - 4], nb = e < 2 ? n0[2 * e + 1] : n1[2 * e - 3];
                w[e] = cvtpk(o[2 * e] * rs * na * silu_f(bflo(gv[e])), o[2 * e + 1] * rs * nb * silu_f(bfhi(gv[e]))); }
            *(v4u*)(Gp + (size_t)row * D + col) = w;
        }
    }
}

#define WGBAR() do { asm volatile("s_waitcnt lgkmcnt(0)" ::: "memory"); __builtin_amdgcn_s_barrier(); asm volatile("" ::: "memory"); } while (0)
constexpr int S2_BM = 0, S2_CM = 17408, S2_GT = 34816, S2_XR = 52224, S2_PW = 89088;
DI size_t scan_rowbase(int dir, int step, int b) {
    if (dir == 0) return step < 4 ? (size_t)(TLAT + b * CTXL + 64 * step) : (size_t)(b * SEQ + 64 * (step - 4));
    return step < 4 ? (size_t)(TLAT + b * CTXL + 64 * (3 - step)) : (size_t)(b * SEQ + 64 * (35 - step));
}
DI void ssd_scan2_phase(const Frame& F, const bf16* XBC, const float* DT, const float* a_log, const float* dsk, bf16* Y, BgConv& bg) {
    const int lane0 = lane_id(), wid = F.wave;
    if (T5_STATIC && wid >= 4) __builtin_amdgcn_s_setprio(1);
    LAS unsigned char* L = F.lds;
    for (int un = blockIdx.x; un < NB * 16; un += F.G) {
        const int b = un >> 4, hg = un & 15, grp = hg >> 1, hd = hg * 4 + (wid >> 1), pt = wid & 1;
        LAS unsigned char* XRh = L + S2_XR + (wid >> 1) * 9216;
        LAS float* PW = (LAS float*)(L + S2_PW + wid * 1024);
        for (int dir = 0; dir < 2; ++dir) {
            const float a = -__expf(a_log[dir * 64 + hd]), dskip = dsk[hd];
            f32x16 st[4];
#pragma unroll
            for (int nb = 0; nb < 4; ++nb)
#pragma unroll
                for (int i = 0; i < 16; ++i) st[nb][i] = 0.f;
            v4u pb[2], pc[2], px[4]; float pdt;
#define S2_LOAD(stp, ln) do { const size_t rb_ = scan_rowbase(dir, (stp), b); const int tid_ = wid * 64 + (ln); \
                _Pragma("unroll") for (int q_ = 0; q_ < 2; ++q_) { const int idx_ = tid_ + 512 * q_, j_ = idx_ >> 4, part_ = idx_ & 15, tj_ = dir ? 63 - j_ : j_; \
                    const bf16* src_ = XBC + (rb_ + tj_) * SSD_CONV + SSD_DI + grp * 128 + part_ * 8; pb[q_] = *(const v4u*)src_; pc[q_] = *(const v4u*)(src_ + 1024); } \
                _Pragma("unroll") for (int q_ = 0; q_ < 4; ++q_) { const int j_ = 32 * (wid & 1) + 8 * q_ + ((ln) >> 3), tj_ = dir ? 63 - j_ : j_; \
                    px[q_] = *(const v4u*)(XBC + (rb_ + tj_) * SSD_CONV + hd * 64 + ((ln) & 7) * 8); } \
                pdt = DT[(rb_ + (dir ? 63 - (ln) : (ln))) * 128 + dir * 64 + hd]; } while (0)
            S2_LOAD(0, lane0);
            for (int step = 0; step < 36; ++step) {
                int lane = lane0; asm volatile("" : "+v"(lane));
                const int tid = wid * 64 + lane, r32 = lane & 31, h = lane >> 5, q4 = (lane & 15) >> 2, p4 = lane & 3, blk = (lane >> 4) & 1;
                const size_t rowbase = scan_rowbase(dir, step, b);
                WGBAR();
#pragma unroll
                for (int q = 0; q < 2; ++q) { const int idx = tid + 512 * q, j = idx >> 4, part = idx & 15;
                    *(LAS v4u*)(L + S2_BM + j * 272 + part * 16) = pb[q]; *(LAS v4u*)(L + S2_CM + j * 272 + part * 16) = pc[q]; }
#pragma unroll
                for (int q = 0; q < 4; ++q) { const int j = 32 * (wid & 1) + 8 * q + (lane >> 3); *(LAS v4u*)(XRh + j * 144 + (lane & 7) * 16) = px[q]; }
                const float dtv = pdt; float ac = dtv * a;
#pragma unroll
                for (int off = 1; off < 64; off <<= 1) { const float t = __shfl_up(ac, off); if (lane >= off) ac += t; }
                const float tot = __int_as_float(__builtin_amdgcn_readlane(__float_as_int(ac), 63));
                { const float la = ac * LOG2E; PW[lane] = la; PW[64 + lane] = __builtin_amdgcn_exp2f(la); PW[128 + lane] = la - __builtin_amdgcn_logf(dtv); PW[192 + lane] = dtv * __expf(tot - ac); }
                if (step + 1 < 36) S2_LOAD(step + 1, lane);
                WGBAR();
#if BG_SSD == 1
                const BgConv::Tok tok = bg.pre();
#endif
                v4u yold[2][2];
                unsigned yoff[2];
#pragma unroll
                for (int it = 0; it < 2; ++it) { const int i = 32 * it + r32, ti = dir ? 63 - i : i; yoff[it] = (unsigned)(((rowbase + ti) * SSD_DI + hd * 64 + 32 * pt + 8 * h) * 2); }
                if (dir) {
#pragma unroll
                    for (int it = 0; it < 2; ++it)
#pragma unroll
                        for (int pr = 0; pr < 2; ++pr) yold[it][pr] = *(const v4u*)((const unsigned char*)Y + yoff[it] + 32 * pr);
                }
                if (wid < 3) {
                    const int jt = wid >> 1, it = wid == 0 ? 0 : 1, i = 32 * it + r32;
                    f32x16 g;
#pragma unroll
                    for (int q = 0; q < 16; ++q) g[q] = 0.f;
#pragma unroll
                    for (int ks = 0; ks < 8; ++ks) g = mfma32(lds_frag(L + S2_BM + (32 * jt + r32) * 272 + 32 * ks + 16 * h), lds_frag(L + S2_CM + i * 272 + 32 * ks + 16 * h), g);
#pragma unroll
                    for (int g4 = 0; g4 < 4; ++g4) *(LAS f32x4*)(L + S2_GT + i * 272 + (32 * jt + 8 * g4 + 4 * h) * 4) = (f32x4){g[4 * g4], g[4 * g4 + 1], g[4 * g4 + 2], g[4 * g4 + 3]};
                }
                f32x16 yacc[2];
#pragma unroll
                for (int it = 0; it < 2; ++it)
#pragma unroll
                    for (int q = 0; q < 16; ++q) yacc[it][q] = 0.f;
#pragma unroll
                for (int nb = 0; nb < 4; ++nb)
#pragma unroll
                    for (int s = 0; s < 2; ++s) { const bf16x8 bfr = pack8(st[nb], s);
#pragma unroll
                        for (int it = 0; it < 2; ++it) { LAS unsigned char* cp = L + S2_CM + (32 * it + r32) * 272 + (32 * nb + 16 * s + 4 * h) * 2;
                            yacc[it] = mfma32(bfr, cat8(*(LAS s16x4*)cp, *(LAS s16x4*)(cp + 16)), yacc[it]); } }
#pragma unroll
                for (int it = 0; it < 2; ++it) { const float ea = PW[64 + 32 * it + r32];
#pragma unroll
                    for (int q = 0; q < 16; ++q) yacc[it][q] *= ea; }
                WGBAR();
#if BG_SSD == 2
                const BgConv::Tok tok = bg.pre();
#endif
#pragma unroll
                for (int it = 0; it < 2; ++it) { const int i = 32 * it + r32; const float aci = PW[i];
#pragma unroll
                    for (int s = 0; s < 4; ++s) { if (s >= 2 * (it + 1)) continue;
                        const int j0 = 16 * s + 8 * h;
                        const f32x4 g0 = *(LAS f32x4*)(L + S2_GT + i * 272 + j0 * 4), g1 = *(LAS f32x4*)(L + S2_GT + i * 272 + j0 * 4 + 16);
                        const f32x4 a0 = *(LAS f32x4*)(PW + 128 + j0), a1 = *(LAS f32x4*)(PW + 128 + j0 + 4);
                        float m[8];
#pragma unroll
                        for (int e = 0; e < 4; ++e) { m[e] = (j0 + e <= i) ? g0[e] * __builtin_amdgcn_exp2f(aci - a0[e]) : 0.f; m[4 + e] = (j0 + 4 + e <= i) ? g1[e] * __builtin_amdgcn_exp2f(aci - a1[e]) : 0.f; }
                        v4u mp; mp.x = cvtpk(m[0], m[1]); mp.y = cvtpk(m[2], m[3]); mp.z = cvtpk(m[4], m[5]); mp.w = cvtpk(m[6], m[7]);
                        LAS unsigned char* xp = XRh + (16 * s + 8 * h + q4) * 144 + (32 * pt + 16 * blk + 4 * p4) * 2;
                        yacc[it] = mfma32(cat8(tr16(xp), tr16(xp + 4 * 144)), __builtin_bit_cast(bf16x8, mp), yacc[it]); } }
#if BG_SSD == 4
                const BgConv::Tok tok = bg.pre();
#endif
#pragma unroll
                for (int it = 0; it < 2; ++it)
#pragma unroll
                    for (int pr = 0; pr < 2; ++pr) {
                        float va[4], vb[4];
#pragma unroll
                        for (int e2 = 0; e2 < 4; ++e2) { va[e2] = yacc[it][8 * pr + e2]; vb[e2] = yacc[it][8 * pr + 4 + e2]; }
                        if (dir) {
                            const auto s0 = __builtin_amdgcn_permlane32_swap(yold[it][pr].x, yold[it][pr].z, false, false), s1 = __builtin_amdgcn_permlane32_swap(yold[it][pr].y, yold[it][pr].w, false, false);
                            va[0] += bflo(s0[0]); va[1] += bfhi(s0[0]); va[2] += bflo(s1[0]); va[3] += bfhi(s1[0]);
                            vb[0] += bflo(s0[1]); vb[1] += bfhi(s0[1]); vb[2] += bflo(s1[1]); vb[3] += bfhi(s1[1]);
                        } else {
                            const u32x2 xa = *(LAS u32x2*)(XRh + (32 * it + r32) * 144 + (32 * pt + 16 * pr + 4 * h) * 2), xb = *(LAS u32x2*)(XRh + (32 * it + r32) * 144 + (32 * pt + 16 * pr + 8 + 4 * h) * 2);
                            va[0] += dskip * bflo(xa.x); va[1] += dskip * bfhi(xa.x); va[2] += dskip * bflo(xa.y); va[3] += dskip * bfhi(xa.y);
                            vb[0] += dskip * bflo(xb.x); vb[1] += dskip * bfhi(xb.x); vb[2] += dskip * bflo(xb.y); vb[3] += dskip * bfhi(xb.y);
                        }
                        const unsigned a0 = cvtpk(va[0], va[1]), a1 = cvtpk(va[2], va[3]), b0 = cvtpk(vb[0], vb[1]), b1 = cvtpk(vb[2], vb[3]);
                        const auto t0 = __builtin_amdgcn_permlane32_swap(a0, b0, false, false), t1 = __builtin_amdgcn_permlane32_swap(a1, b1, false, false);
                        *(v4u*)((unsigned char*)Y + yoff[it] + 32 * pr) = (v4u){t0[0], t1[0], t0[1], t1[1]}; }
#if BG_SSD == 3
                const BgConv::Tok tok = bg.pre();
#endif
                { const float cd = __expf(tot);
#pragma unroll
                  for (int nb = 0; nb < 4; ++nb)
#pragma unroll
                      for (int q = 0; q < 16; ++q) st[nb][q] *= cd; }
#pragma unroll
                for (int s = 0; s < 4; ++s) {
                    LAS unsigned char* xp = XRh + (16 * s + 8 * h + q4) * 144 + (32 * pt + 16 * blk + 4 * p4) * 2;
                    const s16x4 xl = tr16(xp), xh = tr16(xp + 4 * 144);
                    const f32x4 w0 = *(LAS f32x4*)(PW + 192 + 16 * s + 8 * h), w1 = *(LAS f32x4*)(PW + 192 + 16 * s + 8 * h + 4);
                    v4u xd; xd.x = cvtpk(bf2f((unsigned short)xl[0]) * w0[0], bf2f((unsigned short)xl[1]) * w0[1]); xd.y = cvtpk(bf2f((unsigned short)xl[2]) * w0[2], bf2f((unsigned short)xl[3]) * w0[3]);
                    xd.z = cvtpk(bf2f((unsigned short)xh[0]) * w1[0], bf2f((unsigned short)xh[1]) * w1[1]); xd.w = cvtpk(bf2f((unsigned short)xh[2]) * w1[2], bf2f((unsigned short)xh[3]) * w1[3]);
#pragma unroll
                    for (int nb = 0; nb < 4; ++nb) { LAS unsigned char* bp = L + S2_BM + (16 * s + 8 * h + q4) * 272 + (32 * nb + 16 * blk + 4 * p4) * 2;
                        st[nb] = mfma32(cat8(tr16(bp), tr16(bp + 4 * 272)), __builtin_bit_cast(bf16x8, xd), st[nb]); }
                }
#if BG_SSD
                bg.post(tok);
#endif
            }
#undef S2_LOAD
            asm volatile("s_waitcnt vmcnt(0)" ::: "memory");
        }
    }
    if (T5_STATIC) __builtin_amdgcn_s_setprio(0);
    bg.drain();
    __syncthreads();
}

#ifndef HG_SKEW
#define HG_SKEW 1
#endif
constexpr int H2_QT = 0, H2_KT = 17408, H2_VM = 34816, H2_AM = 52224, H2_EG = 61440, H2_TEAM = 61952;
DI void hgrn_scan2_phase(const Frame& F, const _Float16* LG, const bf16* V, const bf16* Q, bf16* O, BgConv& bg) {
    const int lane0 = lane_id(), wid = F.wave, team = wid >> 2, wq = wid & 3;
    LAS unsigned char* L = F.lds + team * H2_TEAM;
    const _Float16* LGd = LG + (size_t)team * TT * D;
    for (int un = blockIdx.x; un < NB * 16; un += F.G) {
        const int b = un >> 4, hd = un & 15;
        f32x16 st[4];
#pragma unroll
        for (int dt = 0; dt < 4; ++dt)
#pragma unroll
            for (int i = 0; i < 16; ++i) st[dt][i] = 0.f;
        v4u plg[4], pq[4], pv[4];
#define H2_LOAD(stp, ln) do { const size_t rb_ = scan_rowbase(team, (stp), b); const int col_ = hd * 128 + 8 * (4 * wq + ((ln) & 3)); \
            _Pragma("unroll") for (int r_ = 0; r_ < 4; ++r_) { const int i_ = 4 * ((ln) >> 2) + r_, ti_ = team ? 63 - i_ : i_; const size_t o_ = (rb_ + ti_) * D + col_; \
                plg[r_] = *(const v4u*)(LGd + o_); pq[r_] = *(const v4u*)(Q + o_); pv[r_] = *(const v4u*)(V + o_); } } while (0)
        H2_LOAD(0, lane0);
        if (HG_SKEW && team) WGBAR();
        for (int step = 0; step < 36; ++step) {
            int lane = lane0; asm volatile("" : "+v"(lane));
            const int r32 = lane & 31, h = lane >> 5, q4 = (lane & 15) >> 2, p4 = lane & 3, blk = (lane >> 4) & 1;
            const size_t rowbase = scan_rowbase(team, step, b);
            WGBAR();
            const BgConv::Tok tok = bg.pre();
            {
                const int part = lane >> 2, dcol = 8 * (4 * wq + (lane & 3));
                float P[4][8], kk[4][8];
#pragma unroll
                for (int r = 0; r < 4; ++r)
#pragma unroll
                    for (int e = 0; e < 4; ++e) { const unsigned w = plg[r][e]; kk[r][2 * e] = (float)__builtin_bit_cast(_Float16, (unsigned short)(w & 0xffffu)); kk[r][2 * e + 1] = (float)__builtin_bit_cast(_Float16, (unsigned short)(w >> 16)); }
                float tot[8];
#pragma unroll
                for (int e = 0; e < 8; ++e) { float run = 1.f;
#pragma unroll
                    for (int r = 0; r < 4; ++r) { run *= 1.f - kk[r][e]; P[r][e] = run; }
                    tot[e] = run; }
#pragma unroll
                for (int e = 0; e < 8; ++e) { float inc = tot[e];
#pragma unroll
                    for (int off = 4; off < 64; off <<= 1) { const float t = __shfl_up(inc, off); if (lane >= off) inc *= t; }
                    float pre = __shfl_up(inc, 4); if (lane < 4) pre = 1.f;
                    tot[e] = __shfl(inc, 60 + (lane & 3));
#pragma unroll
                    for (int r = 0; r < 4; ++r) P[r][e] *= pre; }
                if (part == 0) {
#pragma unroll
                    for (int e = 0; e < 8; e += 4) *(LAS f32x4*)(L + H2_EG + (dcol + e) * 4) = (f32x4){tot[e], tot[e + 1], tot[e + 2], tot[e + 3]}; }
#pragma unroll
                for (int r = 0; r < 4; ++r) { const int i = 4 * part + r; v4u qo, ko;
#pragma unroll
                    for (int e = 0; e < 4; ++e) { const unsigned qw = pq[r][e];
                        const float p0 = P[r][2 * e], p1 = P[r][2 * e + 1];
                        qo[e] = cvtpk(bflo(qw) * p0, bfhi(qw) * p1); ko[e] = cvtpk(kk[r][2 * e] * __builtin_amdgcn_rcpf(p0), kk[r][2 * e + 1] * __builtin_amdgcn_rcpf(p1)); }
                    *(LAS v4u*)(L + H2_QT + i * 272 + dcol * 2) = qo; *(LAS v4u*)(L + H2_KT + i * 272 + dcol * 2) = ko; *(LAS v4u*)(L + H2_VM + i * 272 + dcol * 2) = pv[r]; }
            }
            if (step + 1 < 36) H2_LOAD(step + 1, lane);
            WGBAR();
            if (wq < 3) {
                const int jt = wq >> 1, it = wq == 0 ? 0 : 1, i = 32 * it + r32;
                f32x16 g;
#pragma unroll
                for (int q = 0; q < 16; ++q) g[q] = 0.f;
#pragma unroll
                for (int ks = 0; ks < 8; ++ks) g = mfma32(lds_frag(L + H2_KT + (32 * jt + r32) * 272 + 32 * ks + 16 * h), lds_frag(L + H2_QT + i * 272 + 32 * ks + 16 * h), g);
#pragma unroll
                for (int q = 0; q < 16; ++q) { const int j = 32 * jt + crow(q, h); if (j > i) g[q] = 0.f; }
#pragma unroll
                for (int g4 = 0; g4 < 4; ++g4) { u32x2 w; w.x = cvtpk(g[4 * g4], g[4 * g4 + 1]); w.y = cvtpk(g[4 * g4 + 2], g[4 * g4 + 3]);
                    *(LAS u32x2*)(L + H2_AM + i * 144 + (32 * jt + 8 * g4 + 4 * h) * 2) = w; }
            }
            f32x16 oacc[2];
#pragma unroll
            for (int it = 0; it < 2; ++it)
#pragma unroll
                for (int q = 0; q < 16; ++q) oacc[it][q] = 0.f;
#pragma unroll
            for (int dt = 0; dt < 4; ++dt)
#pragma unroll
                for (int s = 0; s < 2; ++s) { const bf16x8 afr = pack8(st[dt], s);
#pragma unroll
                    for (int it = 0; it < 2; ++it) { LAS unsigned char* qp = L + H2_QT + (32 * it + r32) * 272 + (32 * dt + 16 * s + 4 * h) * 2;
                        oacc[it] = mfma32(afr, cat8(*(LAS s16x4*)qp, *(LAS s16x4*)(qp + 16)), oacc[it]); } }
            WGBAR();
            bf16x8 vfr[4];
#pragma unroll
            for (int s = 0; s < 4; ++s) { LAS unsigned char* vp = L + H2_VM + (16 * s + 8 * h + q4) * 272 + (32 * wq + 16 * blk + 4 * p4) * 2; vfr[s] = cat8(tr16(vp), tr16(vp + 4 * 272)); }
#pragma unroll
            for (int it = 0; it < 2; ++it)
#pragma unroll
                for (int s = 0; s < 4; ++s) { if (s >= 2 * (it + 1)) continue;
                    oacc[it] = mfma32(vfr[s], lds_frag(L + H2_AM + (32 * it + r32) * 144 + 32 * s + 16 * h), oacc[it]); }
#pragma unroll
            for (int it = 0; it < 2; ++it) { const int i = 32 * it + r32, ti = team ? 63 - i : i;
                bf16* op = O + (size_t)team * TT * D + (rowbase + ti) * D + hd * 128 + 32 * wq + 8 * h;
#pragma unroll
                for (int pr = 0; pr < 2; ++pr) {
                    const unsigned a0 = cvtpk(oacc[it][8 * pr], oacc[it][8 * pr + 1]), a1 = cvtpk(oacc[it][8 * pr + 2], oacc[it][8 * pr + 3]);
                    const unsigned b0 = cvtpk(oacc[it][8 * pr + 4], oacc[it][8 * pr + 5]), b1 = cvtpk(oacc[it][8 * pr + 6], oacc[it][8 * pr + 7]);
                    const auto t0 = __builtin_amdgcn_permlane32_swap(a0, b0, false, false), t1 = __builtin_amdgcn_permlane32_swap(a1, b1, false, false);
                    *(v4u*)(op + 16 * pr) = (v4u){t0[0], t1[0], t0[1], t1[1]}; } }
#pragma unroll
            for (int s = 0; s < 4; ++s)
#pragma unroll
                for (int dt = 0; dt < 4; ++dt) { LAS unsigned char* kp = L + H2_KT + (16 * s + 8 * h + q4) * 272 + (32 * dt + 16 * blk + 4 * p4) * 2;
                    st[dt] = mfma32(cat8(tr16(kp), tr16(kp + 4 * 272)), vfr[s], st[dt]); }
#pragma unroll
            for (int dt = 0; dt < 4; ++dt)
#pragma unroll
                for (int g4 = 0; g4 < 4; ++g4) { const f32x4 eg = *(LAS f32x4*)(L + H2_EG + (32 * dt + 8 * g4 + 4 * h) * 4);
#pragma unroll
                    for (int e = 0; e < 4; ++e) st[dt][4 * g4 + e] *= eg[e]; }
            bg.post(tok);
        }
        if (HG_SKEW && !team) WGBAR();
#undef H2_LOAD
    }
    bg.drain();
    __syncthreads();
}

#ifndef EN_MODP
#define EN_MODP 1
#endif
#ifndef EN_PRO
#define EN_PRO 1
#endif
#ifndef EN_NORM
#define EN_NORM 1
#endif
#ifndef EN_G1
#define EN_G1 1
#endif
#ifndef EN_ATT
#define EN_ATT 1
#endif
#ifndef EN_CONV
#define EN_CONV 1
#endif
#ifndef EN_HSCAN
#define EN_HSCAN 1
#endif
#ifndef EN_SSCAN
#define EN_SSCAN 1
#endif
#ifndef EN_FIN
#define EN_FIN 1
#endif
#ifndef EN_G2
#define EN_G2 1
#endif
#ifndef EN_G3
#define EN_G3 1
#endif
#ifndef EN_G4
#define EN_G4 1
#endif
#ifndef EN_G1A
#define EN_G1A 1
#endif
#ifndef EN_G1S
#define EN_G1S 1
#endif
#ifndef EN_G1H
#define EN_G1H 1
#endif
#ifndef REP_G1
#define REP_G1 1
#endif
#ifndef REP_G2
#define REP_G2 1
#endif
#ifndef REP_G3
#define REP_G3 1
#endif
#ifndef REP_G4
#define REP_G4 1
#endif
#ifndef REP_ATT
#define REP_ATT 1
#endif
#ifndef REP_SSCAN
#define REP_SSCAN 1
#endif
#ifndef REP_HSCAN
#define REP_HSCAN 1
#endif
#ifndef REP_PRO
#define REP_PRO 1
#endif
#ifndef MK_ONE_LAUNCH
#define MK_ONE_LAUNCH 1
#endif
#ifndef BG_G2
#define BG_G2 1
#endif
#ifndef BG_G3
#define BG_G3 1
#endif
#ifndef BG_G4
#define BG_G4 1
#endif
#ifndef MK_LAYERS
#define MK_LAYERS 4
#endif
constexpr int PH_MODP = 0, PH_PRO = 1, PH_N0 = 2, PH_L0 = 3, PH_PER = 9, PH_END = PH_L0 + PH_PER * DEPTH;
struct Args { const float* in[24]; float* out; unsigned char* ws; int lo, hi; };
static_assert(sizeof(Args) == 26 * 8 + 8, "no padding");

__global__ void __launch_bounds__(NWAVES * 64, 2) trunk_fwd(Args args) {
    extern __shared__ __attribute__((aligned(16))) unsigned char lds_raw[];
    Frame F;
    F.lds = (LAS unsigned char*)lds_raw;
    F.MISC = (volatile LAS unsigned*)(F.lds + MISC_OFF);
    F.wave = __builtin_amdgcn_readfirstlane((int)threadIdx.x >> 6);
    F.G = gridDim.x; F.gw = blockIdx.x * NWAVES + F.wave; F.NGW = F.G * NWAVES;
    unsigned char* ws = args.ws;
    F.ctl = (gu32*)(ws + WS_CTL);
    for (int u = threadIdx.x; u < (LDS_BYTES - LDSCTL_OFF) / 4; u += NWAVES * 64) ((LAS unsigned*)(F.lds + LDSCTL_OFF))[u] = 0u;
    __syncthreads();
    XcdBarrier bar = xcd_barrier_post((unsigned*)(F.ctl + CW_BAR), F.MISC + 8);
    const int lo = args.lo, hi = args.hi;
#define IN(k) (lo <= (k) && (k) < hi)
#define SEAM(k) do { if ((k) + 1 < hi) xcd_barrier(bar); } while (0)
    float* out = args.out;
    bf16* xbl = (bf16*)out;
    bf16* xbc = (bf16*)(ws + WS_H);
    bf16* xbl3 = (bf16*)(ws + WS_U2 + 144 * MiB);
    float* mod = (float*)(ws + WS_MOD);
        bf16* U = (bf16*)(ws + WS_U2);
    const float* rope = (const float*)(ws + WS_TAB);
    const float* lbv = (const float*)(ws + WS_TAB + 16384);

    if (EN_MODP && IN(PH_MODP)) { mod_partial_phase(F, INP(1), INP(3), INP(4), (float*)(ws + WS_MODP)); SEAM(PH_MODP); }
    if (EN_PRO && IN(PH_PRO)) { for (int rep = 0; rep < REP_PRO; ++rep) prologue_phase(F, ws); SEAM(PH_PRO); }
#ifdef IDLE_TICKS
    { const unsigned long long t0 = __builtin_amdgcn_s_memrealtime(); while (__builtin_amdgcn_s_memrealtime() - t0 < IDLE_TICKS) __builtin_amdgcn_s_sleep(32); }
#endif
    if (EN_NORM && IN(PH_N0)) {
        norm_phase<0>(F, TT, nullptr, nullptr, INP(0), INP(2), xbl, xbc, xbl, nullptr, nullptr, 0, nullptr, mod, 0, INP(6), U);
        SEAM(PH_N0);
    }
    for (int l = 0; l < MK_LAYERS; ++l) {
        const int base = PH_L0 + PH_PER * l, kind = l % 3, j = l / 3;
        const float* modl = mod + (size_t)l * 17 * NMODC;
        const int M2 = l < DEPTH - 1 ? TT : TLAT;
        BgConv bg; bg.init((kind == 0 && !BG_ATT) ? DEPTH : l + 1);
        pg8::NoSide noside;
        if (EN_G1 && IN(base + 0)) { for (int rep = 0; rep < REP_G1; ++rep) {
            pg8::StaticOrder S;
            if (kind == 0) { if (EN_G1A) {
                pg8::Gemm g{U, (const bf16*)(ws + WS_WATT + (size_t)j * (W_ATT_IN + W_ATT_OUT)), TT, ATT_IN, D}; S.init(TT, ATT_IN, F.G, (int)blockIdx.x);
                EpiAttn E{(bf16*)(ws + A_KB), (bf16*)(ws + A_QB), (bf16*)(ws + A_VTL), (bf16*)(ws + A_VTC), rope};
                pg8::gemm_phase<EpiAttn, pg8::StaticOrder, true, true>(F.lds, g, S, E, F.wave, noside); }
            } else if (kind == 1) { if (EN_G1S) {
                pg8::Gemm g{U, (const bf16*)(ws + WS_WSSD), TT, SSD_INP, D}; S.init(TT, SSD_INP, F.G, (int)blockIdx.x);
                EpiSsd E{(bf16*)(ws + S_XBC), (bf16*)(ws + S_Z), (float*)(ws + S_DT), INP(15), (bf16*)(ws + WS_MODP)};
                pg8::gemm_phase<EpiSsd, pg8::StaticOrder, true, true>(F.lds, g, S, E, F.wave, noside); }
            } else if (EN_G1H) {
                pg8::Gemm g{U, (const bf16*)(ws + WS_WHG), TT, HG_IN, D}; S.init(TT, HG_IN, F.G, (int)blockIdx.x);
                EpiHgrn E{(_Float16*)(ws + H_LG), (bf16*)(ws + H_V), lbv};
                pg8::gemm_phase<EpiHgrn, pg8::StaticOrder, true, true>(F.lds, g, S, E, F.wave, noside);
            } }
            SEAM(base + 0);
        }
        if (IN(base + 1)) {
            if (kind == 0) { if (EN_ATT) for (int rep = 0; rep < REP_ATT; ++rep) attn_phase(F, (const bf16*)(ws + A_KB), (const bf16*)(ws + A_QB), (const bf16*)(ws + A_VTL), (const bf16*)(ws + A_VTC), INP(11) + j * 32, (bf16*)(ws + A_O), l < DEPTH - 1, bg); }
            else if (kind == 1) { if (EN_CONV) ssd_conv_phase(F, (bf16*)(ws + S_XBC), (const bf16*)(ws + WS_MODP), INP(13), INP(14)); }
            else if (EN_HSCAN) for (int rep = 0; rep < REP_HSCAN; ++rep) hgrn_scan2_phase(F, (const _Float16*)(ws + H_LG), (const bf16*)(ws + H_V), (const bf16*)(ws + H_Q), (bf16*)(ws + WS_U2), bg);
            SEAM(base + 1);
        }
        if (kind != 0 && IN(base + 2)) {
            if (kind == 1) { if (EN_SSCAN) for (int rep = 0; rep < REP_SSCAN; ++rep) ssd_scan2_phase(F, (const bf16*)(ws + S_XBC), (const float*)(ws + S_DT), INP(16), INP(17), (bf16*)(ws + WS_U2), bg); }
            else if (EN_FIN) hgrn_fin_phase(F, (const bf16*)(ws + WS_U2), (const bf16*)(ws + H_OG), INP(22), (bf16*)(ws + H_LG));
            SEAM(base + 2);
        }
        if (kind == 1 && IN(base + 3)) {
            if (EN_FIN) ssd_fin_phase(F, (bf16*)(ws + WS_U2), (const bf16*)(ws + S_Z), INP(18));
            SEAM(base + 3);
        }
        bf16* ymix = (bf16*)(ws + (kind == 0 ? A_Y : (kind == 1 ? S_XBC : H_V)));
        bf16* Un2 = ((NT_N2 & 2) && kind == 1) ? (bf16*)(ws + S_Z) : U;
        if (EN_G2 && IN(base + 4)) {
            const bf16* A2 = (const bf16*)(ws + (kind == 0 ? A_O : (kind == 1 ? WS_U2 : H_LG)));
            const bf16* W2 = (const bf16*)(ws + (kind == 0 ? WS_WATT + (size_t)j * (W_ATT_IN + W_ATT_OUT) + W_ATT_IN : (kind == 1 ? WS_WSSD + W_SSD_IN : WS_WHG + W_HG_IN)));
            pg8::Gemm g{A2, W2, M2, D, kind == 1 ? SSD_DI : D}; pg8::StaticOrder S; S.init(M2, D, F.G, (int)blockIdx.x);
            EpiBf16Y E{ymix};
            if (NT_ON && l < DEPTH - 1 && (((NT_N2 & 1) && kind != 1) || ((NT_N2 & 2) && kind == 1))) {
                CountOrder SC; SC.init(M2, D, F.G, (int)blockIdx.x); SC.cnt = (unsigned*)F.ctl + CW_PCNT + (l * 2 + 0) * 4096; SC.xcc = (int)bar.x;
                EpiBf16YWT EW{ymix}; NormTail<0> nt{l, (NT_TAIL && SC.idle_last()) ? 1 : 0, (int)blockIdx.x - SC.nwg % SC.G, &SC};
                pg8::gemm_phase<EpiBf16YWT, CountOrder, true, true, NormTail<0>>(F.lds, g, SC, EW, F.wave, nt);
            } else
            for (int rep = 0; rep < REP_G2; ++rep) { if (BG_G2) pg8::gemm_phase<EpiBf16Y, pg8::StaticOrder, true, true>(F.lds, g, S, E, F.wave, noside); else pg8::gemm_phase<EpiBf16Y, pg8::StaticOrder, true, true>(F.lds, g, S, E, F.wave, noside); }
            SEAM(base + 4);
        }
        if (EN_NORM && IN(base + 5)) {
            if (NT_ON && l < DEPTH - 1 && (((NT_N2 & 1) && kind != 1) || ((NT_N2 & 2) && kind == 1))) norm_rest_phase(F, l, 0, ymix, xbl, xbc, modl, 2, INP(6) + (l * 4 + 1) * D, modl, 3, INP(6) + (l * 4 + 2) * D, Un2);
            else norm_phase<1>(F, M2, ymix, nullptr, nullptr, nullptr, xbl, xbc, l == DEPTH - 1 ? xbl3 : xbl, nullptr, modl, 2, INP(6) + (l * 4 + 1) * D, modl, 3, INP(6) + (l * 4 + 2) * D, Un2);
            SEAM(base + 5);
        }
        const unsigned char* wffn = ws + WS_WFFN + (size_t)l * (W_FFN_IN + W_FFN_OUT);
        if (EN_G3 && IN(base + 6)) {
            pg8::Gemm g{Un2, (const bf16*)wffn, M2, 2 * FFN, D}; pg8::StaticOrder S; S.init(M2, 2 * FFN, F.G, (int)blockIdx.x);
            EpiSwiglu E{(bf16*)(ws + F_H)};
            for (int rep = 0; rep < REP_G3; ++rep) { if (BG_G3) pg8::gemm_phase<EpiSwiglu, pg8::StaticOrder, true, true>(F.lds, g, S, E, F.wave, noside); else pg8::gemm_phase<EpiSwiglu, pg8::StaticOrder, true, true>(F.lds, g, S, E, F.wave, noside); }
            SEAM(base + 6);
        }
        if (EN_G4 && IN(base + 7)) {
            pg8::Gemm g{(const bf16*)(ws + F_H), (const bf16*)(wffn + W_FFN_IN), M2, D, FFN}; pg8::StaticOrder S; S.init(M2, D, F.G, (int)blockIdx.x);
            EpiBf16Y E{(bf16*)(ws + F_Y)};
            if (NT_ON && l < DEPTH - 1) {
                CountOrder SC; SC.init(M2, D, F.G, (int)blockIdx.x); SC.cnt = (unsigned*)F.ctl + CW_PCNT + (l * 2 + 1) * 4096; SC.xcc = (int)bar.x;
                EpiBf16YWT EW{(bf16*)(ws + F_Y)}; NormTail<1> nt{l, (NT_TAIL && SC.idle_last()) ? 1 : 0, (int)blockIdx.x - SC.nwg % SC.G, &SC};
                pg8::gemm_phase<EpiBf16YWT, CountOrder, true, true, NormTail<1>>(F.lds, g, SC, EW, F.wave, nt);
            } else
            for (int rep = 0; rep < REP_G4; ++rep) { if (BG_G4) pg8::gemm_phase<EpiBf16Y, pg8::StaticOrder, true, true>(F.lds, g, S, E, F.wave, noside); else pg8::gemm_phase<EpiBf16Y, pg8::StaticOrder, true, true>(F.lds, g, S, E, F.wave, noside); }
            SEAM(base + 7);
        }
        if (EN_NORM && IN(base + 8)) {
            if (l < DEPTH - 1) { if (NT_ON) norm_rest_phase(F, l, 1, (const bf16*)(ws + F_Y), xbl, xbc, modl, 5, INP(6) + (l * 4 + 3) * D, modl + 17 * NMODC, 0, INP(6) + ((l + 1) * 4 + 0) * D, U);
                else norm_phase<1>(F, M2, (const bf16*)(ws + F_Y), nullptr, nullptr, nullptr, xbl, xbc, xbl, nullptr, modl, 5, INP(6) + (l * 4 + 3) * D, modl + 17 * NMODC, 0, INP(6) + ((l + 1) * 4 + 0) * D, U); }
            else norm_phase<2>(F, M2, (const bf16*)(ws + F_Y), nullptr, nullptr, nullptr, xbl3, xbc, xbl3, out, modl, 5, INP(6) + (l * 4 + 3) * D, nullptr, 0, nullptr, nullptr);
            SEAM(base + 8);
        }
    }
#undef IN
#undef SEAM
}

extern "C" void kernel_launch(void* const* d_in, const int* in_sizes, int n_in, void* d_out, int out_size, void* d_ws, size_t ws_size, hipStream_t stream) {
    static int grid = 0;
    if (grid == 0) {
        if (n_in != 24 || in_sizes[0] != TLAT * D || out_size != TLAT * D || ws_size < WS_END) {
            fprintf(stderr, "kernel_launch: unexpected shapes: n_in %d in0 %d out %d ws %zu (need %zu)\n", n_in, n_in > 0 ? in_sizes[0] : -1, out_size, ws_size, (size_t)WS_END); grid = -1; return; }
        int dev = 0, cus = 0, per_cu = 0;
        if (hipGetDevice(&dev) != hipSuccess || hipDeviceGetAttribute(&cus, hipDeviceAttributeMultiprocessorCount, dev) != hipSuccess) { grid = -1; return; }
        if (hipFuncSetAttribute((const void*)trunk_fwd, hipFuncAttributeMaxDynamicSharedMemorySize, LDS_BYTES) != hipSuccess) { fprintf(stderr, "kernel_launch: hipFuncSetAttribute failed\n"); grid = -1; return; }
        if (hipOccupancyMaxActiveBlocksPerMultiprocessor(&per_cu, (const void*)trunk_fwd, NWAVES * 64, LDS_BYTES) != hipSuccess || per_cu < 1)
            fprintf(stderr, "kernel_launch: occupancy query reports %d\n", per_cu);
        (void)hipGetLastError();
        grid = cus;
    }
    if (grid < 0) return;
    if (hipMemsetAsync((char*)d_ws + WS_CTL, 0, CTL_ZERO_BYTES, stream) != hipSuccess) return;
    Args a{};
    for (int i = 0; i < 24; ++i) a.in[i] = (const float*)d_in[i];
    a.out = (float*)d_out; a.ws = (unsigned char*)d_ws;
#if MK_ONE_LAUNCH
    a.lo = 0; a.hi = PH_L0 + PH_PER * MK_LAYERS;
    hipLaunchKernelGGL(trunk_fwd, dim3(grid), dim3(NWAVES * 64), LDS_BYTES, stream, a);
#else
    for (int id = 0; id < PH_L0 + PH_PER * MK_LAYERS; ++id) {
        if (id >= PH_L0) { const int loc = (id - PH_L0) % PH_PER, kind = ((id - PH_L0) / PH_PER) % 3; if ((loc == 2 && kind == 0) || (loc == 3 && kind != 1)) continue; }
        a.lo = id; a.hi = id + 1;
        hipLaunchKernelGGL(trunk_fwd, dim3(grid), dim3(NWAVES * 64), LDS_BYTES, stream, a);
    }
#endif
}
```
